# Optimizing an MI355X kernel written in HIP

```python
import math
import jax, jax.numpy as jnp
from jax import lax
import numpy as np

D_MODEL = 1024
BATCH = 8
SEQ = 2048
DEPTH = 1

MEM_LEN = 256
EPS = 1e-6
RET_HEADS = 4
RET_DK = 128
RET_DV = 256
CHUNK = 128
ROPE_BASE = 10000.0
Q_W = RET_HEADS * RET_DK
V_W = RET_HEADS * RET_DV
LRU_WIDTH = 1024
LRU_BLOCKS = 8
LRU_BLOCK = LRU_WIDTH // LRU_BLOCKS
CONV_W = 4
LRU_C = 8.0
IN_W = 2 * Q_W + 2 * V_W + 2 * LRU_WIDTH
N_BRANCH = 2
D_FF = 2816
X_HEADS = 4
X_HD = D_MODEL // X_HEADS

kernel_name = "hybrid_retention_rglru_macaron_xattn"


def rmsnorm(x, g):
    xf = x.astype(jnp.float32)
    y = xf * lax.rsqrt(jnp.mean(xf * xf, axis=-1, keepdims=True) + EPS)
    return (y * g.astype(jnp.float32)).astype(x.dtype)


def swiglu(h, w1, w3, w2):
    return (jax.nn.silu(h @ w1) * (h @ w3)) @ w2


def rotary(t, pos):
    dk = t.shape[-1]
    inv_freq = ROPE_BASE ** (-jnp.arange(0, dk, 2, dtype=jnp.float32) / dk)
    ang = pos[:, None] * inv_freq[None, :]
    cos = jnp.cos(ang)[None, :, None, :]
    sin = jnp.sin(ang)[None, :, None, :]
    t1, t2 = t[..., : dk // 2], t[..., dk // 2:]
    return jnp.concatenate([t1 * cos - t2 * sin, t2 * cos + t1 * sin], axis=-1)


def retention_chunkwise(q, k, v):
    B, S, H, dk = q.shape
    dv = v.shape[-1]
    nC = S // CHUNK
    log_gamma = jnp.log(1.0 - 2.0 ** (-5.0 - jnp.arange(H, dtype=jnp.float32)))
    q = q.reshape(B, nC, CHUNK, H, dk)
    k = k.reshape(B, nC, CHUNK, H, dk) * (dk ** -0.5)
    v = v.reshape(B, nC, CHUNK, H, dv)
    pos = jnp.arange(CHUNK, dtype=jnp.float32)
    rel = pos[:, None] - pos[None, :]
    decay = jnp.where(rel[None] >= 0, jnp.exp(rel[None] * log_gamma[:, None, None]), 0.0)
    scores = jnp.einsum('bnihd,bnjhd->bnhij', q, k) * decay[None, None]
    inner = jnp.einsum('bnhij,bnjhe->bnihe', scores, v)
    k_decay = jnp.exp((CHUNK - 1.0 - pos)[None, :] * log_gamma[:, None])
    kv = jnp.einsum('bnjhd,bnjhe,hj->nbhde', k, v, k_decay)
    chunk_decay = jnp.exp(CHUNK * log_gamma)[None, :, None, None]

    def step(state, kv_c):
        return chunk_decay * state + kv_c, state

    init = jnp.zeros((B, H, dk, dv), jnp.float32)
    _, prev = lax.scan(step, init, kv)
    prev = jnp.moveaxis(prev, 0, 1)
    q_decay = jnp.exp((pos + 1.0)[:, None] * log_gamma[None, :])
    cross = jnp.einsum('bnihd,bnhde->bnihe', q, prev) * q_decay[None, None, :, :, None]
    return (inner + cross).reshape(B, S, H, dv)


def head_groupnorm(y, g):
    mu = jnp.mean(y, axis=-1, keepdims=True)
    var = jnp.mean(jnp.square(y - mu), axis=-1, keepdims=True)
    yn = (y - mu) * lax.rsqrt(var + EPS)
    B, S, H, dv = y.shape
    return yn.reshape(B, S, H * dv) * g.astype(jnp.float32)


def causal_depthwise_conv(x, w, b):
    S = x.shape[1]
    xp = jnp.pad(x, ((0, 0), (CONV_W - 1, 0), (0, 0)))
    y = xp[:, 0:S] * w[0]
    for tap in range(1, CONV_W):
        y = y + xp[:, tap:tap + S] * w[tap]
    return y + b


def rg_lru(x, w_r, b_r, w_i, b_i, lam):
    B, S, W = x.shape
    xb = x.reshape(B, S, LRU_BLOCKS, LRU_BLOCK)
    r = jax.nn.sigmoid(jnp.einsum('bsgi,gij->bsgj', xb, w_r).reshape(B, S, W) + b_r)
    i = jax.nn.sigmoid(jnp.einsum('bsgi,gij->bsgj', xb, w_i).reshape(B, S, W) + b_i)
    log_a = -LRU_C * r * jax.nn.softplus(-lam)
    a = jnp.exp(log_a)
    mult = jnp.sqrt(-jnp.expm1(2.0 * log_a))
    bx = mult * (i * x)

    def combine(c1, c2):
        a1, b1 = c1
        a2, b2 = c2
        return a1 * a2, a2 * b1 + b2

    _, h = lax.associative_scan(combine, (a, bx), axis=1)
    return h


def setup_inputs(seed: int = 0) -> dict:
    key = jax.random.key(seed)
    ks = iter(jax.random.split(key, 64))

    def nrm(shape, scale):
        return jax.random.normal(next(ks), shape, jnp.float32) * scale

    def gain(shape):
        return 1.0 + nrm(shape, 0.02)

    L, D = DEPTH, D_MODEL
    lam_a = jax.random.uniform(next(ks), (L, LRU_WIDTH), jnp.float32, 0.9, 0.999)
    return {
        "x": nrm((BATCH, SEQ, D), 1.0),
        "mem": nrm((BATCH, MEM_LEN, D), 1.0),
        "ffn1_norm": gain((L, D)),
        "ffn1_w1": nrm((L, D, D_FF), D ** -0.5),
        "ffn1_w3": nrm((L, D, D_FF), D ** -0.5),
        "ffn1_w2": nrm((L, D_FF, D), D_FF ** -0.5),
        "mix_norm": gain((L, D)),
        "w_in": nrm((L, D, IN_W), D ** -0.5),
        "ret_gn": gain((L, V_W)),
        "w_ret_o": nrm((L, V_W, D), V_W ** -0.5),
        "conv_w": nrm((L, CONV_W, LRU_WIDTH), CONV_W ** -0.5),
        "conv_b": nrm((L, LRU_WIDTH), 0.01),
        "w_rgate": nrm((L, LRU_BLOCKS, LRU_BLOCK, LRU_BLOCK), LRU_BLOCK ** -0.5),
        "b_rgate": nrm((L, LRU_WIDTH), 0.01),
        "w_igate": nrm((L, LRU_BLOCKS, LRU_BLOCK, LRU_BLOCK), LRU_BLOCK ** -0.5),
        "b_igate": nrm((L, LRU_WIDTH), 0.01),
        "lru_lambda": jnp.log(lam_a) - jnp.log1p(-lam_a),
        "w_lru_o": nrm((L, LRU_WIDTH, D), LRU_WIDTH ** -0.5),
        "w_branch_gate": nrm((L, D, N_BRANCH * D), D ** -0.5),
        "b_branch_gate": nrm((L, N_BRANCH * D), 0.01),
        "w_out": nrm((L, D, D), D ** -0.5),
        "xattn_norm": gain((L, D)),
        "mem_norm": gain((L, D)),
        "w_xq": nrm((L, D, D), D ** -0.5),
        "w_xk": nrm((L, D, D), D ** -0.5),
        "w_xv": nrm((L, D, D), D ** -0.5),
        "w_xo": nrm((L, D, D), D ** -0.5),
        "ffn2_norm": gain((L, D)),
        "ffn2_w1": nrm((L, D, D_FF), D ** -0.5),
        "ffn2_w3": nrm((L, D, D_FF), D ** -0.5),
        "ffn2_w2": nrm((L, D_FF, D), D_FF ** -0.5),
        "final_norm": gain((D,)),
    }


def reference(x, mem, ffn1_norm, ffn1_w1, ffn1_w3, ffn1_w2, mix_norm, w_in, ret_gn, w_ret_o,
              conv_w, conv_b, w_rgate, b_rgate, w_igate, b_igate, lru_lambda, w_lru_o,
              w_branch_gate, b_branch_gate, w_out, xattn_norm, mem_norm, w_xq, w_xk, w_xv, w_xo,
              ffn2_norm, ffn2_w1, ffn2_w3, ffn2_w2, final_norm):
    B, S, D = x.shape
    M = mem.shape[1]
    pos = jnp.arange(S, dtype=jnp.float32)
    for l in range(DEPTH):
        x = x + 0.5 * swiglu(rmsnorm(x, ffn1_norm[l]), ffn1_w1[l], ffn1_w3[l], ffn1_w2[l])

        h = rmsnorm(x, mix_norm[l])
        u = h @ w_in[l]
        o1 = Q_W
        o2 = o1 + Q_W
        o3 = o2 + V_W
        o4 = o3 + V_W
        o5 = o4 + LRU_WIDTH
        q = u[..., :o1].reshape(B, S, RET_HEADS, RET_DK).astype(jnp.float32)
        k = u[..., o1:o2].reshape(B, S, RET_HEADS, RET_DK).astype(jnp.float32)
        v = u[..., o2:o3].reshape(B, S, RET_HEADS, RET_DV).astype(jnp.float32)
        g_ret = u[..., o3:o4]
        x_lru = u[..., o4:o5]
        g_lru = u[..., o5:]

        ret = retention_chunkwise(rotary(q, pos), rotary(k, pos), v)
        ret = head_groupnorm(ret, ret_gn[l])
        y_ret = (jax.nn.silu(g_ret.astype(jnp.float32)) * ret).astype(x.dtype) @ w_ret_o[l]

        xc = causal_depthwise_conv(x_lru, conv_w[l], conv_b[l]).astype(jnp.float32)
        hl = rg_lru(xc, w_rgate[l].astype(jnp.float32), b_rgate[l].astype(jnp.float32),
                    w_igate[l].astype(jnp.float32), b_igate[l].astype(jnp.float32),
                    lru_lambda[l].astype(jnp.float32))
        y_lru = (hl * jax.nn.gelu(g_lru.astype(jnp.float32))).astype(x.dtype) @ w_lru_o[l]

        gates = jax.nn.sigmoid(h @ w_branch_gate[l] + b_branch_gate[l])
        merged = gates[..., :D] * y_ret + gates[..., D:] * y_lru
        x = x + merged @ w_out[l]

        hq = rmsnorm(x, xattn_norm[l])
        m = rmsnorm(mem, mem_norm[l])
        xq = (hq @ w_xq[l]).reshape(B, S, X_HEADS, X_HD)
        xk = (m @ w_xk[l]).reshape(B, M, X_HEADS, X_HD)
        xv = (m @ w_xv[l]).reshape(B, M, X_HEADS, X_HD)
        sc = jnp.einsum('bshd,bmhd->bhsm', xq.astype(jnp.float32), xk.astype(jnp.float32)) * (X_HD ** -0.5)
        p = jax.nn.softmax(sc, axis=-1)
        xo = jnp.einsum('bhsm,bmhd->bshd', p, xv.astype(jnp.float32)).reshape(B, S, D).astype(x.dtype)
        x = x + xo @ w_xo[l]

        x = x + 0.5 * swiglu(rmsnorm(x, ffn2_norm[l]), ffn2_w1[l], ffn2_w3[l], ffn2_w2[l])
    return rmsnorm(x, final_norm)
```

```cpp
#include <hip/hip_runtime.h>
#include <hip/hip_cooperative_groups.h>
#include <cstdio>
namespace cg = cooperative_groups;

#define LAS __attribute__((address_space(3)))
typedef unsigned short bf16_t;
typedef short bf16x8 __attribute__((ext_vector_type(8)));
typedef short s16x4 __attribute__((ext_vector_type(4)));
typedef float f32x4 __attribute__((ext_vector_type(4)));
typedef unsigned u32x4 __attribute__((ext_vector_type(4)));
typedef unsigned u32x2 __attribute__((ext_vector_type(2)));

constexpr int T_TOK = 16384, DM = 1024, SEQ = 2048, NB = 8, DFF = 2816, MEMT = 2048;
constexpr float EPS = 1e-6f;
constexpr int LDS_BYTES = 140 * 1024;

constexpr size_t MiB = 1024 * 1024;
constexpr size_t W_13A = 0;
constexpr size_t W_2A = W_13A + (size_t)5632 * 1024 * 2;
constexpr size_t W_IN = W_2A + (size_t)1024 * 2816 * 2;
constexpr size_t W_GG = W_IN + (size_t)4096 * 1024 * 2;
constexpr size_t W_RO = W_GG + (size_t)3072 * 1024 * 2;
constexpr size_t W_LO = W_RO + (size_t)1024 * 1024 * 2;
constexpr size_t W_OUT = W_LO + (size_t)1024 * 1024 * 2;
constexpr size_t W_XQ = W_OUT + (size_t)1024 * 1024 * 2;
constexpr size_t W_XKV = W_XQ + (size_t)1024 * 1024 * 2;
constexpr size_t W_XO = W_XKV + (size_t)2048 * 1024 * 2;
constexpr size_t W_13B = W_XO + (size_t)1024 * 1024 * 2;
constexpr size_t W_2B = W_13B + (size_t)5632 * 1024 * 2;
constexpr size_t W_LRU = W_2B + (size_t)1024 * 2816 * 2;
constexpr size_t W_END = W_LRU + (size_t)2 * 1024 * 128 * 2;
static_assert(W_END <= 62 * MiB, "weights");
constexpr size_t S_SS = 62 * MiB;
constexpr size_t S_SSM = S_SS + 5 * 65536;
constexpr size_t S_STATS = S_SSM + 8192;
constexpr size_t S_COS = S_STATS + 524288;
constexpr size_t S_SIN = S_COS + 524288;
constexpr size_t S_BAR = S_SIN + 524288;
static_assert(S_BAR + 16384 <= 64 * MiB && S_BAR % 256 == 0, "small");
constexpr size_t A_MB = 64 * MiB;
constexpr size_t A_XKV = 68 * MiB;
constexpr size_t A_B0 = 76 * MiB, A_B1 = 108 * MiB, A_B2 = 140 * MiB, A_B3 = 172 * MiB, A_B4 = 204 * MiB;
constexpr size_t WS_NEED = 236 * MiB;

struct Params { const float* in[32]; float* out; unsigned char* ws; int ph_lo, ph_hi; };

typedef float f32x2v __attribute__((ext_vector_type(2)));
typedef __bf16 bf16x2v __attribute__((ext_vector_type(2)));
__device__ __forceinline__ unsigned cvt_pk_bf16(float lo, float hi) { const f32x2v v = {lo, hi}; return __builtin_bit_cast(unsigned, __builtin_convertvector(v, bf16x2v)); }
__device__ __forceinline__ float bflo(unsigned w) { return __uint_as_float(w << 16); }
__device__ __forceinline__ float bfhi(unsigned w) { return __uint_as_float(w & 0xffff0000u); }
__device__ __forceinline__ float bf2f(bf16_t b) { return __uint_as_float((unsigned)b << 16); }
__device__ __forceinline__ u32x4 pack8(const float* o) { u32x4 w; w.x = cvt_pk_bf16(o[0], o[1]); w.y = cvt_pk_bf16(o[2], o[3]); w.z = cvt_pk_bf16(o[4], o[5]); w.w = cvt_pk_bf16(o[6], o[7]); return w; }
__device__ __forceinline__ void unpack8(u32x4 w, float* o) { o[0] = bflo(w.x); o[1] = bfhi(w.x); o[2] = bflo(w.y); o[3] = bfhi(w.y); o[4] = bflo(w.z); o[5] = bfhi(w.z); o[6] = bflo(w.w); o[7] = bfhi(w.w); }
__device__ __forceinline__ float sigmoidf_(float x) { return __builtin_amdgcn_rcpf(1.0f + __expf(-x)); }
__device__ __forceinline__ void sigmoid2(float x0, float x1, float& s0, float& s1) {
    const float d0 = 1.0f + __expf(-fmaxf(x0, -40.f)), d1 = 1.0f + __expf(-fmaxf(x1, -40.f)); const float r = __builtin_amdgcn_rcpf(d0 * d1); s0 = r * d1; s1 = r * d0; }
__device__ __forceinline__ float rs_of(float ss) { return rsqrtf(ss * (1.0f / 1024.0f) + EPS); }
__device__ __forceinline__ void lds_barrier() { asm volatile("s_waitcnt lgkmcnt(0)" ::: "memory"); __builtin_amdgcn_s_barrier(); asm volatile("" ::: "memory"); }

namespace pg8 {
constexpr int BM = 256, BK = 64, HALF = 128, HTB = HALF * BK * 2, STAGE_BYTES = 8 * HTB, NXCD = 8, WGM = 8;
__host__ __device__ __forceinline__ int lds_byte(int r, int c) { const int st = (r >> 4) * 2 + (c >> 5), rr = r & 15, cc = c & 31, ob = rr * 64 + cc * 2; return st * 1024 + (ob ^ (((ob >> 9) & 1) << 5)); }
__host__ __device__ __forceinline__ void stage_rc(int b, int& R, int& C) { const int st = b / 1024, sb = b % 1024, swz = sb ^ (((sb >> 9) & 1) << 5); R = (st >> 1) * 16 + swz / 64; C = (st & 1) * 32 + (swz % 64) / 2; }
__host__ __device__ __forceinline__ int perm32(int rho) { const int n = rho >> 4, i = rho & 15; return 8 * (i >> 2) + 4 * n + (i & 3); }
struct Unit { int pm, pn; };
struct Gemm { const bf16_t* A; const bf16_t* Bt; int M, N, K, lda, ldb; };
struct StaticOrder {
    int nM, nN, nwg, G, c;
    __device__ __forceinline__ void init(int M, int N, int G_, int c_) { nM = M / BM; nN = N / BM; nwg = nM * nN; G = G_; c = c_; }
    __device__ __forceinline__ bool next(int i, Unit& u) const {
        const long L = (long)i * G + c; if (L >= nwg) return false;
        int wgid = (int)L; { const int q = nwg / NXCD, r = nwg % NXCD, xcd = wgid % NXCD, off = wgid / NXCD; wgid = (xcd < r ? xcd * (q + 1) : r * (q + 1) + (xcd - r) * q) + off; }
        const int nig = WGM * nN, gid = wgid / nig, fm = gid * WGM, gsz = (nM - fm) < WGM ? (nM - fm) : WGM;
        u.pm = fm + ((wgid % nig) % gsz); u.pn = (wgid % nig) / gsz; return true;
    }
};
template <class Epi>
__device__ __forceinline__ void gemm_phase(LAS unsigned char* lds, const Gemm g, const StaticOrder& S, const Epi& E) {
    const int tid = threadIdx.x, wid = __builtin_amdgcn_readfirstlane(tid >> 6), lane = tid & 63, wr = wid >> 2, wc = wid & 3, fr = lane & 15, fq = lane >> 4;
    const int K = g.K, nt = K / BK;
    unsigned voffA[2], voffB[2];
#pragma unroll
    for (int i = 0; i < 2; ++i) { int R, C; stage_rc(tid * 16 + i * 8192, R, C); const int Rb = Epi::PERM ? ((R & ~31) + perm32(R & 31)) : R;
        voffA[i] = (unsigned)(R * g.lda + C) * 2u; voffB[i] = (unsigned)(Rb * g.ldb + C) * 2u; }
    const size_t kstep = (size_t)(BK * 2);
    const size_t hstepA = (size_t)HALF * g.lda * 2, hstepB = (size_t)HALF * g.ldb * 2;
    const size_t tstepA = 2 * hstepA, tstepB = 2 * hstepB;
    const unsigned ldsw = (unsigned)wid * 1024u;
    const int aoff = lds_byte(wr * 64 + fr, fq * 8), boff = lds_byte(wc * 32 + fr, fq * 8);
#define PG8_SA(b, h) (((b) * 2 + (h)) * HTB)
#define PG8_SB(b, h) ((4 + (b) * 2 + (h)) * HTB)
#define PG8_STAGE(bufoff, gbase, voff) do { _Pragma("unroll") for (int _i = 0; _i < 2; ++_i) \
        __builtin_amdgcn_global_load_lds((const unsigned*)((const char*)(gbase) + (voff)[_i]), (LAS unsigned*)(lds + (bufoff) + ldsw + _i * 8192), 16, 0, 0); } while (0)
#define PG8_LDA(dst, b, h) do { _Pragma("unroll") for (int m = 0; m < 4; ++m) _Pragma("unroll") for (int k = 0; k < 2; ++k) dst[m][k] = *(const LAS bf16x8*)(lds + PG8_SA(b, h) + aoff + m * 2048 + k * 1024); } while (0)
#define PG8_LDB(dst, b, h) do { _Pragma("unroll") for (int n = 0; n < 2; ++n) _Pragma("unroll") for (int k = 0; k < 2; ++k) dst[n][k] = *(const LAS bf16x8*)(lds + PG8_SB(b, h) + boff + n * 2048 + k * 1024); } while (0)
#define PG8_MMA(ai, bj, At, Bt) do { __builtin_amdgcn_s_setprio(1); _Pragma("unroll") for (int m = 0; m < 4; ++m) _Pragma("unroll") for (int n = 0; n < 2; ++n) _Pragma("unroll") for (int k = 0; k < 2; ++k) \
        acc[ai][bj][m][n] = __builtin_amdgcn_mfma_f32_16x16x32_bf16(Bt[n][k], At[m][k], acc[ai][bj][m][n], 0, 0, 0); __builtin_amdgcn_s_setprio(0); } while (0)
#define PG8_WAIT_V(n) asm volatile("s_waitcnt vmcnt(" #n ")" ::: "memory")
#define PG8_WAIT_L(n) asm volatile("s_waitcnt lgkmcnt(" #n ")" ::: "memory")
#define PG8_BAR __builtin_amdgcn_s_barrier()
#define PG8_SCHED __builtin_amdgcn_sched_barrier(0)
    Unit cur, nxt; int ui = 0;
    if (!S.next(0, cur)) return;
    f32x4 acc[2][2][4][2];
#pragma unroll
    for (int a = 0; a < 2; ++a)
#pragma unroll
        for (int b = 0; b < 2; ++b)
#pragma unroll
            for (int m = 0; m < 4; ++m)
#pragma unroll
                for (int n = 0; n < 2; ++n) acc[a][b][m][n] = (f32x4){0.f, 0.f, 0.f, 0.f};
    bf16x8 At[4][2], B0[2][2], B1[2][2];
    const char* cA = (const char*)g.A + (size_t)cur.pm * tstepA; const char* cB = (const char*)g.Bt + (size_t)cur.pn * tstepB;
    PG8_STAGE(PG8_SB(0, 0), cB, voffB); PG8_STAGE(PG8_SA(0, 0), cA, voffA); PG8_STAGE(PG8_SB(0, 1), cB + hstepB, voffB); PG8_STAGE(PG8_SA(0, 1), cA + hstepA, voffA);
    if (wr == 1) PG8_BAR;
    PG8_WAIT_V(4); PG8_BAR;
    PG8_STAGE(PG8_SB(1, 0), cB + kstep, voffB); PG8_STAGE(PG8_SA(1, 0), cA + kstep, voffA); PG8_STAGE(PG8_SB(1, 1), cB + hstepB + kstep, voffB);
    PG8_WAIT_V(6); PG8_BAR;
    for (;;) {
        const bool has_next = S.next(ui + 1, nxt);
        const char* nA = has_next ? (const char*)g.A + (size_t)nxt.pm * tstepA : cA; const char* nB = has_next ? (const char*)g.Bt + (size_t)nxt.pn * tstepB : cB;
        for (int t = 0; t < nt; t += 2) {
            const bool last = (t == nt - 2);
            const char* a1 = cA + (size_t)(t + 1) * kstep;
            const char* a2 = last ? nA : cA + (size_t)(t + 2) * kstep; const char* b2 = last ? nB : cB + (size_t)(t + 2) * kstep;
            const char* a3 = a2 + kstep; const char* b3 = b2 + kstep;
            PG8_LDB(B0, 0, 0); PG8_SCHED; PG8_LDA(At, 0, 0); PG8_STAGE(PG8_SA(1, 1), a1 + hstepA, voffA);
            PG8_WAIT_L(8); PG8_BAR; PG8_WAIT_L(0); PG8_MMA(0, 0, At, B0); PG8_BAR; PG8_SCHED;
            PG8_LDB(B1, 0, 1); PG8_STAGE(PG8_SB(0, 0), b2, voffB);
            PG8_BAR; PG8_WAIT_L(0); PG8_MMA(0, 1, At, B1); PG8_BAR;
            PG8_LDA(At, 0, 1); PG8_STAGE(PG8_SA(0, 0), a2, voffA);
            PG8_BAR; PG8_WAIT_L(0); PG8_MMA(1, 0, At, B0); PG8_BAR; PG8_SCHED;
            PG8_STAGE(PG8_SB(0, 1), b2 + hstepB, voffB);
            PG8_WAIT_V(6); PG8_BAR; PG8_MMA(1, 1, At, B1); PG8_BAR;
            PG8_LDB(B0, 1, 0); PG8_SCHED; PG8_LDA(At, 1, 0); PG8_STAGE(PG8_SA(0, 1), a2 + hstepA, voffA);
            PG8_WAIT_L(8); PG8_BAR; PG8_WAIT_L(0); PG8_MMA(0, 0, At, B0); PG8_BAR; PG8_SCHED;
            PG8_LDB(B1, 1, 1); PG8_STAGE(PG8_SB(1, 0), b3, voffB);
            PG8_BAR; PG8_WAIT_L(0); PG8_MMA(0, 1, At, B1); PG8_BAR;
            PG8_LDA(At, 1, 1); PG8_STAGE(PG8_SA(1, 0), a3, voffA);
            PG8_BAR; PG8_WAIT_L(0); PG8_MMA(1, 0, At, B0); PG8_BAR; PG8_SCHED;
            PG8_STAGE(PG8_SB(1, 1), b3 + hstepB, voffB);
            PG8_WAIT_V(6); PG8_BAR; PG8_MMA(1, 1, At, B1); PG8_BAR;
        }
        if constexpr (!Epi::AFTER_DRAIN) E(acc, cur, wr, wc, fr, fq);
        if (!has_next) break;
#pragma unroll
        for (int a = 0; a < 2; ++a)
#pragma unroll
            for (int b = 0; b < 2; ++b)
#pragma unroll
                for (int m = 0; m < 4; ++m)
#pragma unroll
                    for (int n = 0; n < 2; ++n) acc[a][b][m][n] = (f32x4){0.f, 0.f, 0.f, 0.f};
        cur = nxt; cA = nA; cB = nB; ++ui;
    }
    PG8_WAIT_V(0);
    if (wr == 0) PG8_BAR;
    PG8_BAR;
    if constexpr (Epi::AFTER_DRAIN) E.fused(acc, cur, wr, wc, fr, fq);
#undef PG8_SA
#undef PG8_SB
#undef PG8_STAGE
#undef PG8_LDA
#undef PG8_LDB
#undef PG8_MMA
#undef PG8_WAIT_V
#undef PG8_WAIT_L
#undef PG8_BAR
#undef PG8_SCHED
}
}
using pg8::Unit;
typedef f32x4 AccT[2][2][4][2];

#define XB_TMO      128
#define XB_XCNT(j)  (256  + 64 * (j))
#define XB_XSUB(j)  (1280 + 64 * (j))
#define XB_XGEN(j)  (2304 + 64 * (j))
#define XB_TOP      3328
#define XB_TOPGEN   3392
#define XCD_BAR_WORDS 3456
#define XB_SPIN_CAP (1u << 18)

__device__ __forceinline__ unsigned xb_ld(unsigned* p)              { return __hip_atomic_load(p, __ATOMIC_RELAXED, __HIP_MEMORY_SCOPE_AGENT); }
__device__ __forceinline__ unsigned xb_add(unsigned* p, unsigned v) { return __hip_atomic_fetch_add(p, v, __ATOMIC_RELAXED, __HIP_MEMORY_SCOPE_AGENT); }
__device__ __forceinline__ unsigned xb_xcc_id() { return (unsigned)__builtin_amdgcn_s_getreg((3 << 11) | 20) & 0xFu; }
#define XB_SPIN(cond, bar) do { unsigned _sp = 0; while (cond) { __builtin_amdgcn_s_sleep(1); \
    if ((++_sp & 255u) == 0u) { if (xb_ld(&(bar)[XB_TMO])) break; if (_sp > XB_SPIN_CAP) { atomicAdd(&(bar)[XB_TMO], 1u); break; } } } } while (0)

struct XcdBarrier {
    unsigned* bar; unsigned x;
    volatile LAS unsigned* st;
};

__device__ __forceinline__ XcdBarrier xcd_barrier_post(unsigned* bar, volatile LAS unsigned* st) {
    XcdBarrier b; b.bar = bar; b.x = xb_xcc_id(); b.st = st;
    if (threadIdx.x == 0) (void)xb_add(&bar[XB_XCNT(b.x)], 1u);
    return b;
}
__device__ __forceinline__ void xcd_barrier_complete(unsigned* bar, unsigned x, unsigned& nloc, unsigned& nx) {
    const unsigned G = gridDim.x * gridDim.y * gridDim.z;
    unsigned sum, cnt, mine, sp = 0u;
    for (;;) {
        sum = 0u; cnt = 0u; mine = 0u;
#pragma unroll
        for (unsigned j = 0; j < 16; ++j) { const unsigned c = xb_ld(&bar[XB_XCNT(j)]); sum += c; cnt += (c > 0u) ? 1u : 0u; mine = (j == x) ? c : mine; }
        if (sum == G) break;
        __builtin_amdgcn_s_sleep(1);
        if ((++sp & 255u) == 0u) { if (xb_ld(&bar[XB_TMO])) break; if (sp > XB_SPIN_CAP) { atomicAdd(&bar[XB_TMO], 1u); break; } }
    }
    nloc = mine > 0u ? mine : 1u; nx = cnt > 0u ? cnt : 1u;
}

__device__ __forceinline__ void xcd_barrier(const XcdBarrier& b) {
    asm volatile("s_waitcnt vmcnt(0)" ::: "memory");
    __syncthreads();
    if (threadIdx.x == 0) {
        unsigned* bar = b.bar;
        __builtin_amdgcn_s_waitcnt(0);
        unsigned nloc = b.st[0], nx = b.st[1];
        if (nloc == 0u) { xcd_barrier_complete(bar, b.x, nloc, nx); b.st[0] = nloc; b.st[1] = nx; }
        const unsigned old = xb_add(&bar[XB_XSUB(b.x)], 1u);
        const unsigned gen = old / nloc;
        if (old + 1u == (gen + 1u) * nloc) {
            __builtin_amdgcn_fence(__ATOMIC_RELEASE, "agent");
            asm volatile("s_waitcnt vmcnt(0)" ::: "memory");
            const unsigned og = xb_add(&bar[XB_TOP], 1u);
            const unsigned tg = og / nx;
            if (og + 1u == (tg + 1u) * nx) xb_add(&bar[XB_TOPGEN], 1u);
            else XB_SPIN(xb_ld(&bar[XB_TOPGEN]) == tg, bar);
            __builtin_amdgcn_fence(__ATOMIC_ACQUIRE, "agent");
            xb_add(&bar[XB_XGEN(b.x)], 1u);
            asm volatile("s_waitcnt vmcnt(0)" ::: "memory");
        } else {
            XB_SPIN(xb_ld(&bar[XB_XGEN(b.x)]) == gen, bar);
            __builtin_amdgcn_fence(__ATOMIC_ACQUIRE, "agent");
            asm volatile("s_waitcnt vmcnt(0)" ::: "memory");
        }
    }
    __syncthreads();
}


struct EpiSwiglu {
    static constexpr bool PERM = true, AFTER_DRAIN = false;
    bf16_t* G; const float* ss;
    __device__ __forceinline__ void operator()(const AccT& acc, const Unit& u, int wr, int wc, int fr, int fq) const {
        const int row0 = u.pm * 256 + wr * 64 + fr, col0 = u.pn * 128 + wc * 32 + 8 * fq;
#pragma unroll
        for (int ai = 0; ai < 2; ++ai)
#pragma unroll
            for (int m = 0; m < 4; ++m) {
                const int row = row0 + ai * 128 + m * 16; const float rs = rs_of(ss[row]); float o[8];
#pragma unroll
                for (int n = 0; n < 2; ++n)
#pragma unroll
                    for (int j = 0; j < 4; j += 2) {
                        const float a1 = acc[ai][0][m][n][j] * rs, b1 = acc[ai][0][m][n][j + 1] * rs;
                        const float d0 = 1.0f + __expf(-fmaxf(a1, -40.f)), d1 = 1.0f + __expf(-fmaxf(b1, -40.f));
                        const float r = __builtin_amdgcn_rcpf(d0 * d1);
                        o[4 * n + j] = a1 * (r * d1) * (acc[ai][1][m][n][j] * rs); o[4 * n + j + 1] = b1 * (r * d0) * (acc[ai][1][m][n][j + 1] * rs); }
                *(u32x4*)(G + (size_t)row * DFF + col0) = pack8(o);
            }
    }
};
template <bool WB> struct EpiResid {
    static constexpr bool PERM = true, AFTER_DRAIN = false;
    const float* base; float* X; bf16_t* Xb; float* ss; float scale;
    __device__ __forceinline__ void operator()(const AccT& acc, const Unit& u, int wr, int wc, int fr, int fq) const {
        const int row0 = u.pm * 256 + wr * 64 + fr, col0 = u.pn * 256 + wc * 32 + 8 * fq;
#pragma unroll
        for (int ai = 0; ai < 2; ++ai)
#pragma unroll
            for (int m = 0; m < 4; ++m) {
                const int row = row0 + ai * 128 + m * 16; float sq = 0.f;
#pragma unroll
                for (int bj = 0; bj < 2; ++bj) {
                    const size_t off = (size_t)row * DM + col0 + bj * 128;
                    const f32x4 b0 = *(const f32x4*)(base + off), b1 = *(const f32x4*)(base + off + 4);
                    const f32x4 v0 = b0 + scale * acc[ai][bj][m][0], v1 = b1 + scale * acc[ai][bj][m][1];
                    *(f32x4*)(X + off) = v0; *(f32x4*)(X + off + 4) = v1;
                    sq += (v0[0] * v0[0] + v0[1] * v0[1]) + (v0[2] * v0[2] + v0[3] * v0[3]) + (v1[0] * v1[0] + v1[1] * v1[1]) + (v1[2] * v1[2] + v1[3] * v1[3]);
                    if (WB) { u32x4 w; w.x = cvt_pk_bf16(v0[0], v0[1]); w.y = cvt_pk_bf16(v0[2], v0[3]); w.z = cvt_pk_bf16(v1[0], v1[1]); w.w = cvt_pk_bf16(v1[2], v1[3]); *(u32x4*)(Xb + off) = w; }
                }
                sq += __shfl_xor(sq, 16); sq += __shfl_xor(sq, 32);
                if (fq == 0) unsafeAtomicAdd(ss + row, sq);
            }
    }
};
struct EpiInproj {
    static constexpr bool PERM = true, AFTER_DRAIN = false;
    bf16_t *q, *xl; const float *ss, *cs, *sn;
    __device__ __forceinline__ void operator()(const AccT& acc, const Unit& u, int wr, int wc, int fr, int fq) const {
        const int row0 = u.pm * 256 + wr * 64 + fr, p0 = wc * 32 + 8 * fq, pn = u.pn;
        if (pn < 4) {
            bf16_t* dst = q + (size_t)(pn >> 1) * ((size_t)T_TOK * 512); const float sc = pn < 2 ? 1.0f : 0.08838834764831845f;
            const int head = 2 * (pn & 1) + (p0 >> 6), d0 = p0 & 63;
#pragma unroll
            for (int ai = 0; ai < 2; ++ai)
#pragma unroll
                for (int m = 0; m < 4; ++m) {
                    const int row = row0 + ai * 128 + m * 16; const float rs = rs_of(ss[row]) * sc; const int pos = row & (SEQ - 1);
                    const float* cp = cs + pos * 64 + d0; const float* sp = sn + pos * 64 + d0;
                    bf16_t* dp = dst + (size_t)row * 512 + head * 128 + d0;
#pragma unroll
                    for (int n = 0; n < 2; ++n) {
                        const f32x4 c = *(const f32x4*)(cp + 4 * n), s = *(const f32x4*)(sp + 4 * n);
                        const f32x4 t1 = acc[ai][0][m][n] * rs, t2 = acc[ai][1][m][n] * rs;
                        const f32x4 o1 = t1 * c - t2 * s, o2 = t2 * c + t1 * s;
                        u32x2 w1, w2; w1.x = cvt_pk_bf16(o1[0], o1[1]); w1.y = cvt_pk_bf16(o1[2], o1[3]); w2.x = cvt_pk_bf16(o2[0], o2[1]); w2.y = cvt_pk_bf16(o2[2], o2[3]);
                        *(u32x2*)(dp + 4 * n) = w1; *(u32x2*)(dp + 64 + 4 * n) = w2;
                    }
                    __builtin_amdgcn_sched_barrier(0);
                }
        } else {
            const int seg = (pn - 4) >> 2; bf16_t* dst = xl + (size_t)seg * ((size_t)T_TOK * DM); const int colb = ((pn - 4) & 3) * 256 + p0;
#pragma unroll
            for (int ai = 0; ai < 2; ++ai)
#pragma unroll
                for (int m = 0; m < 4; ++m) {
                    const int row = row0 + ai * 128 + m * 16; const float rs = rs_of(ss[row]);
#pragma unroll
                    for (int bj = 0; bj < 2; ++bj) {
                        float o[8];
#pragma unroll
                        for (int n = 0; n < 2; ++n)
#pragma unroll
                            for (int j = 0; j < 4; j += 2) { float a = acc[ai][bj][m][n][j] * rs, b = acc[ai][bj][m][n][j + 1] * rs;
                                if (seg == 2) { const float ua = 1.5957691216057308f * (a + 0.044715f * a * a * a), ub = 1.5957691216057308f * (b + 0.044715f * b * b * b);
                                    float sa, sb; sigmoid2(ua, ub, sa, sb); a *= sa; b *= sb; }
                                o[4 * n + j] = a; o[4 * n + j + 1] = b; }
                        *(u32x4*)(dst + (size_t)row * DM + colb + bj * 128) = pack8(o);
                    }
                }
        }
    }
};
struct EpiGG {
    static constexpr bool PERM = true, AFTER_DRAIN = false;
    bf16_t* aret; bf16_t* gates; const float *ss, *stats, *gn, *bg;
    __device__ __forceinline__ void operator()(const AccT& acc, const Unit& u, int wr, int wc, int fr, int fq) const {
        const int row0 = u.pm * 256 + wr * 64 + fr, p0 = wc * 32 + 8 * fq, pn = u.pn;
        if (pn < 4) {
#pragma unroll
            for (int ai = 0; ai < 2; ++ai)
#pragma unroll
                for (int m = 0; m < 4; ++m) {
                    const int row = row0 + ai * 128 + m * 16; const float rs = rs_of(ss[row]);
                    const float s1 = stats[((size_t)row * 4 + pn) * 2], s2 = stats[((size_t)row * 4 + pn) * 2 + 1];
                    const float mu = s1 * (1.0f / 256.0f); const float var = fmaxf(s2 * (1.0f / 256.0f) - mu * mu, 0.f); const float rstd = rsqrtf(var + EPS);
#pragma unroll
                    for (int bj = 0; bj < 2; ++bj) {
                        const int col = pn * 256 + bj * 128 + p0; bf16_t* rp = aret + (size_t)row * DM + col;
                        float r[8], o[8]; unpack8(*(const u32x4*)rp, r);
                        const f32x4 g0 = *(const f32x4*)(gn + col), g1 = *(const f32x4*)(gn + col + 4);
#pragma unroll
                        for (int n = 0; n < 2; ++n)
#pragma unroll
                            for (int j = 0; j < 4; j += 2) { const float a = acc[ai][bj][m][n][j] * rs, b = acc[ai][bj][m][n][j + 1] * rs; float sa, sb; sigmoid2(a, b, sa, sb);
                                o[4 * n + j] = a * sa * (n ? g1[j] : g0[j]) * (r[4 * n + j] - mu) * rstd; o[4 * n + j + 1] = b * sb * (n ? g1[j + 1] : g0[j + 1]) * (r[4 * n + j + 1] - mu) * rstd; }
                        *(u32x4*)rp = pack8(o);
                    }
                }
        } else {
#pragma unroll
            for (int ai = 0; ai < 2; ++ai)
#pragma unroll
                for (int m = 0; m < 4; ++m) {
                    const int row = row0 + ai * 128 + m * 16; const float rs = rs_of(ss[row]);
#pragma unroll
                    for (int bj = 0; bj < 2; ++bj) {
                        const int col = (pn - 4) * 256 + bj * 128 + p0; float o[8];
                        const f32x4 b0 = *(const f32x4*)(bg + col), b1 = *(const f32x4*)(bg + col + 4);
#pragma unroll
                        for (int n = 0; n < 2; ++n)
#pragma unroll
                            for (int j = 0; j < 4; j += 2) sigmoid2(acc[ai][bj][m][n][j] * rs + (n ? b1[j] : b0[j]), acc[ai][bj][m][n][j + 1] * rs + (n ? b1[j + 1] : b0[j + 1]), o[4 * n + j], o[4 * n + j + 1]);
                        *(u32x4*)(gates + (size_t)row * 2048 + col) = pack8(o);
                    }
                }
        }
    }
};
template <bool SECOND> struct EpiMerge {
    static constexpr bool PERM = true, AFTER_DRAIN = false;
    bf16_t* merged; const bf16_t* gates;
    __device__ __forceinline__ void operator()(const AccT& acc, const Unit& u, int wr, int wc, int fr, int fq) const {
        const int row0 = u.pm * 256 + wr * 64 + fr, col0 = u.pn * 256 + wc * 32 + 8 * fq;
#pragma unroll
        for (int ai = 0; ai < 2; ++ai)
#pragma unroll
            for (int m = 0; m < 4; ++m) {
                const int row = row0 + ai * 128 + m * 16;
#pragma unroll
                for (int bj = 0; bj < 2; ++bj) {
                    const int col = col0 + bj * 128; float g[8], o[8];
                    unpack8(*(const u32x4*)(gates + (size_t)row * 2048 + (SECOND ? 1024 : 0) + col), g);
                    bf16_t* mp = merged + (size_t)row * DM + col;
                    if (SECOND) unpack8(*(const u32x4*)mp, o);
#pragma unroll
                    for (int n = 0; n < 2; ++n)
#pragma unroll
                        for (int j = 0; j < 4; ++j) { const float t = g[4 * n + j] * acc[ai][bj][m][n][j]; o[4 * n + j] = SECOND ? o[4 * n + j] + t : t; }
                    *(u32x4*)mp = pack8(o);
                }
            }
    }
};
struct EpiScale {
    static constexpr bool PERM = true, AFTER_DRAIN = false;
    bf16_t* O; int ldc; const float* ss; float sc;
    __device__ __forceinline__ void operator()(const AccT& acc, const Unit& u, int wr, int wc, int fr, int fq) const {
        const int row0 = u.pm * 256 + wr * 64 + fr, col0 = u.pn * 256 + wc * 32 + 8 * fq;
#pragma unroll
        for (int ai = 0; ai < 2; ++ai)
#pragma unroll
            for (int m = 0; m < 4; ++m) {
                const int row = row0 + ai * 128 + m * 16; const float rs = rs_of(ss[row]) * sc;
#pragma unroll
                for (int bj = 0; bj < 2; ++bj) { float o[8];
#pragma unroll
                    for (int n = 0; n < 2; ++n)
#pragma unroll
                        for (int j = 0; j < 4; ++j) o[4 * n + j] = acc[ai][bj][m][n][j] * rs;
                    *(u32x4*)(O + (size_t)row * ldc + col0 + bj * 128) = pack8(o); }
            }
    }
};

struct EpiFinal {
    static constexpr bool PERM = true, AFTER_DRAIN = true;
    float* X; float* ss; const float* gfin; XcdBarrier xb;
    __device__ __forceinline__ void fused(AccT& acc, const Unit& u, int wr, int wc, int fr, int fq) const {
        const int row0 = u.pm * 256 + wr * 64 + fr, col0 = u.pn * 256 + wc * 32 + 8 * fq;
#pragma unroll
        for (int ai = 0; ai < 2; ++ai)
#pragma unroll
            for (int m = 0; m < 4; ++m) {
                const int row = row0 + ai * 128 + m * 16; float sq = 0.f;
#pragma unroll
                for (int bj = 0; bj < 2; ++bj) {
                    const size_t off = (size_t)row * DM + col0 + bj * 128;
                    const f32x4 v0 = *(const f32x4*)(X + off) + 0.5f * acc[ai][bj][m][0], v1 = *(const f32x4*)(X + off + 4) + 0.5f * acc[ai][bj][m][1];
                    acc[ai][bj][m][0] = v0; acc[ai][bj][m][1] = v1;
                    sq += (v0[0] * v0[0] + v0[1] * v0[1]) + (v0[2] * v0[2] + v0[3] * v0[3]) + (v1[0] * v1[0] + v1[1] * v1[1]) + (v1[2] * v1[2] + v1[3] * v1[3]);
                }
                sq += __shfl_xor(sq, 16); sq += __shfl_xor(sq, 32);
                if (fq == 0) unsafeAtomicAdd(ss + row, sq);
            }
        xcd_barrier(xb);
#pragma unroll
        for (int ai = 0; ai < 2; ++ai)
#pragma unroll
            for (int m = 0; m < 4; ++m) {
                const int row = row0 + ai * 128 + m * 16; const float rs = rs_of(ss[row]);
#pragma unroll
                for (int bj = 0; bj < 2; ++bj) {
                    const size_t off = (size_t)row * DM + col0 + bj * 128; const int col = col0 + bj * 128;
                    const f32x4 g0 = *(const f32x4*)(gfin + col), g1 = *(const f32x4*)(gfin + col + 4);
                    *(f32x4*)(X + off) = acc[ai][bj][m][0] * rs * g0; *(f32x4*)(X + off + 4) = acc[ai][bj][m][1] * rs * g1;
                }
            }
    }
};
struct RowSrc { const float* p; int ld; };
template <class F>
__device__ __forceinline__ void wprep(LAS unsigned char* lds, bf16_t* dst, int nrows, int K, const float* gain, F rowsrc, int b0 = (int)blockIdx.x, int nb = (int)gridDim.x) {
    LAS float* tile = (LAS float*)lds;
    const int tid = threadIdx.x, kk = tid >> 4, r4 = (tid & 15) * 4;
    const int ntk = K / 128, ntiles = (nrows / 64) * ntk;
    f32x4 cur[4], nxt[4];
    auto fetch = [&](int t, f32x4 (&v)[4]) {
        const int r0 = (t / ntk) * 64, k0 = (t % ntk) * 128; const RowSrc rs = rowsrc(r0 + r4);
#pragma unroll
        for (int it = 0; it < 4; ++it) { const int k = k0 + kk + 32 * it; f32x4 x = *(const f32x4*)(rs.p + (size_t)k * rs.ld); if (gain) x *= gain[k]; v[it] = x; }
    };
    int t = b0;
    if (t < ntiles) fetch(t, cur);
    for (; t < ntiles; t += nb) {
        const int tn = t + nb;
        if (tn < ntiles) fetch(tn, nxt);
        const int r0 = (t / ntk) * 64, k0 = (t % ntk) * 128;
        __syncthreads();
#pragma unroll
        for (int it = 0; it < 4; ++it)
#pragma unroll
            for (int j = 0; j < 4; ++j) tile[(r4 + j) * 129 + kk + 32 * it] = cur[it][j];
        __syncthreads();
        const int row = tid >> 3, ch = tid & 7;
#pragma unroll
        for (int hf = 0; hf < 2; ++hf) { float o[8];
#pragma unroll
            for (int j = 0; j < 8; ++j) o[j] = tile[row * 129 + hf * 64 + ch * 8 + j];
            *(u32x4*)(dst + (size_t)(r0 + row) * K + k0 + hf * 64 + ch * 8) = pack8(o); }
#pragma unroll
        for (int it = 0; it < 4; ++it) cur[it] = nxt[it];
    }
    __syncthreads();
}

__device__ __forceinline__ void rows_prep(const float* src, bf16_t* dst, float* ss, int nrows) {
    const int lane = threadIdx.x & 63, gw = blockIdx.x * 8 + (threadIdx.x >> 6), nw = gridDim.x * 8;
    for (int r = gw; r < nrows; r += nw) {
        const float* sp = src + (size_t)r * DM; float sq = 0.f;
#pragma unroll
        for (int i = 0; i < 2; ++i) {
            const int c = (i * 64 + lane) * 8;
            const f32x4 a = *(const f32x4*)(sp + c), b = *(const f32x4*)(sp + c + 4);
            sq += (a[0] * a[0] + a[1] * a[1]) + (a[2] * a[2] + a[3] * a[3]) + (b[0] * b[0] + b[1] * b[1]) + (b[2] * b[2] + b[3] * b[3]);
            u32x4 w; w.x = cvt_pk_bf16(a[0], a[1]); w.y = cvt_pk_bf16(a[2], a[3]); w.z = cvt_pk_bf16(b[0], b[1]); w.w = cvt_pk_bf16(b[2], b[3]);
            *(u32x4*)(dst + (size_t)r * DM + c) = w;
        }
#pragma unroll
        for (int o = 32; o >= 1; o >>= 1) sq += __shfl_xor(sq, o);
        if (lane == 0) ss[r] = sq;
    }
}

__device__ __forceinline__ bf16x8 tr_frag(LAS unsigned char* tile, int stride, int k0, int x0, int lane) {
    const int g = lane >> 4, ii = lane & 15, q = ii >> 2, p = ii & 3;
    LAS unsigned char* a = tile + (k0 + 8 * g + q) * stride + (x0 + 4 * p) * 2;
    const s16x4 lo = __builtin_amdgcn_ds_read_tr16_b64_v4i16((LAS s16x4*)a);
    const s16x4 hi = __builtin_amdgcn_ds_read_tr16_b64_v4i16((LAS s16x4*)(a + 4 * stride));
    bf16x8 r; r[0] = lo[0]; r[1] = lo[1]; r[2] = lo[2]; r[3] = lo[3]; r[4] = hi[0]; r[5] = hi[1]; r[6] = hi[2]; r[7] = hi[3]; return r;
}
__device__ __forceinline__ bf16x8 scale_frag(bf16x8 f, const float* s) {
    u32x4 w = __builtin_bit_cast(u32x4, f); float o[8]; unpack8(w, o);
#pragma unroll
    for (int j = 0; j < 8; ++j) o[j] *= s[j];
    return __builtin_bit_cast(bf16x8, pack8(o));
}

constexpr int R_KT = 0, R_KS = 272;
constexpr int R_VT = 128 * 272, R_VS = 144;
constexpr int R_SB = R_VT + 128 * 144;
constexpr int R_PW = R_SB + 128 * 144;
static_assert(R_PW + 8 * 16 * 272 <= LDS_BYTES, "ret lds");
__device__ __forceinline__ void retention_item(LAS unsigned char* lds, int item, const bf16_t* qb, const bf16_t* kb, bf16_t* vb  , float* stats) {
    int tid = threadIdx.x; asm volatile("" : "+v"(tid));
    const int wid = tid >> 6, lane = tid & 63, fr = lane & 15, fg = lane >> 4;
    const int widu = __builtin_amdgcn_readfirstlane(tid >> 6);
    const int b = item >> 4, h = (item >> 2) & 3, es = item & 3;
    const float l2g = __log2f(1.0f - exp2f(-5.0f - (float)h));
    const float cd = exp2f(128.0f * l2g);
    const size_t tok0 = (size_t)b * SEQ;
    LAS unsigned char* Pw = lds + R_PW + wid * (16 * 272);
    f32x4 st[4];
#pragma unroll
    for (int e = 0; e < 4; ++e) st[e] = (f32x4){0.f, 0.f, 0.f, 0.f};
    u32x4 kreg[4], vreg[2], qnext[4], qf[4];
    auto issue = [&](int n) {
        const size_t t0 = tok0 + (size_t)n * 128;
#pragma unroll
        for (int i = 0; i < 4; ++i) { const int c = tid + 512 * i, row = c >> 4, c16 = c & 15; kreg[i] = *(const u32x4*)(kb + (t0 + row) * 512 + h * 128 + c16 * 8); }
#pragma unroll
        for (int i = 0; i < 2; ++i) { const int c = tid + 512 * i, row = c >> 3, c8 = c & 7; vreg[i] = *(const u32x4*)(vb + (t0 + row) * DM + h * 256 + es * 64 + c8 * 8); }
#pragma unroll
        for (int s = 0; s < 4; ++s) qnext[s] = *(const u32x4*)(qb + (t0 + wid * 16 + fr) * 512 + h * 128 + s * 32 + fg * 8);
    };
    issue(0);
    const float qdec = exp2f((float)(wid * 16 + fr + 1) * l2g);
    for (int n = 0; n < 16; ++n) {
        float l2 = l2g; asm volatile("" : "+v"(l2));
        int irow = wid * 16 + fr, fgl = fg; asm volatile("" : "+v"(irow), "+v"(fgl));
        lds_barrier();
#pragma unroll
        for (int i = 0; i < 4; ++i) { const int c = tid + 512 * i, row = c >> 4, c16 = c & 15; *(LAS u32x4*)(lds + R_KT + row * R_KS + c16 * 16) = kreg[i]; }
#pragma unroll
        for (int i = 0; i < 2; ++i) { const int c = tid + 512 * i, row = c >> 3, c8 = c & 7; *(LAS u32x4*)(lds + R_VT + row * R_VS + c8 * 16) = vreg[i]; }
#pragma unroll
        for (int e = 0; e < 4; ++e) { u32x2 w; w.x = cvt_pk_bf16(st[e][0], st[e][1]); w.y = cvt_pk_bf16(st[e][2], st[e][3]);
            *(LAS u32x2*)(lds + R_SB + (wid * 16 + fr) * R_VS + (e * 16 + fg * 4) * 2) = w; }
#pragma unroll
        for (int s = 0; s < 4; ++s) qf[s] = qnext[s];
        if (n + 1 < 16) issue(n + 1);
        lds_barrier();
        {
#pragma unroll
            for (int jf = 0; jf < 8; ++jf) {
                if (jf > (widu | 1)) break;
                f32x4 sc = (f32x4){0.f, 0.f, 0.f, 0.f};
#pragma unroll
                for (int s = 0; s < 4; ++s) {
                    const bf16x8 a = *(const LAS bf16x8*)(lds + R_KT + (jf * 16 + fr) * R_KS + (s * 32 + fg * 8) * 2);
                    sc = __builtin_amdgcn_mfma_f32_16x16x32_bf16(a, __builtin_bit_cast(bf16x8, qf[s]), sc, 0, 0, 0);
                }
                float pv[4];
#pragma unroll
                for (int r = 0; r < 4; ++r) { const int j = jf * 16 + fgl * 4 + r; const int dlt = irow - j; pv[r] = dlt >= 0 ? sc[r] * __builtin_amdgcn_exp2f((float)dlt * l2) : 0.f; }
                u32x2 w; w.x = cvt_pk_bf16(pv[0], pv[1]); w.y = cvt_pk_bf16(pv[2], pv[3]);
                *(LAS u32x2*)(Pw + fr * 272 + (jf * 16 + fg * 4) * 2) = w;
                __builtin_amdgcn_sched_barrier(0);
            }
        }
        asm volatile("s_waitcnt lgkmcnt(0)" ::: "memory");
        {
            f32x4 o[4];
#pragma unroll
            for (int e = 0; e < 4; ++e) { o[e] = (f32x4){0.f, 0.f, 0.f, 0.f}; st[e] *= cd; }
#pragma unroll
            for (int s = 0; s < 4; ++s) {
                const bf16x8 pf = *(const LAS bf16x8*)(Pw + fr * 272 + (s * 32 + fg * 8) * 2);
                float kd[8];
#pragma unroll
                for (int j = 0; j < 8; ++j) kd[j] = __builtin_amdgcn_exp2f((float)(127 - (s * 32 + fgl * 8 + j)) * l2);
                const bf16x8 kf = scale_frag(tr_frag(lds + R_KT, R_KS, s * 32, wid * 16, lane), kd);
                float qs[8];
#pragma unroll
                for (int j = 0; j < 8; ++j) qs[j] = qdec;
                const bf16x8 qsf = scale_frag(__builtin_bit_cast(bf16x8, qf[s]), qs);
#pragma unroll
                for (int e = 0; e < 4; ++e) {
                    const bf16x8 vf = tr_frag(lds + R_VT, R_VS, s * 32, e * 16, lane);
                    if (s <= (widu >> 1)) o[e] = __builtin_amdgcn_mfma_f32_16x16x32_bf16(vf, pf, o[e], 0, 0, 0);
                    st[e] = __builtin_amdgcn_mfma_f32_16x16x32_bf16(vf, kf, st[e], 0, 0, 0);
                    const bf16x8 sf = tr_frag(lds + R_SB, R_VS, s * 32, e * 16, lane);
                    o[e] = __builtin_amdgcn_mfma_f32_16x16x32_bf16(sf, qsf, o[e], 0, 0, 0);
                }
                __builtin_amdgcn_sched_barrier(0);
            }
            const size_t tok = tok0 + (size_t)n * 128 + wid * 16 + fr;
            float s1 = 0.f, s2 = 0.f;
#pragma unroll
            for (int e = 0; e < 4; ++e) {
                u32x2 w; w.x = cvt_pk_bf16(o[e][0], o[e][1]); w.y = cvt_pk_bf16(o[e][2], o[e][3]);
                *(u32x2*)(vb + tok * DM + h * 256 + es * 64 + e * 16 + fg * 4) = w;
                s1 += (o[e][0] + o[e][1]) + (o[e][2] + o[e][3]);
                s2 += (o[e][0] * o[e][0] + o[e][1] * o[e][1]) + (o[e][2] * o[e][2] + o[e][3] * o[e][3]);
            }
            s1 += __shfl_xor(s1, 16); s1 += __shfl_xor(s1, 32); s2 += __shfl_xor(s2, 16); s2 += __shfl_xor(s2, 32);
            if (fg == 0) { unsafeAtomicAdd(stats + (tok * 4 + h) * 2, s1); unsafeAtomicAdd(stats + (tok * 4 + h) * 2 + 1, s2); }
        }
    }
    lds_barrier();
}

constexpr int L_XC = 0;
constexpr int L_WL = 128 * 272;
constexpr int L_SA = L_WL + 128 * 272;
constexpr int L_SBX = L_SA + 32768;
constexpr int L_SEGA = L_SBX + 32768;
constexpr int L_SEGB = L_SEGA + 2048;
constexpr int L_CARRY = L_SEGB + 2048;
constexpr int L_CW = L_CARRY + 512;
static_assert(L_CW + 5 * 512 <= LDS_BYTES - 16, "lru lds");
__device__ __forceinline__ void lru_item(LAS unsigned char* lds, int item, const bf16_t* xl, bf16_t* gg  , const bf16_t* wlru,
                                         const float* conv_w, const float* conv_b, const float* b_r, const float* b_i, const float* lam) {
    int tid = threadIdx.x; asm volatile("" : "+v"(tid));
    const int wid = tid >> 6, lane = tid & 63, fr = lane & 15, fg = lane >> 4;
    const int b = item >> 4, g = (item >> 1) & 7, hf2 = item & 1;
    const int chg = g * 128, c0 = chg + hf2 * 64;
    const size_t tok0 = (size_t)b * SEQ;
    for (int c = tid; c < 128 * 16; c += 512) { const int n = c >> 4, c16 = c & 15; const bf16_t* src = wlru + ((size_t)(n >> 6) * 1024 + c0 + (n & 63)) * 128 + c16 * 8;
        *(LAS u32x4*)(lds + L_WL + n * 272 + c16 * 16) = *(const u32x4*)src; }
    if (tid < 64) ((LAS float*)(lds + L_CARRY))[tid] = 0.f;
    const int ch8 = tid & 15;
    for (int c = tid; c < 5 * 128; c += 512) ((LAS float*)(lds + L_CW))[c] = c < 512 ? conv_w[(c >> 7) * DM + chg + (c & 127)] : conv_b[chg + (c & 127)];
    float br_[4], bi_[4], sp_[4];
#pragma unroll
    for (int hf = 0; hf < 4; ++hf) { const int ch = c0 + hf * 16 + fr; br_[hf] = b_r[ch]; bi_[hf] = b_i[ch]; sp_[hf] = log1pf(__expf(-lam[ch])); }
    u32x4 rwn[7];
    auto load_rows = [&](int T0n) {
        const int tk0 = (tid >> 4) * 4;
#pragma unroll
        for (int q = 0; q < 7; ++q) { const int ts = T0n + tk0 - 3 + q; rwn[q] = ts >= 0 ? *(const u32x4*)(xl + (tok0 + ts) * DM + chg + ch8 * 8) : (u32x4){0u, 0u, 0u, 0u}; }
    };
    load_rows(0);
    for (int tile = 0; tile < 16; ++tile) {
        const int T0 = tile * 128;
        bf16_t gpre[16];
#pragma unroll
        for (int t = 0; t < 16; ++t) gpre[t] = gg[(tok0 + T0 + wid * 16 + t) * DM + c0 + lane];
        {
            const int tk0 = (tid >> 4) * 4;
            float acc8[4][8], cw[4][8];
            { const f32x4 b0 = *(const LAS f32x4*)(lds + L_CW + 2048 + ch8 * 32), b1 = *(const LAS f32x4*)(lds + L_CW + 2048 + ch8 * 32 + 16);
#pragma unroll
              for (int i = 0; i < 4; ++i)
#pragma unroll
                for (int j = 0; j < 4; ++j) { acc8[i][j] = b0[j]; acc8[i][4 + j] = b1[j]; } }
#pragma unroll
            for (int t = 0; t < 4; ++t) { const f32x4 w0 = *(const LAS f32x4*)(lds + L_CW + t * 512 + ch8 * 32), w1 = *(const LAS f32x4*)(lds + L_CW + t * 512 + ch8 * 32 + 16);
#pragma unroll
                for (int j = 0; j < 4; ++j) { cw[t][j] = w0[j]; cw[t][4 + j] = w1[j]; } }
#pragma unroll
            for (int q = 0; q < 7; ++q) { float x[8]; unpack8(rwn[q], x);
#pragma unroll
                for (int i = 0; i < 4; ++i) { const int tap = q - i;
                    if (tap >= 0 && tap < 4) {
#pragma unroll
                        for (int j = 0; j < 8; ++j) acc8[i][j] += cw[tap][j] * x[j]; } } }
#pragma unroll
            for (int i = 0; i < 4; ++i) *(LAS u32x4*)(lds + L_XC + (tk0 + i) * 272 + ch8 * 16) = pack8(acc8[i]);
            if (tile + 1 < 16) load_rows(T0 + 128);
        }
        lds_barrier();
        {
            f32x4 ga[8];
#pragma unroll
            for (int nf = 0; nf < 8; ++nf) ga[nf] = (f32x4){0.f, 0.f, 0.f, 0.f};
#pragma unroll
            for (int s = 0; s < 4; ++s) {
                const bf16x8 af = *(const LAS bf16x8*)(lds + L_XC + (wid * 16 + fr) * 272 + (s * 32 + fg * 8) * 2);
#pragma unroll
                for (int nf = 0; nf < 8; ++nf) {
                    const bf16x8 bfr = *(const LAS bf16x8*)(lds + L_WL + (nf * 16 + fr) * 272 + (s * 32 + fg * 8) * 2);
                    ga[nf] = __builtin_amdgcn_mfma_f32_16x16x32_bf16(af, bfr, ga[nf], 0, 0, 0);
                }
            }
#pragma unroll
            for (int hf = 0; hf < 4; ++hf)
#pragma unroll
                for (int r = 0; r < 4; ++r) {
                    const int tk = wid * 16 + fg * 4 + r, cl = hf * 16 + fr;
                    float rg, ig; sigmoid2(ga[hf][r] + br_[hf], ga[4 + hf][r] + bi_[hf], rg, ig);
                    const float la = -8.0f * rg * sp_[hf]; const float a = __expf(la); const float mult = __builtin_amdgcn_sqrtf(fmaxf(fmaf(-a, a, 1.0f), 0.f));
                    const float x = bf2f(*(const LAS bf16_t*)(lds + L_XC + tk * 272 + (hf2 * 64 + cl) * 2));
                    ((LAS float*)(lds + L_SA))[tk * 64 + cl] = a; ((LAS float*)(lds + L_SBX))[tk * 64 + cl] = mult * ig * x;
                }
        }
        asm volatile("s_waitcnt lgkmcnt(0)" ::: "memory");
        {
            const int c = lane, sg = wid;
            float A = 1.f, B = 0.f;
#pragma unroll
            for (int t = 0; t < 16; ++t) { const float a_ = ((LAS float*)(lds + L_SA))[(sg * 16 + t) * 64 + c], b_ = ((LAS float*)(lds + L_SBX))[(sg * 16 + t) * 64 + c]; A *= a_; B = a_ * B + b_; }
            ((LAS float*)(lds + L_SEGA))[sg * 64 + c] = A; ((LAS float*)(lds + L_SEGB))[sg * 64 + c] = B;
            lds_barrier();
            float hst = ((LAS float*)(lds + L_CARRY))[(tile & 1) * 64 + c];
            { float sa_[7], sb_[7];
#pragma unroll
              for (int s2 = 0; s2 < 7; ++s2) { sa_[s2] = ((LAS float*)(lds + L_SEGA))[s2 * 64 + c]; sb_[s2] = ((LAS float*)(lds + L_SEGB))[s2 * 64 + c]; }
#pragma unroll
              for (int s2 = 0; s2 < 7; ++s2) hst = s2 < sg ? sa_[s2] * hst + sb_[s2] : hst; }
#pragma unroll
            for (int t = 0; t < 16; ++t) {
                hst = ((LAS float*)(lds + L_SA))[(sg * 16 + t) * 64 + c] * hst + ((LAS float*)(lds + L_SBX))[(sg * 16 + t) * 64 + c];
                gg[(tok0 + T0 + sg * 16 + t) * DM + c0 + c] = (bf16_t)(cvt_pk_bf16(hst * bf2f(gpre[t]), 0.f) & 0xffffu);
            }
            if (sg == 7) ((LAS float*)(lds + L_CARRY))[((tile + 1) & 1) * 64 + c] = hst;
        }
    }
    lds_barrier();
}

constexpr int X_T = 0, X_TS = 528;
constexpr int X_VS = 272;
constexpr int X_PW = 256 * 272;
constexpr int X_SCR = X_PW + 8 * 16 * 272;
static_assert(128 * 528 <= X_PW && X_SCR + 8 * 256 <= 128 * 1024, "xattn lds");
__device__ __forceinline__ void xattn_item(LAS unsigned char* lds, int item, const bf16_t* xq, const bf16_t* xkv, bf16_t* xo) {
    const int tid = threadIdx.x, wid = tid >> 6, lane = tid & 63, fr = lane & 15, fg = lane >> 4;
    const int b = item >> 6, h = (item >> 4) & 3, qt = item & 15;
    const size_t tok = (size_t)b * SEQ + qt * 128 + wid * 16 + fr;
    LAS unsigned char* Pw = lds + X_PW + wid * (16 * 272);
    bf16x8 qf[8];
#pragma unroll
    for (int s = 0; s < 8; ++s) qf[s] = __builtin_bit_cast(bf16x8, *(const u32x4*)(xq + tok * DM + h * 256 + s * 32 + fg * 8));
    f32x4 sc[16];
#pragma unroll
    for (int mt = 0; mt < 2; ++mt) {
        lds_barrier();
#pragma unroll
        for (int i = 0; i < 8; ++i) { const int c = tid + 512 * i, row = c >> 5, c16 = c & 31;
            *(LAS u32x4*)(lds + X_T + row * X_TS + c16 * 16) = *(const u32x4*)(xkv + ((size_t)b * 256 + mt * 128 + row) * 2048 + h * 256 + c16 * 8); }
        lds_barrier();
#pragma unroll
        for (int mf = 0; mf < 8; ++mf) {
            f32x4 a4 = (f32x4){0.f, 0.f, 0.f, 0.f};
#pragma unroll
            for (int s = 0; s < 8; ++s) {
                const bf16x8 kf = *(const LAS bf16x8*)(lds + X_T + (mf * 16 + fr) * X_TS + (s * 32 + fg * 8) * 2);
                a4 = __builtin_amdgcn_mfma_f32_16x16x32_bf16(kf, qf[s], a4, 0, 0, 0);
            }
            sc[mt * 8 + mf] = a4;
        }
    }
    float mx = -3.0e38f;
#pragma unroll
    for (int f = 0; f < 16; ++f) mx = fmaxf(mx, fmaxf(fmaxf(sc[f][0], sc[f][1]), fmaxf(sc[f][2], sc[f][3])));
    volatile LAS float* scr = (volatile LAS float*)(lds + X_SCR) + wid * 64;
    scr[lane] = mx;
    { const float m0 = scr[fr], m1 = scr[fr + 16], m2 = scr[fr + 32], m3 = scr[fr + 48]; mx = fmaxf(fmaxf(m0, m1), fmaxf(m2, m3)); }
    float sum = 0.f;
#pragma unroll
    for (int f = 0; f < 16; ++f)
#pragma unroll
        for (int r = 0; r < 4; ++r) { const float pe = __expf(sc[f][r] - mx); sc[f][r] = pe; sum += pe; }
    scr[lane] = sum;
    { const float m0 = scr[fr], m1 = scr[fr + 16], m2 = scr[fr + 32], m3 = scr[fr + 48]; sum = (m0 + m1) + (m2 + m3); }
    const float inv = 1.0f / sum;
    f32x4 o[16];
#pragma unroll
    for (int f = 0; f < 16; ++f) o[f] = (f32x4){0.f, 0.f, 0.f, 0.f};
#pragma unroll
    for (int mt = 0; mt < 2; ++mt) {
        lds_barrier();
#pragma unroll
        for (int i = 0; i < 8; ++i) { const int c = tid + 512 * i, m = c & 127, c16 = c >> 7;
            const u32x4 w = *(const u32x4*)(xkv + ((size_t)b * 256 + mt * 128 + m) * 2048 + 1024 + h * 256 + c16 * 8);
            LAS unsigned char* dp = lds + X_T + (c16 * 8) * X_VS + m * 2;
            *(LAS bf16_t*)(dp + 0 * X_VS) = (bf16_t)(w.x & 0xffffu); *(LAS bf16_t*)(dp + 1 * X_VS) = (bf16_t)(w.x >> 16);
            *(LAS bf16_t*)(dp + 2 * X_VS) = (bf16_t)(w.y & 0xffffu); *(LAS bf16_t*)(dp + 3 * X_VS) = (bf16_t)(w.y >> 16);
            *(LAS bf16_t*)(dp + 4 * X_VS) = (bf16_t)(w.z & 0xffffu); *(LAS bf16_t*)(dp + 5 * X_VS) = (bf16_t)(w.z >> 16);
            *(LAS bf16_t*)(dp + 6 * X_VS) = (bf16_t)(w.w & 0xffffu); *(LAS bf16_t*)(dp + 7 * X_VS) = (bf16_t)(w.w >> 16); }
#pragma unroll
        for (int f = 0; f < 8; ++f) { const f32x4 pv = sc[mt * 8 + f] * inv; u32x2 w; w.x = cvt_pk_bf16(pv[0], pv[1]); w.y = cvt_pk_bf16(pv[2], pv[3]);
            *(LAS u32x2*)(Pw + fr * 272 + (f * 16 + fg * 4) * 2) = w; }
        lds_barrier();
#pragma unroll
        for (int s = 0; s < 4; ++s) {
            const bf16x8 pf = *(const LAS bf16x8*)(Pw + fr * 272 + (s * 32 + fg * 8) * 2);
#pragma unroll
            for (int df = 0; df < 16; ++df) {
                const bf16x8 vf = *(const LAS bf16x8*)(lds + X_T + (df * 16 + fr) * X_VS + (s * 32 + fg * 8) * 2);
                o[df] = __builtin_amdgcn_mfma_f32_16x16x32_bf16(vf, pf, o[df], 0, 0, 0);
            }
        }
    }
#pragma unroll
    for (int df = 0; df < 16; ++df) { u32x2 w; w.x = cvt_pk_bf16(o[df][0], o[df][1]); w.y = cvt_pk_bf16(o[df][2], o[df][3]);
        *(u32x2*)(xo + tok * DM + h * 256 + df * 16 + fg * 4) = w; }
    lds_barrier();
}

struct Ptrs {
    unsigned char* ws; float *ss1, *ss2, *ss3, *ss4, *ss5, *ssm, *stats, *rcos, *rsin; bf16_t *mb, *xkv, *B0, *B1, *B2, *B3, *B4, *qbuf, *kbuf;
    __device__ __forceinline__ explicit Ptrs(unsigned char* w) {
        size_t z = 0; asm volatile("" : "+s"(z));
        ws = w + z; ss1 = (float*)(ws + S_SS); ss2 = ss1 + T_TOK; ss3 = ss2 + T_TOK; ss4 = ss3 + T_TOK; ss5 = ss4 + T_TOK;
        ssm = (float*)(ws + S_SSM); stats = (float*)(ws + S_STATS); rcos = (float*)(ws + S_COS); rsin = (float*)(ws + S_SIN);
        mb = (bf16_t*)(ws + A_MB); xkv = (bf16_t*)(ws + A_XKV);
        B0 = (bf16_t*)(ws + A_B0); B1 = (bf16_t*)(ws + A_B1); B2 = (bf16_t*)(ws + A_B2); B3 = (bf16_t*)(ws + A_B3); B4 = (bf16_t*)(ws + A_B4);
        qbuf = B1; kbuf = B1 + (size_t)T_TOK * 512;
    }
    __device__ __forceinline__ const bf16_t* w(size_t off) const { return (const bf16_t*)(ws + off); }
};
template <class Epi>
__device__ __forceinline__ void run_gemm(LAS unsigned char* lds, const bf16_t* A, int lda, const bf16_t* Bt, int M, int N, int K, int c, const Epi& E) {
    pg8::StaticOrder S; S.init(M, N, (int)gridDim.x, c);
    pg8::gemm_phase(lds, pg8::Gemm{A, Bt, M, N, K, lda, K}, S, E);
}
__device__ __forceinline__ void phase_prep(const Params& p, LAS unsigned char* lds) {
    const Ptrs P(p.ws); unsigned char* ws = P.ws;
    const int G = (int)gridDim.x, bid = (int)blockIdx.x, tid = threadIdx.x;
    for (int i = bid * 512 + tid; i < 4 * T_TOK; i += G * 512) P.ss2[i] = 0.f;
    for (int i = bid * 512 + tid; i < T_TOK * 8; i += G * 512) P.stats[i] = 0.f;
    for (int i = bid * 512 + tid; i < SEQ * 64; i += G * 512) {
        const int pos = i >> 6, d = i & 63;
        const float invf = exp2f(-(float)d * (13.287712379549449f / 64.0f));
        const float ang = (float)pos * invf;
        const float nrev = rintf(ang * 0.15915494309189535f);
        float r = fmaf(-nrev, 6.2831854820251465f, ang); r = fmaf(-nrev, -1.7484555314695172e-07f, r);
        P.rcos[i] = __builtin_amdgcn_cosf(r * 0.15915494309189535f); P.rsin[i] = __builtin_amdgcn_sinf(r * 0.15915494309189535f);
    }
    rows_prep(p.in[0], P.B0, P.ss1, T_TOK);
    rows_prep(p.in[1], P.mb, P.ssm, MEMT);
    const float* w1a = p.in[3]; const float* w3a = p.in[4];
    wprep(lds, (bf16_t*)(ws + W_13A), 5632, 1024, p.in[2], [=](int r) { const int pn = r >> 8, bj = (r >> 7) & 1, pp = r & 127; return RowSrc{(bj ? w3a : w1a) + pn * 128 + pp, DFF}; });
    const float* w2a = p.in[5];
    wprep(lds, (bf16_t*)(ws + W_2A), 1024, 2816, nullptr, [=](int r) { return RowSrc{w2a + r, 1024}; });
    const float* win = p.in[7];
    wprep(lds, (bf16_t*)(ws + W_IN), 4096, 1024, p.in[6], [=](int r) {
        int col;
        if (r < 1024) { const int seg = r >> 9, rr = r & 511, pnl = rr >> 8, bj = (rr >> 7) & 1, pp = rr & 127; const int head = 2 * pnl + (pp >> 6), d = pp & 63; col = seg * 512 + head * 128 + 64 * bj + d; }
        else if (r < 2048) col = 3072 + (r - 1024);
        else if (r < 3072) col = 1024 + (r - 2048);
        else col = 4096 + (r - 3072);
        return RowSrc{win + col, 5120}; });
    const float* wxk = p.in[24]; const float* wxv = p.in[25];
    wprep(lds, (bf16_t*)(ws + W_XKV), 2048, 1024, p.in[22], [=](int r) { return r < 1024 ? RowSrc{wxk + r, 1024} : RowSrc{wxv + (r - 1024), 1024}; });
    const float* wrg = p.in[12]; const float* wig = p.in[14];
    wprep(lds, (bf16_t*)(ws + W_LRU), 2048, 128, nullptr, [=](int r) { const int gi = (r >> 7) & 7, c = r & 127; return RowSrc{(r < 1024 ? wrg : wig) + gi * 16384 + c, 128}; });
}
__device__ __forceinline__ void phase1_late(const Params& p, LAS unsigned char* lds, unsigned char* ws) {
    const int G = (int)gridDim.x, bid = (int)blockIdx.x;
    const int nlate = G / 4, l0 = G - nlate;
    if (bid >= l0) {
        const float* w1b = p.in[28]; const float* w3b = p.in[29];
        wprep(lds, (bf16_t*)(ws + W_13B), 5632, 1024, p.in[27], [=](int r) { const int pn = r >> 8, bj = (r >> 7) & 1, pp = r & 127; return RowSrc{(bj ? w3b : w1b) + pn * 128 + pp, DFF}; }, bid - l0, nlate);
        const float* w2b = p.in[30];
        wprep(lds, (bf16_t*)(ws + W_2B), 1024, 2816, nullptr, [=](int r) { return RowSrc{w2b + r, 1024}; }, bid - l0, nlate);
    } else if (bid >= G / 2) {
        const int m0 = G / 2, nm = l0 - m0;
        const float* wout = p.in[20]; wprep(lds, (bf16_t*)(ws + W_OUT), 1024, 1024, nullptr, [=](int r) { return RowSrc{wout + r, 1024}; }, bid - m0, nm);
        const float* wxq = p.in[23]; wprep(lds, (bf16_t*)(ws + W_XQ), 1024, 1024, p.in[21], [=](int r) { return RowSrc{wxq + r, 1024}; }, bid - m0, nm);
        const float* wxo = p.in[26]; wprep(lds, (bf16_t*)(ws + W_XO), 1024, 1024, nullptr, [=](int r) { return RowSrc{wxo + r, 1024}; }, bid - m0, nm);
    }
}
__device__ __forceinline__ void phase_mix(const Params& p, LAS unsigned char* lds, int mode = 0) {
    const Ptrs P(p.ws); const int G = (int)gridDim.x, bid = (int)blockIdx.x;
    if (G == 256) {
        if (bid < 128) { retention_item(lds, bid, P.qbuf, P.kbuf, P.B3, P.stats);
            unsigned char* ws = P.ws; const float* win = p.in[7]; const float* wbg = p.in[18];
            wprep(lds, (bf16_t*)(ws + W_GG), 3072, 1024, p.in[6], [=](int r) { return r < 1024 ? RowSrc{win + 2048 + r, 5120} : RowSrc{wbg + (r - 1024), 2048}; }, bid, 128);
            const float* wro = p.in[9]; wprep(lds, (bf16_t*)(ws + W_RO), 1024, 1024, nullptr, [=](int r) { return RowSrc{wro + r, 1024}; }, bid, 128);
            const float* wlo = p.in[17]; wprep(lds, (bf16_t*)(ws + W_LO), 1024, 1024, nullptr, [=](int r) { return RowSrc{wlo + r, 1024}; }, bid, 128); }
        else lru_item(lds, bid - 128, P.B2, P.B4, P.w(W_LRU), p.in[10], p.in[11], p.in[13], p.in[15], p.in[16]);
    } else {
        { unsigned char* ws = P.ws; const float* win = p.in[7]; const float* wbg = p.in[18];
          wprep(lds, (bf16_t*)(ws + W_GG), 3072, 1024, p.in[6], [=](int r) { return r < 1024 ? RowSrc{win + 2048 + r, 5120} : RowSrc{wbg + (r - 1024), 2048}; });
          const float* wro = p.in[9]; wprep(lds, (bf16_t*)(ws + W_RO), 1024, 1024, nullptr, [=](int r) { return RowSrc{wro + r, 1024}; });
          const float* wlo = p.in[17]; wprep(lds, (bf16_t*)(ws + W_LO), 1024, 1024, nullptr, [=](int r) { return RowSrc{wlo + r, 1024}; }); }
        for (int it = bid; it < 256; it += G) {
            if (it < 128) retention_item(lds, it, P.qbuf, P.kbuf, P.B3, P.stats);
            else lru_item(lds, it - 128, P.B2, P.B4, P.w(W_LRU), p.in[10], p.in[11], p.in[13], p.in[15], p.in[16]);
        }
    }
}
__device__ __forceinline__ void phase_final(const Params& p) {
    const Ptrs P(p.ws); const int G = (int)gridDim.x, bid = (int)blockIdx.x, tid = threadIdx.x;
    const float* gf = p.in[31]; float* X = p.out;
    for (int i = bid * 512 + tid; i < T_TOK * 256; i += G * 512) {
        const int row = i >> 8, c = (i & 255) * 4; const float rs = rs_of(P.ss5[row]);
        f32x4 v = *(f32x4*)(X + (size_t)row * DM + c); const f32x4 gv = *(const f32x4*)(gf + c);
        v = v * rs * gv; *(f32x4*)(X + (size_t)row * DM + c) = v;
    }
}

__device__ __forceinline__ void gsync(unsigned* bar, unsigned& gen) {
    asm volatile("s_waitcnt vmcnt(0) lgkmcnt(0)" ::: "memory");
    __syncthreads();
    gen += 1u;
    if (threadIdx.x == 0) {
        __builtin_amdgcn_fence(__ATOMIC_RELEASE, "agent");
        asm volatile("s_waitcnt vmcnt(0)" ::: "memory");
        __hip_atomic_fetch_add(bar, 1u, __ATOMIC_RELAXED, __HIP_MEMORY_SCOPE_AGENT);
        const unsigned target = gen * gridDim.x;
        while (__hip_atomic_load(bar, __ATOMIC_RELAXED, __HIP_MEMORY_SCOPE_AGENT) < target) __builtin_amdgcn_s_sleep(1);
        __builtin_amdgcn_fence(__ATOMIC_ACQUIRE, "agent");
        asm volatile("s_waitcnt vmcnt(0)" ::: "memory");
    }
    __syncthreads();
}
__global__ __launch_bounds__(512, 2) void fwd_mega(Params p) {
    extern __shared__ __attribute__((aligned(16))) unsigned char shm[];
    LAS unsigned char* lds = (LAS unsigned char*)shm;
    cg::grid_group grid = cg::this_grid();
    const int bid = (int)blockIdx.x, G = (int)gridDim.x;
    unsigned* bar = (unsigned*)(p.ws + S_BAR);
    volatile LAS unsigned* xst = (volatile LAS unsigned*)(lds + LDS_BYTES - 16);
    if (threadIdx.x == 0) { xst[0] = 0u; xst[1] = 0u; }
    __syncthreads();
    const XcdBarrier xb = xcd_barrier_post(bar, xst);
    if (p.ph_lo > 1000) grid.sync();
#ifndef PHMASK
#define PHMASK 0x7fff
#endif
#ifndef REPMASK
#define REPMASK 0
#endif
#define PHASE(k, body) if (((PHMASK >> (k)) & 1) && p.ph_lo <= (k) && (k) < p.ph_hi) { if ((k) > p.ph_lo) xcd_barrier(xb); { body } if ((REPMASK >> (k)) & 1) { xcd_barrier(xb); { body } } }
    PHASE(0, phase_prep(p, lds);)
    PHASE(1, { const Ptrs P(p.ws);
        run_gemm(lds, P.B0, 1024, P.w(W_13A), T_TOK, 5632, 1024, bid, EpiSwiglu{P.B1, P.ss1});
        run_gemm(lds, P.mb, 1024, P.w(W_XKV), MEMT, 2048, 1024, (bid + G / 2) % G, EpiScale{P.xkv, 2048, P.ssm, 1.0f});
        phase1_late(p, lds, P.ws); })
    PHASE(2, { const Ptrs P(p.ws);
        run_gemm(lds, P.B1, DFF, P.w(W_2A), T_TOK, 1024, DFF, bid, EpiResid<true>{p.in[0], p.out, P.B0, P.ss2, 0.5f}); })
    PHASE(3, { const Ptrs P(p.ws);
        run_gemm(lds, P.B0, 1024, P.w(W_IN), T_TOK, 4096, 1024, bid, EpiInproj{P.qbuf, P.B2, P.ss2, P.rcos, P.rsin}); })
#ifdef REP34
    PHASE(4, phase_mix(p, lds, REP34);)
#else
    PHASE(4, phase_mix(p, lds);)
#endif
#ifdef REP34
    { xcd_barrier(xb); { const Ptrs P(p.ws); for (int i = bid * 512 + threadIdx.x; i < T_TOK * 8; i += G * 512) P.stats[i] = 0.f;
        run_gemm(lds, P.B0, 1024, P.w(W_IN), T_TOK, 4096, 1024, bid, EpiInproj{P.qbuf, P.B2, P.ss2, P.rcos, P.rsin}); }
      xcd_barrier(xb); phase_mix(p, lds); }
#endif
    PHASE(5, { const Ptrs P(p.ws);
        run_gemm(lds, P.B0, 1024, P.w(W_GG), T_TOK, 3072, 1024, bid, EpiGG{P.B3, P.B1, P.ss2, P.stats, p.in[8], p.in[19]}); })
    PHASE(6, { const Ptrs P(p.ws);
        run_gemm(lds, P.B3, 1024, P.w(W_RO), T_TOK, 1024, 1024, bid, EpiMerge<false>{P.B0, P.B1}); })
    if (((PHMASK >> 7) & 1) && p.ph_lo <= 7 && 7 < p.ph_hi) { const Ptrs P(p.ws);
        run_gemm(lds, P.B4, 1024, P.w(W_LO), T_TOK, 1024, 1024, bid, EpiMerge<true>{P.B0, P.B1}); }
    PHASE(8, { const Ptrs P(p.ws);
        run_gemm(lds, P.B0, 1024, P.w(W_OUT), T_TOK, 1024, 1024, bid, EpiResid<true>{p.out, p.out, P.B3, P.ss3, 1.0f}); })
    PHASE(9, { const Ptrs P(p.ws);
        run_gemm(lds, P.B3, 1024, P.w(W_XQ), T_TOK, 1024, 1024, bid, EpiScale{P.B4, 1024, P.ss3, 0.0625f});
        if (G == 256) {
            pg8::StaticOrder S; S.init(T_TOK, 1024, G, bid); Unit u; S.next(0, u);
            asm volatile("s_waitcnt vmcnt(0)" ::: "memory"); __syncthreads();
            for (int j = 0; j < 2; ++j) xattn_item(lds, ((u.pm >> 3) << 6) | (u.pn << 4) | ((u.pm & 7) * 2 + j), P.B4, P.xkv, P.B0);
        } })
    if (G != 256) { PHASE(10, { const Ptrs P(p.ws);
        for (int it = bid; it < 512; it += G) xattn_item(lds, it, P.B4, P.xkv, P.B0); }) }
    PHASE(11, { const Ptrs P(p.ws);
        run_gemm(lds, P.B0, 1024, P.w(W_XO), T_TOK, 1024, 1024, bid, EpiResid<true>{p.out, p.out, P.B4, P.ss4, 1.0f}); })
    PHASE(12, { const Ptrs P(p.ws);
        run_gemm(lds, P.B4, 1024, P.w(W_13B), T_TOK, 5632, 1024, bid, EpiSwiglu{P.B1, P.ss4}); })
    if (G == 256) {
        PHASE(13, { const Ptrs P(p.ws);
            run_gemm(lds, P.B1, DFF, P.w(W_2B), T_TOK, 1024, DFF, bid, EpiFinal{p.out, P.ss5, p.in[31], xb}); })
    } else {
        PHASE(13, { const Ptrs P(p.ws);
            run_gemm(lds, P.B1, DFF, P.w(W_2B), T_TOK, 1024, DFF, bid, EpiResid<false>{p.out, p.out, nullptr, P.ss5, 0.5f}); })
        PHASE(14, phase_final(p);)
    }
#ifdef DBG_DUMP
    { xcd_barrier(xb); const Ptrs P(p.ws);
      for (size_t i = (size_t)bid * 512 + threadIdx.x; i < (size_t)T_TOK * DM; i += (size_t)G * 512) p.out[i] = bf2f(P.DBG_BUF[i]); }
#endif
#ifdef EXTRA_SYNCS
    for (int i = 0; i < EXTRA_SYNCS; ++i) xcd_barrier(xb);
#endif
#undef PHASE
}

constexpr int N_PHASES = 15;
#ifndef DBG_HI
#define DBG_HI N_PHASES
#endif
extern "C" void kernel_launch(void* const* d_in, const int* in_sizes, int n_in, void* d_out, int out_size, void* d_ws, size_t ws_size, hipStream_t stream) {
    static int grid = 0;
    if (grid == 0) {
        if (n_in != 32 || out_size != T_TOK * DM || ws_size < WS_NEED) { fprintf(stderr, "kernel_launch: unexpected shapes (n_in %d out %d ws %zu)\n", n_in, out_size, ws_size); grid = -1; return; }
        int dev = 0, cus = 0, per_cu = 0;
        hipGetDevice(&dev); hipDeviceGetAttribute(&cus, hipDeviceAttributeMultiprocessorCount, dev);
        hipFuncSetAttribute((const void*)fwd_mega, hipFuncAttributeMaxDynamicSharedMemorySize, LDS_BYTES);
        hipOccupancyMaxActiveBlocksPerMultiprocessor(&per_cu, (const void*)fwd_mega, 512, LDS_BYTES);
        if (per_cu < 1) { fprintf(stderr, "kernel_launch: occupancy query says %d blocks/CU\n", per_cu); per_cu = 1; }
        (void)hipGetLastError();
        grid = cus;
    }
    if (grid < 0) return;
    Params p{};
    for (int i = 0; i < 32; ++i) p.in[i] = (const float*)d_in[i];
    p.out = (float*)d_out; p.ws = (unsigned char*)d_ws;
#ifndef N_CUTS
#define N_CUTS 1
#endif
    if (hipMemsetAsync((unsigned char*)d_ws + S_BAR, 0, 16384, stream) != hipSuccess) { fprintf(stderr, "kernel_launch: memset of the barrier word failed\n"); return; }
    for (int li = 0; li < N_CUTS; ++li) {
        p.ph_lo = li * DBG_HI / N_CUTS; p.ph_hi = (li + 1) * DBG_HI / N_CUTS;
        void* args[] = {&p};
        hipError_t e = hipLaunchCooperativeKernel((const void*)fwd_mega, dim3(grid), dim3(512), args, LDS_BYTES, stream);
        if (e != hipSuccess) fprintf(stderr, "cooperative launch failed: %s (grid %d)\n", hipGetErrorString(e), grid);
    }
}
```

```cpp
#include <hip/hip_runtime.h>
#include <hip/hip_cooperative_groups.h>
#include <cstdio>
namespace cg = cooperative_groups;

#define LAS __attribute__((address_space(3)))
typedef unsigned short bf16_t;
typedef short bf16x8 __attribute__((ext_vector_type(8)));
typedef short s16x4 __attribute__((ext_vector_type(4)));
typedef float f32x4 __attribute__((ext_vector_type(4)));
typedef unsigned u32x4 __attribute__((ext_vector_type(4)));
typedef unsigned u32x2 __attribute__((ext_vector_type(2)));

constexpr int T_TOK = 16384, DM = 1024, SEQ = 2048, NB = 8, DFF = 2816, MEMT = 2048;
constexpr float EPS = 1e-6f;
constexpr int LDS_BYTES = 140 * 1024;

constexpr size_t MiB = 1024 * 1024;
constexpr size_t W_13A = 0;
constexpr size_t W_2A = W_13A + (size_t)5632 * 1024 * 2;
constexpr size_t W_IN = W_2A + (size_t)1024 * 2816 * 2;
constexpr size_t W_GG = W_IN + (size_t)4096 * 1024 * 2;
constexpr size_t W_RO = W_GG + (size_t)3072 * 1024 * 2;
constexpr size_t W_LO = W_RO + (size_t)1024 * 1024 * 2;
constexpr size_t W_OUT = W_LO + (size_t)1024 * 1024 * 2;
constexpr size_t W_XQ = W_OUT + (size_t)1024 * 1024 * 2;
constexpr size_t W_XKV = W_XQ + (size_t)1024 * 1024 * 2;
constexpr size_t W_XO = W_XKV + (size_t)2048 * 1024 * 2;
constexpr size_t W_13B = W_XO + (size_t)1024 * 1024 * 2;
constexpr size_t W_2B = W_13B + (size_t)5632 * 1024 * 2;
constexpr size_t W_LRU = W_2B + (size_t)1024 * 2816 * 2;
constexpr size_t W_END = W_LRU + (size_t)2 * 1024 * 128 * 2;
static_assert(W_END <= 62 * MiB, "weights");
constexpr size_t S_SS = 62 * MiB;
constexpr size_t S_SSM = S_SS + 5 * 65536;
constexpr size_t S_STATS = S_SSM + 8192;
constexpr size_t S_COS = S_STATS + 524288;
constexpr size_t S_SIN = S_COS + 524288;
constexpr size_t S_BAR = S_SIN + 524288;
static_assert(S_BAR + 16384 <= 64 * MiB && S_BAR % 256 == 0, "small");
constexpr size_t A_MB = 64 * MiB;
constexpr size_t A_XKV = 68 * MiB;
constexpr size_t A_B0 = 76 * MiB, A_B1 = 108 * MiB, A_B2 = 140 * MiB, A_B3 = 172 * MiB, A_B4 = 204 * MiB;
constexpr size_t WS_NEED = 236 * MiB;

struct Params { const float* in[32]; float* out; unsigned char* ws; int ph_lo, ph_hi; };

typedef float f32x2v __attribute__((ext_vector_type(2)));
typedef __bf16 bf16x2v __attribute__((ext_vector_type(2)));
__device__ __forceinline__ unsigned cvt_pk_bf16(float lo, float hi) { const f32x2v v = {lo, hi}; return __builtin_bit_cast(unsigned, __builtin_convertvector(v, bf16x2v)); }
__device__ __forceinline__ float bflo(unsigned w) { return __uint_as_float(w << 16); }
__device__ __forceinline__ float bfhi(unsigned w) { return __uint_as_float(w & 0xffff0000u); }
__device__ __forceinline__ float bf2f(bf16_t b) { return __uint_as_float((unsigned)b << 16); }
__device__ __forceinline__ u32x4 pack8(const float* o) { u32x4 w; w.x = cvt_pk_bf16(o[0], o[1]); w.y = cvt_pk_bf16(o[2], o[3]); w.z = cvt_pk_bf16(o[4], o[5]); w.w = cvt_pk_bf16(o[6], o[7]); return w; }
__device__ __forceinline__ void unpack8(u32x4 w, float* o) { o[0] = bflo(w.x); o[1] = bfhi(w.x); o[2] = bflo(w.y); o[3] = bfhi(w.y); o[4] = bflo(w.z); o[5] = bfhi(w.z); o[6] = bflo(w.w); o[7] = bfhi(w.w); }
__device__ __forceinline__ float sigmoidf_(float x) { return __builtin_amdgcn_rcpf(1.0f + __expf(-x)); }
__device__ __forceinline__ float rs_of(float ss) { return rsqrtf(ss * (1.0f / 1024.0f) + EPS); }
__device__ __forceinline__ void lds_barrier() { asm volatile("s_waitcnt lgkmcnt(0)" ::: "memory"); __builtin_amdgcn_s_barrier(); asm volatile("" ::: "memory"); }

namespace pg8 {
constexpr int BM = 256, BK = 64, HALF = 128, HTB = HALF * BK * 2, STAGE_BYTES = 8 * HTB, NXCD = 8, WGM = 8;
__host__ __device__ __forceinline__ int lds_byte(int r, int c) { const int st = (r >> 4) * 2 + (c >> 5), rr = r & 15, cc = c & 31, ob = rr * 64 + cc * 2; return st * 1024 + (ob ^ (((ob >> 9) & 1) << 5)); }
__host__ __device__ __forceinline__ void stage_rc(int b, int& R, int& C) { const int st = b / 1024, sb = b % 1024, swz = sb ^ (((sb >> 9) & 1) << 5); R = (st >> 1) * 16 + swz / 64; C = (st & 1) * 32 + (swz % 64) / 2; }
__host__ __device__ __forceinline__ int perm32(int rho) { const int n = rho >> 4, i = rho & 15; return 8 * (i >> 2) + 4 * n + (i & 3); }
struct Unit { int pm, pn; };
struct Gemm { const bf16_t* A; const bf16_t* Bt; int M, N, K, lda, ldb; };
struct StaticOrder {
    int nM, nN, nwg, G, c;
    __device__ __forceinline__ void init(int M, int N, int G_, int c_) { nM = M / BM; nN = N / BM; nwg = nM * nN; G = G_; c = c_; }
    __device__ __forceinline__ bool next(int i, Unit& u) const {
        const long L = (long)i * G + c; if (L >= nwg) return false;
        int wgid = (int)L; { const int q = nwg / NXCD, r = nwg % NXCD, xcd = wgid % NXCD, off = wgid / NXCD; wgid = (xcd < r ? xcd * (q + 1) : r * (q + 1) + (xcd - r) * q) + off; }
        const int nig = WGM * nN, gid = wgid / nig, fm = gid * WGM, gsz = (nM - fm) < WGM ? (nM - fm) : WGM;
        u.pm = fm + ((wgid % nig) % gsz); u.pn = (wgid % nig) / gsz; return true;
    }
};
template <class Epi>
__device__ __forceinline__ void gemm_phase(LAS unsigned char* lds, const Gemm g, const StaticOrder& S, const Epi& E) {
    const int tid = threadIdx.x, wid = __builtin_amdgcn_readfirstlane(tid >> 6), lane = tid & 63, wr = wid >> 2, wc = wid & 3, fr = lane & 15, fq = lane >> 4;
    const int K = g.K, nt = K / BK;
    unsigned voffA[2], voffB[2];
#pragma unroll
    for (int i = 0; i < 2; ++i) { int R, C; stage_rc(tid * 16 + i * 8192, R, C); const int Rb = Epi::PERM ? ((R & ~31) + perm32(R & 31)) : R;
        voffA[i] = (unsigned)(R * g.lda + C) * 2u; voffB[i] = (unsigned)(Rb * g.ldb + C) * 2u; }
    const size_t kstep = (size_t)(BK * 2);
    const size_t hstepA = (size_t)HALF * g.lda * 2, hstepB = (size_t)HALF * g.ldb * 2;
    const size_t tstepA = 2 * hstepA, tstepB = 2 * hstepB;
    const unsigned ldsw = (unsigned)wid * 1024u;
    const int aoff = lds_byte(wr * 64 + fr, fq * 8), boff = lds_byte(wc * 32 + fr, fq * 8);
#define PG8_SA(b, h) (((b) * 2 + (h)) * HTB)
#define PG8_SB(b, h) ((4 + (b) * 2 + (h)) * HTB)
#define PG8_STAGE(bufoff, gbase, voff) do { _Pragma("unroll") for (int _i = 0; _i < 2; ++_i) \
        __builtin_amdgcn_global_load_lds((const unsigned*)((const char*)(gbase) + (voff)[_i]), (LAS unsigned*)(lds + (bufoff) + ldsw + _i * 8192), 16, 0, 0); } while (0)
#define PG8_LDA(dst, b, h) do { _Pragma("unroll") for (int m = 0; m < 4; ++m) _Pragma("unroll") for (int k = 0; k < 2; ++k) dst[m][k] = *(const LAS bf16x8*)(lds + PG8_SA(b, h) + aoff + m * 2048 + k * 1024); } while (0)
#define PG8_LDB(dst, b, h) do { _Pragma("unroll") for (int n = 0; n < 2; ++n) _Pragma("unroll") for (int k = 0; k < 2; ++k) dst[n][k] = *(const LAS bf16x8*)(lds + PG8_SB(b, h) + boff + n * 2048 + k * 1024); } while (0)
#define PG8_MMA(ai, bj, At, Bt) do { __builtin_amdgcn_s_setprio(1); _Pragma("unroll") for (int m = 0; m < 4; ++m) _Pragma("unroll") for (int n = 0; n < 2; ++n) _Pragma("unroll") for (int k = 0; k < 2; ++k) \
        acc[ai][bj][m][n] = __builtin_amdgcn_mfma_f32_16x16x32_bf16(Bt[n][k], At[m][k], acc[ai][bj][m][n], 0, 0, 0); __builtin_amdgcn_s_setprio(0); } while (0)
#define PG8_WAIT_V(n) asm volatile("s_waitcnt vmcnt(" #n ")" ::: "memory")
#define PG8_WAIT_L(n) asm volatile("s_waitcnt lgkmcnt(" #n ")" ::: "memory")
#define PG8_BAR __builtin_amdgcn_s_barrier()
#define PG8_SCHED __builtin_amdgcn_sched_barrier(0)
    Unit cur, nxt; int ui = 0;
    if (!S.next(0, cur)) return;
    f32x4 acc[2][2][4][2];
#pragma unroll
    for (int a = 0; a < 2; ++a)
#pragma unroll
        for (int b = 0; b < 2; ++b)
#pragma unroll
            for (int m = 0; m < 4; ++m)
#pragma unroll
                for (int n = 0; n < 2; ++n) acc[a][b][m][n] = (f32x4){0.f, 0.f, 0.f, 0.f};
    bf16x8 At[4][2], B0[2][2], B1[2][2];
    const char* cA = (const char*)g.A + (size_t)cur.pm * tstepA; const char* cB = (const char*)g.Bt + (size_t)cur.pn * tstepB;
    PG8_STAGE(PG8_SB(0, 0), cB, voffB); PG8_STAGE(PG8_SA(0, 0), cA, voffA); PG8_STAGE(PG8_SB(0, 1), cB + hstepB, voffB); PG8_STAGE(PG8_SA(0, 1), cA + hstepA, voffA);
    if (wr == 1) PG8_BAR;
    PG8_WAIT_V(4); PG8_BAR;
    PG8_STAGE(PG8_SB(1, 0), cB + kstep, voffB); PG8_STAGE(PG8_SA(1, 0), cA + kstep, voffA); PG8_STAGE(PG8_SB(1, 1), cB + hstepB + kstep, voffB);
    PG8_WAIT_V(6); PG8_BAR;
    for (;;) {
        const bool has_next = S.next(ui + 1, nxt);
        const char* nA = has_next ? (const char*)g.A + (size_t)nxt.pm * tstepA : cA; const char* nB = has_next ? (const char*)g.Bt + (size_t)nxt.pn * tstepB : cB;
        for (int t = 0; t < nt; t += 2) {
            const bool last = (t == nt - 2);
            const char* a1 = cA + (size_t)(t + 1) * kstep;
            const char* a2 = last ? nA : cA + (size_t)(t + 2) * kstep; const char* b2 = last ? nB : cB + (size_t)(t + 2) * kstep;
            const char* a3 = a2 + kstep; const char* b3 = b2 + kstep;
            PG8_LDB(B0, 0, 0); PG8_SCHED; PG8_LDA(At, 0, 0); PG8_STAGE(PG8_SA(1, 1), a1 + hstepA, voffA);
            PG8_WAIT_L(8); PG8_BAR; PG8_WAIT_L(0); PG8_MMA(0, 0, At, B0); PG8_BAR; PG8_SCHED;
            PG8_LDB(B1, 0, 1); PG8_STAGE(PG8_SB(0, 0), b2, voffB);
            PG8_BAR; PG8_WAIT_L(0); PG8_MMA(0, 1, At, B1); PG8_BAR;
            PG8_LDA(At, 0, 1); PG8_STAGE(PG8_SA(0, 0), a2, voffA);
            PG8_BAR; PG8_WAIT_L(0); PG8_MMA(1, 0, At, B0); PG8_BAR; PG8_SCHED;
            PG8_STAGE(PG8_SB(0, 1), b2 + hstepB, voffB);
            PG8_WAIT_V(6); PG8_BAR; PG8_MMA(1, 1, At, B1); PG8_BAR;
            PG8_LDB(B0, 1, 0); PG8_SCHED; PG8_LDA(At, 1, 0); PG8_STAGE(PG8_SA(0, 1), a2 + hstepA, voffA);
            PG8_WAIT_L(8); PG8_BAR; PG8_WAIT_L(0); PG8_MMA(0, 0, At, B0); PG8_BAR; PG8_SCHED;
            PG8_LDB(B1, 1, 1); PG8_STAGE(PG8_SB(1, 0), b3, voffB);
            PG8_BAR; PG8_WAIT_L(0); PG8_MMA(0, 1, At, B1); PG8_BAR;
            PG8_LDA(At, 1, 1); PG8_STAGE(PG8_SA(1, 0), a3, voffA);
            PG8_BAR; PG8_WAIT_L(0); PG8_MMA(1, 0, At, B0); PG8_BAR; PG8_SCHED;
            PG8_STAGE(PG8_SB(1, 1), b3 + hstepB, voffB);
            PG8_WAIT_V(6); PG8_BAR; PG8_MMA(1, 1, At, B1); PG8_BAR;
        }
        if constexpr (!Epi::AFTER_DRAIN) E(acc, cur, wr, wc, fr, fq);
        if (!has_next) break;
#pragma unroll
        for (int a = 0; a < 2; ++a)
#pragma unroll
            for (int b = 0; b < 2; ++b)
#pragma unroll
                for (int m = 0; m < 4; ++m)
#pragma unroll
                    for (int n = 0; n < 2; ++n) acc[a][b][m][n] = (f32x4){0.f, 0.f, 0.f, 0.f};
        cur = nxt; cA = nA; cB = nB; ++ui;
    }
    PG8_WAIT_V(0);
    if (wr == 0) PG8_BAR;
    PG8_BAR;
    if constexpr (Epi::AFTER_DRAIN) E.fused(acc, cur, wr, wc, fr, fq);
#undef PG8_SA
#undef PG8_SB
#undef PG8_STAGE
#undef PG8_LDA
#undef PG8_LDB
#undef PG8_MMA
#undef PG8_WAIT_V
#undef PG8_WAIT_L
#undef PG8_BAR
#undef PG8_SCHED
}
}
using pg8::Unit;
typedef f32x4 AccT[2][2][4][2];

#define XB_TMO      128
#define XB_XCNT(j)  (256  + 64 * (j))
#define XB_XSUB(j)  (1280 + 64 * (j))
#define XB_XGEN(j)  (2304 + 64 * (j))
#define XB_TOP      3328
#define XB_TOPGEN   3392
#define XCD_BAR_WORDS 3456
#define XB_SPIN_CAP (1u << 18)

__device__ __forceinline__ unsigned xb_ld(unsigned* p)              { return __hip_atomic_load(p, __ATOMIC_RELAXED, __HIP_MEMORY_SCOPE_AGENT); }
__device__ __forceinline__ unsigned xb_add(unsigned* p, unsigned v) { return __hip_atomic_fetch_add(p, v, __ATOMIC_RELAXED, __HIP_MEMORY_SCOPE_AGENT); }
__device__ __forceinline__ unsigned xb_xcc_id() { return (unsigned)__builtin_amdgcn_s_getreg((3 << 11) | 20) & 0xFu; }
#define XB_SPIN(cond, bar) do { unsigned _sp = 0; while (cond) { __builtin_amdgcn_s_sleep(1); \
    if ((++_sp & 255u) == 0u) { if (xb_ld(&(bar)[XB_TMO])) break; if (_sp > XB_SPIN_CAP) { atomicAdd(&(bar)[XB_TMO], 1u); break; } } } } while (0)

struct XcdBarrier {
    unsigned* bar; unsigned x;
    volatile LAS unsigned* st;
};

__device__ __forceinline__ XcdBarrier xcd_barrier_post(unsigned* bar, volatile LAS unsigned* st) {
    XcdBarrier b; b.bar = bar; b.x = xb_xcc_id(); b.st = st;
    if (threadIdx.x == 0) (void)xb_add(&bar[XB_XCNT(b.x)], 1u);
    return b;
}
__device__ __forceinline__ void xcd_barrier_complete(unsigned* bar, unsigned x, unsigned& nloc, unsigned& nx) {
    const unsigned G = gridDim.x * gridDim.y * gridDim.z;
    unsigned sum, cnt, mine, sp = 0u;
    for (;;) {
        sum = 0u; cnt = 0u; mine = 0u;
#pragma unroll
        for (unsigned j = 0; j < 16; ++j) { const unsigned c = xb_ld(&bar[XB_XCNT(j)]); sum += c; cnt += (c > 0u) ? 1u : 0u; mine = (j == x) ? c : mine; }
        if (sum == G) break;
        __builtin_amdgcn_s_sleep(1);
        if ((++sp & 255u) == 0u) { if (xb_ld(&bar[XB_TMO])) break; if (sp > XB_SPIN_CAP) { atomicAdd(&bar[XB_TMO], 1u); break; } }
    }
    nloc = mine > 0u ? mine : 1u; nx = cnt > 0u ? cnt : 1u;
}

__device__ __forceinline__ void xcd_barrier(const XcdBarrier& b) {
    asm volatile("s_waitcnt vmcnt(0)" ::: "memory");
    __syncthreads();
    if (threadIdx.x == 0) {
        unsigned* bar = b.bar;
        __builtin_amdgcn_s_waitcnt(0);
        unsigned nloc = b.st[0], nx = b.st[1];
        if (nloc == 0u) { xcd_barrier_complete(bar, b.x, nloc, nx); b.st[0] = nloc; b.st[1] = nx; }
        const unsigned old = xb_add(&bar[XB_XSUB(b.x)], 1u);
        const unsigned gen = old / nloc;
        if (old + 1u == (gen + 1u) * nloc) {
            __builtin_amdgcn_fence(__ATOMIC_RELEASE, "agent");
            asm volatile("s_waitcnt vmcnt(0)" ::: "memory");
            const unsigned og = xb_add(&bar[XB_TOP], 1u);
            const unsigned tg = og / nx;
            if (og + 1u == (tg + 1u) * nx) xb_add(&bar[XB_TOPGEN], 1u);
            else XB_SPIN(xb_ld(&bar[XB_TOPGEN]) == tg, bar);
            __builtin_amdgcn_fence(__ATOMIC_ACQUIRE, "agent");
            xb_add(&bar[XB_XGEN(b.x)], 1u);
            asm volatile("s_waitcnt vmcnt(0)" ::: "memory");
        } else {
            XB_SPIN(xb_ld(&bar[XB_XGEN(b.x)]) == gen, bar);
            __builtin_amdgcn_fence(__ATOMIC_ACQUIRE, "agent");
            asm volatile("s_waitcnt vmcnt(0)" ::: "memory");
        }
    }
    __syncthreads();
}


struct EpiSwiglu {
    static constexpr bool PERM = true, AFTER_DRAIN = false;
    bf16_t* G; const float* ss;
    __device__ __forceinline__ void operator()(const AccT& acc, const Unit& u, int wr, int wc, int fr, int fq) const {
        const int row0 = u.pm * 256 + wr * 64 + fr, col0 = u.pn * 128 + wc * 32 + 8 * fq;
#pragma unroll
        for (int ai = 0; ai < 2; ++ai)
#pragma unroll
            for (int m = 0; m < 4; ++m) {
                const int row = row0 + ai * 128 + m * 16; const float rs = rs_of(ss[row]); float o[8];
#pragma unroll
                for (int n = 0; n < 2; ++n)
#pragma unroll
                    for (int j = 0; j < 4; j += 2) {
                        const float a1 = acc[ai][0][m][n][j] * rs, b1 = acc[ai][0][m][n][j + 1] * rs;
                        const float d0 = 1.0f + __expf(-fmaxf(a1, -40.f)), d1 = 1.0f + __expf(-fmaxf(b1, -40.f));
                        const float r = __builtin_amdgcn_rcpf(d0 * d1);
                        o[4 * n + j] = a1 * (r * d1) * (acc[ai][1][m][n][j] * rs); o[4 * n + j + 1] = b1 * (r * d0) * (acc[ai][1][m][n][j + 1] * rs); }
                *(u32x4*)(G + (size_t)row * DFF + col0) = pack8(o);
            }
    }
};
template <bool WB> struct EpiResid {
    static constexpr bool PERM = true, AFTER_DRAIN = false;
    const float* base; float* X; bf16_t* Xb; float* ss; float scale;
    __device__ __forceinline__ void operator()(const AccT& acc, const Unit& u, int wr, int wc, int fr, int fq) const {
        const int row0 = u.pm * 256 + wr * 64 + fr, col0 = u.pn * 256 + wc * 32 + 8 * fq;
#pragma unroll
        for (int ai = 0; ai < 2; ++ai)
#pragma unroll
            for (int m = 0; m < 4; ++m) {
                const int row = row0 + ai * 128 + m * 16; float sq = 0.f;
#pragma unroll
                for (int bj = 0; bj < 2; ++bj) {
                    const size_t off = (size_t)row * DM + col0 + bj * 128;
                    const f32x4 b0 = *(const f32x4*)(base + off), b1 = *(const f32x4*)(base + off + 4);
                    const f32x4 v0 = b0 + scale * acc[ai][bj][m][0], v1 = b1 + scale * acc[ai][bj][m][1];
                    *(f32x4*)(X + off) = v0; *(f32x4*)(X + off + 4) = v1;
                    sq += (v0[0] * v0[0] + v0[1] * v0[1]) + (v0[2] * v0[2] + v0[3] * v0[3]) + (v1[0] * v1[0] + v1[1] * v1[1]) + (v1[2] * v1[2] + v1[3] * v1[3]);
                    if (WB) { u32x4 w; w.x = cvt_pk_bf16(v0[0], v0[1]); w.y = cvt_pk_bf16(v0[2], v0[3]); w.z = cvt_pk_bf16(v1[0], v1[1]); w.w = cvt_pk_bf16(v1[2], v1[3]); *(u32x4*)(Xb + off) = w; }
                }
                sq += __shfl_xor(sq, 16); sq += __shfl_xor(sq, 32);
                if (fq == 0) unsafeAtomicAdd(ss + row, sq);
            }
    }
};
struct EpiInproj {
    static constexpr bool PERM = true, AFTER_DRAIN = false;
    bf16_t *q, *xl; const float *ss, *cs, *sn;
    __device__ __forceinline__ void operator()(const AccT& acc, const Unit& u, int wr, int wc, int fr, int fq) const {
        const int row0 = u.pm * 256 + wr * 64 + fr, p0 = wc * 32 + 8 * fq, pn = u.pn;
        if (pn < 4) {
            bf16_t* dst = q + (size_t)(pn >> 1) * ((size_t)T_TOK * 512); const float sc = pn < 2 ? 1.0f : 0.08838834764831845f;
            const int head = 2 * (pn & 1) + (p0 >> 6), d0 = p0 & 63;
#pragma unroll
            for (int ai = 0; ai < 2; ++ai)
#pragma unroll
                for (int m = 0; m < 4; ++m) {
                    const int row = row0 + ai * 128 + m * 16; const float rs = rs_of(ss[row]) * sc; const int pos = row & (SEQ - 1);
                    const float* cp = cs + pos * 64 + d0; const float* sp = sn + pos * 64 + d0;
                    bf16_t* dp = dst + (size_t)row * 512 + head * 128 + d0;
#pragma unroll
                    for (int n = 0; n < 2; ++n) {
                        const f32x4 c = *(const f32x4*)(cp + 4 * n), s = *(const f32x4*)(sp + 4 * n);
                        const f32x4 t1 = acc[ai][0][m][n] * rs, t2 = acc[ai][1][m][n] * rs;
                        const f32x4 o1 = t1 * c - t2 * s, o2 = t2 * c + t1 * s;
                        u32x2 w1, w2; w1.x = cvt_pk_bf16(o1[0], o1[1]); w1.y = cvt_pk_bf16(o1[2], o1[3]); w2.x = cvt_pk_bf16(o2[0], o2[1]); w2.y = cvt_pk_bf16(o2[2], o2[3]);
                        *(u32x2*)(dp + 4 * n) = w1; *(u32x2*)(dp + 64 + 4 * n) = w2;
                    }
                    __builtin_amdgcn_sched_barrier(0);
                }
        } else {
            const int seg = (pn - 4) >> 2; bf16_t* dst = xl + (size_t)seg * ((size_t)T_TOK * DM); const int colb = ((pn - 4) & 3) * 256 + p0;
#pragma unroll
            for (int ai = 0; ai < 2; ++ai)
#pragma unroll
                for (int m = 0; m < 4; ++m) {
                    const int row = row0 + ai * 128 + m * 16; const float rs = rs_of(ss[row]);
#pragma unroll
                    for (int bj = 0; bj < 2; ++bj) {
                        float o[8];
#pragma unroll
                        for (int n = 0; n < 2; ++n)
#pragma unroll
                            for (int j = 0; j < 4; ++j) { float a = acc[ai][bj][m][n][j] * rs;
                                if (seg == 2) { const float uu = 0.7978845608028654f * (a + 0.044715f * a * a * a); a = a * sigmoidf_(2.0f * uu); }
                                o[4 * n + j] = a; }
                        *(u32x4*)(dst + (size_t)row * DM + colb + bj * 128) = pack8(o);
                    }
                }
        }
    }
};
struct EpiGG {
    static constexpr bool PERM = true, AFTER_DRAIN = false;
    bf16_t* aret; bf16_t* gates; const float *ss, *stats, *gn, *bg;
    __device__ __forceinline__ void operator()(const AccT& acc, const Unit& u, int wr, int wc, int fr, int fq) const {
        const int row0 = u.pm * 256 + wr * 64 + fr, p0 = wc * 32 + 8 * fq, pn = u.pn;
        if (pn < 4) {
#pragma unroll
            for (int ai = 0; ai < 2; ++ai)
#pragma unroll
                for (int m = 0; m < 4; ++m) {
                    const int row = row0 + ai * 128 + m * 16; const float rs = rs_of(ss[row]);
                    const float s1 = stats[((size_t)row * 4 + pn) * 2], s2 = stats[((size_t)row * 4 + pn) * 2 + 1];
                    const float mu = s1 * (1.0f / 256.0f); const float var = fmaxf(s2 * (1.0f / 256.0f) - mu * mu, 0.f); const float rstd = rsqrtf(var + EPS);
#pragma unroll
                    for (int bj = 0; bj < 2; ++bj) {
                        const int col = pn * 256 + bj * 128 + p0; bf16_t* rp = aret + (size_t)row * DM + col;
                        float r[8], o[8]; unpack8(*(const u32x4*)rp, r);
                        const f32x4 g0 = *(const f32x4*)(gn + col), g1 = *(const f32x4*)(gn + col + 4);
#pragma unroll
                        for (int n = 0; n < 2; ++n)
#pragma unroll
                            for (int j = 0; j < 4; ++j) { const float a = acc[ai][bj][m][n][j] * rs; const float gv = n ? g1[j] : g0[j];
                                o[4 * n + j] = a * sigmoidf_(a) * gv * (r[4 * n + j] - mu) * rstd; }
                        *(u32x4*)rp = pack8(o);
                    }
                }
        } else {
#pragma unroll
            for (int ai = 0; ai < 2; ++ai)
#pragma unroll
                for (int m = 0; m < 4; ++m) {
                    const int row = row0 + ai * 128 + m * 16; const float rs = rs_of(ss[row]);
#pragma unroll
                    for (int bj = 0; bj < 2; ++bj) {
                        const int col = (pn - 4) * 256 + bj * 128 + p0; float o[8];
                        const f32x4 b0 = *(const f32x4*)(bg + col), b1 = *(const f32x4*)(bg + col + 4);
#pragma unroll
                        for (int n = 0; n < 2; ++n)
#pragma unroll
                            for (int j = 0; j < 4; ++j) o[4 * n + j] = sigmoidf_(acc[ai][bj][m][n][j] * rs + (n ? b1[j] : b0[j]));
                        *(u32x4*)(gates + (size_t)row * 2048 + col) = pack8(o);
                    }
                }
        }
    }
};
template <bool SECOND> struct EpiMerge {
    static constexpr bool PERM = true, AFTER_DRAIN = false;
    bf16_t* merged; const bf16_t* gates;
    __device__ __forceinline__ void operator()(const AccT& acc, const Unit& u, int wr, int wc, int fr, int fq) const {
        const int row0 = u.pm * 256 + wr * 64 + fr, col0 = u.pn * 256 + wc * 32 + 8 * fq;
#pragma unroll
        for (int ai = 0; ai < 2; ++ai)
#pragma unroll
            for (int m = 0; m < 4; ++m) {
                const int row = row0 + ai * 128 + m * 16;
#pragma unroll
                for (int bj = 0; bj < 2; ++bj) {
                    const int col = col0 + bj * 128; float g[8], o[8];
                    unpack8(*(const u32x4*)(gates + (size_t)row * 2048 + (SECOND ? 1024 : 0) + col), g);
                    bf16_t* mp = merged + (size_t)row * DM + col;
                    if (SECOND) unpack8(*(const u32x4*)mp, o);
#pragma unroll
                    for (int n = 0; n < 2; ++n)
#pragma unroll
                        for (int j = 0; j < 4; ++j) { const float t = g[4 * n + j] * acc[ai][bj][m][n][j]; o[4 * n + j] = SECOND ? o[4 * n + j] + t : t; }
                    *(u32x4*)mp = pack8(o);
                }
            }
    }
};
struct EpiScale {
    static constexpr bool PERM = true, AFTER_DRAIN = false;
    bf16_t* O; int ldc; const float* ss; float sc;
    __device__ __forceinline__ void operator()(const AccT& acc, const Unit& u, int wr, int wc, int fr, int fq) const {
        const int row0 = u.pm * 256 + wr * 64 + fr, col0 = u.pn * 256 + wc * 32 + 8 * fq;
#pragma unroll
        for (int ai = 0; ai < 2; ++ai)
#pragma unroll
            for (int m = 0; m < 4; ++m) {
                const int row = row0 + ai * 128 + m * 16; const float rs = rs_of(ss[row]) * sc;
#pragma unroll
                for (int bj = 0; bj < 2; ++bj) { float o[8];
#pragma unroll
                    for (int n = 0; n < 2; ++n)
#pragma unroll
                        for (int j = 0; j < 4; ++j) o[4 * n + j] = acc[ai][bj][m][n][j] * rs;
                    *(u32x4*)(O + (size_t)row * ldc + col0 + bj * 128) = pack8(o); }
            }
    }
};

struct EpiFinal {
    static constexpr bool PERM = true, AFTER_DRAIN = true;
    float* X; float* ss; const float* gfin; XcdBarrier xb;
    __device__ __forceinline__ void fused(AccT& acc, const Unit& u, int wr, int wc, int fr, int fq) const {
        const int row0 = u.pm * 256 + wr * 64 + fr, col0 = u.pn * 256 + wc * 32 + 8 * fq;
#pragma unroll
        for (int ai = 0; ai < 2; ++ai)
#pragma unroll
            for (int m = 0; m < 4; ++m) {
                const int row = row0 + ai * 128 + m * 16; float sq = 0.f;
#pragma unroll
                for (int bj = 0; bj < 2; ++bj) {
                    const size_t off = (size_t)row * DM + col0 + bj * 128;
                    const f32x4 v0 = *(const f32x4*)(X + off) + 0.5f * acc[ai][bj][m][0], v1 = *(const f32x4*)(X + off + 4) + 0.5f * acc[ai][bj][m][1];
                    acc[ai][bj][m][0] = v0; acc[ai][bj][m][1] = v1;
                    sq += (v0[0] * v0[0] + v0[1] * v0[1]) + (v0[2] * v0[2] + v0[3] * v0[3]) + (v1[0] * v1[0] + v1[1] * v1[1]) + (v1[2] * v1[2] + v1[3] * v1[3]);
                }
                sq += __shfl_xor(sq, 16); sq += __shfl_xor(sq, 32);
                if (fq == 0) unsafeAtomicAdd(ss + row, sq);
            }
        xcd_barrier(xb);
#pragma unroll
        for (int ai = 0; ai < 2; ++ai)
#pragma unroll
            for (int m = 0; m < 4; ++m) {
                const int row = row0 + ai * 128 + m * 16; const float rs = rs_of(ss[row]);
#pragma unroll
                for (int bj = 0; bj < 2; ++bj) {
                    const size_t off = (size_t)row * DM + col0 + bj * 128; const int col = col0 + bj * 128;
                    const f32x4 g0 = *(const f32x4*)(gfin + col), g1 = *(const f32x4*)(gfin + col + 4);
                    *(f32x4*)(X + off) = acc[ai][bj][m][0] * rs * g0; *(f32x4*)(X + off + 4) = acc[ai][bj][m][1] * rs * g1;
                }
            }
    }
};
struct RowSrc { const float* p; int ld; };
template <class F>
__device__ __forceinline__ void wprep(LAS unsigned char* lds, bf16_t* dst, int nrows, int K, const float* gain, F rowsrc, int b0 = (int)blockIdx.x, int nb = (int)gridDim.x) {
    LAS float* tile = (LAS float*)lds;
    const int tid = threadIdx.x, kk = tid >> 4, r4 = (tid & 15) * 4;
    const int ntk = K / 128, ntiles = (nrows / 64) * ntk;
    f32x4 cur[4], nxt[4];
    auto fetch = [&](int t, f32x4 (&v)[4]) {
        const int r0 = (t / ntk) * 64, k0 = (t % ntk) * 128; const RowSrc rs = rowsrc(r0 + r4);
#pragma unroll
        for (int it = 0; it < 4; ++it) { const int k = k0 + kk + 32 * it; f32x4 x = *(const f32x4*)(rs.p + (size_t)k * rs.ld); if (gain) x *= gain[k]; v[it] = x; }
    };
    int t = b0;
    if (t < ntiles) fetch(t, cur);
    for (; t < ntiles; t += nb) {
        const int tn = t + nb;
        if (tn < ntiles) fetch(tn, nxt);
        const int r0 = (t / ntk) * 64, k0 = (t % ntk) * 128;
        __syncthreads();
#pragma unroll
        for (int it = 0; it < 4; ++it)
#pragma unroll
            for (int j = 0; j < 4; ++j) tile[(r4 + j) * 129 + kk + 32 * it] = cur[it][j];
        __syncthreads();
        const int row = tid >> 3, ch = tid & 7;
#pragma unroll
        for (int hf = 0; hf < 2; ++hf) { float o[8];
#pragma unroll
            for (int j = 0; j < 8; ++j) o[j] = tile[row * 129 + hf * 64 + ch * 8 + j];
            *(u32x4*)(dst + (size_t)(r0 + row) * K + k0 + hf * 64 + ch * 8) = pack8(o); }
#pragma unroll
        for (int it = 0; it < 4; ++it) cur[it] = nxt[it];
    }
    __syncthreads();
}

__device__ __forceinline__ void rows_prep(const float* src, bf16_t* dst, float* ss, int nrows) {
    const int lane = threadIdx.x & 63, gw = blockIdx.x * 8 + (threadIdx.x >> 6), nw = gridDim.x * 8;
    for (int r = gw; r < nrows; r += nw) {
        const float* sp = src + (size_t)r * DM; float sq = 0.f;
#pragma unroll
        for (int i = 0; i < 2; ++i) {
            const int c = (i * 64 + lane) * 8;
            const f32x4 a = *(const f32x4*)(sp + c), b = *(const f32x4*)(sp + c + 4);
            sq += (a[0] * a[0] + a[1] * a[1]) + (a[2] * a[2] + a[3] * a[3]) + (b[0] * b[0] + b[1] * b[1]) + (b[2] * b[2] + b[3] * b[3]);
            u32x4 w; w.x = cvt_pk_bf16(a[0], a[1]); w.y = cvt_pk_bf16(a[2], a[3]); w.z = cvt_pk_bf16(b[0], b[1]); w.w = cvt_pk_bf16(b[2], b[3]);
            *(u32x4*)(dst + (size_t)r * DM + c) = w;
        }
#pragma unroll
        for (int o = 32; o >= 1; o >>= 1) sq += __shfl_xor(sq, o);
        if (lane == 0) ss[r] = sq;
    }
}

__device__ __forceinline__ bf16x8 tr_frag(LAS unsigned char* tile, int stride, int k0, int x0, int lane) {
    const int g = lane >> 4, ii = lane & 15, q = ii >> 2, p = ii & 3;
    LAS unsigned char* a = tile + (k0 + 8 * g + q) * stride + (x0 + 4 * p) * 2;
    const s16x4 lo = __builtin_amdgcn_ds_read_tr16_b64_v4i16((LAS s16x4*)a);
    const s16x4 hi = __builtin_amdgcn_ds_read_tr16_b64_v4i16((LAS s16x4*)(a + 4 * stride));
    bf16x8 r; r[0] = lo[0]; r[1] = lo[1]; r[2] = lo[2]; r[3] = lo[3]; r[4] = hi[0]; r[5] = hi[1]; r[6] = hi[2]; r[7] = hi[3]; return r;
}
__device__ __forceinline__ bf16x8 scale_frag(bf16x8 f, const float* s) {
    u32x4 w = __builtin_bit_cast(u32x4, f); float o[8]; unpack8(w, o);
#pragma unroll
    for (int j = 0; j < 8; ++j) o[j] *= s[j];
    return __builtin_bit_cast(bf16x8, pack8(o));
}

constexpr int R_KT = 0, R_KS = 272;
constexpr int R_VT = 128 * 272, R_VS = 144;
constexpr int R_SB = R_VT + 128 * 144;
constexpr int R_PW = R_SB + 128 * 144;
static_assert(R_PW + 8 * 16 * 272 <= LDS_BYTES, "ret lds");
__device__ __forceinline__ void retention_item(LAS unsigned char* lds, int item, const bf16_t* qb, const bf16_t* kb, bf16_t* vb  , float* stats) {
    int tid = threadIdx.x; asm volatile("" : "+v"(tid));
    const int wid = tid >> 6, lane = tid & 63, fr = lane & 15, fg = lane >> 4;
    const int widu = __builtin_amdgcn_readfirstlane(tid >> 6);
    const int b = item >> 4, h = (item >> 2) & 3, es = item & 3;
    const float l2g = __log2f(1.0f - exp2f(-5.0f - (float)h));
    const float cd = exp2f(128.0f * l2g);
    const size_t tok0 = (size_t)b * SEQ;
    LAS unsigned char* Pw = lds + R_PW + wid * (16 * 272);
    f32x4 st[4];
#pragma unroll
    for (int e = 0; e < 4; ++e) st[e] = (f32x4){0.f, 0.f, 0.f, 0.f};
    u32x4 kreg[4], vreg[2], qnext[4], qf[4];
    auto issue = [&](int n) {
        const size_t t0 = tok0 + (size_t)n * 128;
#pragma unroll
        for (int i = 0; i < 4; ++i) { const int c = tid + 512 * i, row = c >> 4, c16 = c & 15; kreg[i] = *(const u32x4*)(kb + (t0 + row) * 512 + h * 128 + c16 * 8); }
#pragma unroll
        for (int i = 0; i < 2; ++i) { const int c = tid + 512 * i, row = c >> 3, c8 = c & 7; vreg[i] = *(const u32x4*)(vb + (t0 + row) * DM + h * 256 + es * 64 + c8 * 8); }
#pragma unroll
        for (int s = 0; s < 4; ++s) qnext[s] = *(const u32x4*)(qb + (t0 + wid * 16 + fr) * 512 + h * 128 + s * 32 + fg * 8);
    };
    issue(0);
    const float qdec = exp2f((float)(wid * 16 + fr + 1) * l2g);
    for (int n = 0; n < 16; ++n) {
        float l2 = l2g; asm volatile("" : "+v"(l2));
        int irow = wid * 16 + fr, fgl = fg; asm volatile("" : "+v"(irow), "+v"(fgl));
        lds_barrier();
#pragma unroll
        for (int i = 0; i < 4; ++i) { const int c = tid + 512 * i, row = c >> 4, c16 = c & 15; *(LAS u32x4*)(lds + R_KT + row * R_KS + c16 * 16) = kreg[i]; }
#pragma unroll
        for (int i = 0; i < 2; ++i) { const int c = tid + 512 * i, row = c >> 3, c8 = c & 7; *(LAS u32x4*)(lds + R_VT + row * R_VS + c8 * 16) = vreg[i]; }
#pragma unroll
        for (int e = 0; e < 4; ++e) { u32x2 w; w.x = cvt_pk_bf16(st[e][0], st[e][1]); w.y = cvt_pk_bf16(st[e][2], st[e][3]);
            *(LAS u32x2*)(lds + R_SB + (wid * 16 + fr) * R_VS + (e * 16 + fg * 4) * 2) = w; }
#pragma unroll
        for (int s = 0; s < 4; ++s) qf[s] = qnext[s];
        if (n + 1 < 16) issue(n + 1);
        lds_barrier();
        {
#pragma unroll
            for (int jf = 0; jf < 8; ++jf) {
                if (jf > (widu | 1)) break;
                f32x4 sc = (f32x4){0.f, 0.f, 0.f, 0.f};
#pragma unroll
                for (int s = 0; s < 4; ++s) {
                    const bf16x8 a = *(const LAS bf16x8*)(lds + R_KT + (jf * 16 + fr) * R_KS + (s * 32 + fg * 8) * 2);
                    sc = __builtin_amdgcn_mfma_f32_16x16x32_bf16(a, __builtin_bit_cast(bf16x8, qf[s]), sc, 0, 0, 0);
                }
                float pv[4];
#pragma unroll
                for (int r = 0; r < 4; ++r) { const int j = jf * 16 + fgl * 4 + r; const int dlt = irow - j; pv[r] = dlt >= 0 ? sc[r] * __builtin_amdgcn_exp2f((float)dlt * l2) : 0.f; }
                u32x2 w; w.x = cvt_pk_bf16(pv[0], pv[1]); w.y = cvt_pk_bf16(pv[2], pv[3]);
                *(LAS u32x2*)(Pw + fr * 272 + (jf * 16 + fg * 4) * 2) = w;
                __builtin_amdgcn_sched_barrier(0);
            }
        }
        asm volatile("s_waitcnt lgkmcnt(0)" ::: "memory");
        {
            f32x4 o[4];
#pragma unroll
            for (int e = 0; e < 4; ++e) { o[e] = (f32x4){0.f, 0.f, 0.f, 0.f}; st[e] *= cd; }
#pragma unroll
            for (int s = 0; s < 4; ++s) {
                const bf16x8 pf = *(const LAS bf16x8*)(Pw + fr * 272 + (s * 32 + fg * 8) * 2);
                float kd[8];
#pragma unroll
                for (int j = 0; j < 8; ++j) kd[j] = __builtin_amdgcn_exp2f((float)(127 - (s * 32 + fgl * 8 + j)) * l2);
                const bf16x8 kf = scale_frag(tr_frag(lds + R_KT, R_KS, s * 32, wid * 16, lane), kd);
                float qs[8];
#pragma unroll
                for (int j = 0; j < 8; ++j) qs[j] = qdec;
                const bf16x8 qsf = scale_frag(__builtin_bit_cast(bf16x8, qf[s]), qs);
#pragma unroll
                for (int e = 0; e < 4; ++e) {
                    const bf16x8 vf = tr_frag(lds + R_VT, R_VS, s * 32, e * 16, lane);
                    if (s <= (widu >> 1)) o[e] = __builtin_amdgcn_mfma_f32_16x16x32_bf16(vf, pf, o[e], 0, 0, 0);
                    st[e] = __builtin_amdgcn_mfma_f32_16x16x32_bf16(vf, kf, st[e], 0, 0, 0);
                    const bf16x8 sf = tr_frag(lds + R_SB, R_VS, s * 32, e * 16, lane);
                    o[e] = __builtin_amdgcn_mfma_f32_16x16x32_bf16(sf, qsf, o[e], 0, 0, 0);
                }
                __builtin_amdgcn_sched_barrier(0);
            }
            const size_t tok = tok0 + (size_t)n * 128 + wid * 16 + fr;
            float s1 = 0.f, s2 = 0.f;
#pragma unroll
            for (int e = 0; e < 4; ++e) {
                u32x2 w; w.x = cvt_pk_bf16(o[e][0], o[e][1]); w.y = cvt_pk_bf16(o[e][2], o[e][3]);
                *(u32x2*)(vb + tok * DM + h * 256 + es * 64 + e * 16 + fg * 4) = w;
                s1 += (o[e][0] + o[e][1]) + (o[e][2] + o[e][3]);
                s2 += (o[e][0] * o[e][0] + o[e][1] * o[e][1]) + (o[e][2] * o[e][2] + o[e][3] * o[e][3]);
            }
            s1 += __shfl_xor(s1, 16); s1 += __shfl_xor(s1, 32); s2 += __shfl_xor(s2, 16); s2 += __shfl_xor(s2, 32);
            if (fg == 0) { unsafeAtomicAdd(stats + (tok * 4 + h) * 2, s1); unsafeAtomicAdd(stats + (tok * 4 + h) * 2 + 1, s2); }
        }
    }
    lds_barrier();
}

constexpr int L_XC = 0;
constexpr int L_WL = 128 * 272;
constexpr int L_SA = L_WL + 128 * 272;
constexpr int L_SBX = L_SA + 32768;
constexpr int L_SEGA = L_SBX + 32768;
constexpr int L_SEGB = L_SEGA + 2048;
constexpr int L_CARRY = L_SEGB + 2048;
constexpr int L_CW = L_CARRY + 512;
static_assert(L_CW + 5 * 512 <= LDS_BYTES - 16, "lru lds");
__device__ __forceinline__ void lru_item(LAS unsigned char* lds, int item, const bf16_t* xl, bf16_t* gg  , const bf16_t* wlru,
                                         const float* conv_w, const float* conv_b, const float* b_r, const float* b_i, const float* lam) {
    int tid = threadIdx.x; asm volatile("" : "+v"(tid));
    const int wid = tid >> 6, lane = tid & 63, fr = lane & 15, fg = lane >> 4;
    const int b = item >> 4, g = (item >> 1) & 7, hf2 = item & 1;
    const int chg = g * 128, c0 = chg + hf2 * 64;
    const size_t tok0 = (size_t)b * SEQ;
    for (int c = tid; c < 128 * 16; c += 512) { const int n = c >> 4, c16 = c & 15; const bf16_t* src = wlru + ((size_t)(n >> 6) * 1024 + c0 + (n & 63)) * 128 + c16 * 8;
        *(LAS u32x4*)(lds + L_WL + n * 272 + c16 * 16) = *(const u32x4*)src; }
    if (tid < 64) ((LAS float*)(lds + L_CARRY))[tid] = 0.f;
    const int ch8 = tid & 15;
    for (int c = tid; c < 5 * 128; c += 512) ((LAS float*)(lds + L_CW))[c] = c < 512 ? conv_w[(c >> 7) * DM + chg + (c & 127)] : conv_b[chg + (c & 127)];
    float br_[4], bi_[4], sp_[4];
#pragma unroll
    for (int hf = 0; hf < 4; ++hf) { const int ch = c0 + hf * 16 + fr; br_[hf] = b_r[ch]; bi_[hf] = b_i[ch]; sp_[hf] = log1pf(__expf(-lam[ch])); }
    u32x4 rwn[7];
    auto load_rows = [&](int T0n) {
        const int tk0 = (tid >> 4) * 4;
#pragma unroll
        for (int q = 0; q < 7; ++q) { const int ts = T0n + tk0 - 3 + q; rwn[q] = ts >= 0 ? *(const u32x4*)(xl + (tok0 + ts) * DM + chg + ch8 * 8) : (u32x4){0u, 0u, 0u, 0u}; }
    };
    load_rows(0);
    for (int tile = 0; tile < 16; ++tile) {
        const int T0 = tile * 128;
        bf16_t gpre[16];
#pragma unroll
        for (int t = 0; t < 16; ++t) gpre[t] = gg[(tok0 + T0 + wid * 16 + t) * DM + c0 + lane];
        {
            const int tk0 = (tid >> 4) * 4;
            float acc8[4][8], cw[4][8];
            { const f32x4 b0 = *(const LAS f32x4*)(lds + L_CW + 2048 + ch8 * 32), b1 = *(const LAS f32x4*)(lds + L_CW + 2048 + ch8 * 32 + 16);
#pragma unroll
              for (int i = 0; i < 4; ++i)
#pragma unroll
                for (int j = 0; j < 4; ++j) { acc8[i][j] = b0[j]; acc8[i][4 + j] = b1[j]; } }
#pragma unroll
            for (int t = 0; t < 4; ++t) { const f32x4 w0 = *(const LAS f32x4*)(lds + L_CW + t * 512 + ch8 * 32), w1 = *(const LAS f32x4*)(lds + L_CW + t * 512 + ch8 * 32 + 16);
#pragma unroll
                for (int j = 0; j < 4; ++j) { cw[t][j] = w0[j]; cw[t][4 + j] = w1[j]; } }
#pragma unroll
            for (int q = 0; q < 7; ++q) { float x[8]; unpack8(rwn[q], x);
#pragma unroll
                for (int i = 0; i < 4; ++i) { const int tap = q - i;
                    if (tap >= 0 && tap < 4) {
#pragma unroll
                        for (int j = 0; j < 8; ++j) acc8[i][j] += cw[tap][j] * x[j]; } } }
#pragma unroll
            for (int i = 0; i < 4; ++i) *(LAS u32x4*)(lds + L_XC + (tk0 + i) * 272 + ch8 * 16) = pack8(acc8[i]);
            if (tile + 1 < 16) load_rows(T0 + 128);
        }
        lds_barrier();
        {
            f32x4 ga[8];
#pragma unroll
            for (int nf = 0; nf < 8; ++nf) ga[nf] = (f32x4){0.f, 0.f, 0.f, 0.f};
#pragma unroll
            for (int s = 0; s < 4; ++s) {
                const bf16x8 af = *(const LAS bf16x8*)(lds + L_XC + (wid * 16 + fr) * 272 + (s * 32 + fg * 8) * 2);
#pragma unroll
                for (int nf = 0; nf < 8; ++nf) {
                    const bf16x8 bfr = *(const LAS bf16x8*)(lds + L_WL + (nf * 16 + fr) * 272 + (s * 32 + fg * 8) * 2);
                    ga[nf] = __builtin_amdgcn_mfma_f32_16x16x32_bf16(af, bfr, ga[nf], 0, 0, 0);
                }
            }
#pragma unroll
            for (int hf = 0; hf < 4; ++hf)
#pragma unroll
                for (int r = 0; r < 4; ++r) {
                    const int tk = wid * 16 + fg * 4 + r, cl = hf * 16 + fr;
                    const float rg = sigmoidf_(ga[hf][r] + br_[hf]), ig = sigmoidf_(ga[4 + hf][r] + bi_[hf]);
                    const float la = -8.0f * rg * sp_[hf]; const float a = __expf(la); const float mult = __builtin_amdgcn_sqrtf(fmaxf(fmaf(-a, a, 1.0f), 0.f));
                    const float x = bf2f(*(const LAS bf16_t*)(lds + L_XC + tk * 272 + (hf2 * 64 + cl) * 2));
                    ((LAS float*)(lds + L_SA))[tk * 64 + cl] = a; ((LAS float*)(lds + L_SBX))[tk * 64 + cl] = mult * ig * x;
                }
        }
        asm volatile("s_waitcnt lgkmcnt(0)" ::: "memory");
        {
            const int c = lane, sg = wid;
            float A = 1.f, B = 0.f;
#pragma unroll
            for (int t = 0; t < 16; ++t) { const float a_ = ((LAS float*)(lds + L_SA))[(sg * 16 + t) * 64 + c], b_ = ((LAS float*)(lds + L_SBX))[(sg * 16 + t) * 64 + c]; A *= a_; B = a_ * B + b_; }
            ((LAS float*)(lds + L_SEGA))[sg * 64 + c] = A; ((LAS float*)(lds + L_SEGB))[sg * 64 + c] = B;
            lds_barrier();
            float hst = ((LAS float*)(lds + L_CARRY))[(tile & 1) * 64 + c];
            { float sa_[7], sb_[7];
#pragma unroll
              for (int s2 = 0; s2 < 7; ++s2) { sa_[s2] = ((LAS float*)(lds + L_SEGA))[s2 * 64 + c]; sb_[s2] = ((LAS float*)(lds + L_SEGB))[s2 * 64 + c]; }
#pragma unroll
              for (int s2 = 0; s2 < 7; ++s2) hst = s2 < sg ? sa_[s2] * hst + sb_[s2] : hst; }
#pragma unroll
            for (int t = 0; t < 16; ++t) {
                hst = ((LAS float*)(lds + L_SA))[(sg * 16 + t) * 64 + c] * hst + ((LAS float*)(lds + L_SBX))[(sg * 16 + t) * 64 + c];
                gg[(tok0 + T0 + sg * 16 + t) * DM + c0 + c] = (bf16_t)(cvt_pk_bf16(hst * bf2f(gpre[t]), 0.f) & 0xffffu);
            }
            if (sg == 7) ((LAS float*)(lds + L_CARRY))[((tile + 1) & 1) * 64 + c] = hst;
        }
    }
    lds_barrier();
}

constexpr int X_T = 0, X_TS = 528;
constexpr int X_VS = 272;
constexpr int X_PW = 256 * 272;
constexpr int X_SCR = X_PW + 8 * 16 * 272;
static_assert(128 * 528 <= X_PW && X_SCR + 8 * 256 <= 128 * 1024, "xattn lds");
__device__ __forceinline__ void xattn_item(LAS unsigned char* lds, int item, const bf16_t* xq, const bf16_t* xkv, bf16_t* xo) {
    const int tid = threadIdx.x, wid = tid >> 6, lane = tid & 63, fr = lane & 15, fg = lane >> 4;
    const int b = item >> 6, h = (item >> 4) & 3, qt = item & 15;
    const size_t tok = (size_t)b * SEQ + qt * 128 + wid * 16 + fr;
    LAS unsigned char* Pw = lds + X_PW + wid * (16 * 272);
    bf16x8 qf[8];
#pragma unroll
    for (int s = 0; s < 8; ++s) qf[s] = __builtin_bit_cast(bf16x8, *(const u32x4*)(xq + tok * DM + h * 256 + s * 32 + fg * 8));
    f32x4 sc[16];
#pragma unroll
    for (int mt = 0; mt < 2; ++mt) {
        lds_barrier();
#pragma unroll
        for (int i = 0; i < 8; ++i) { const int c = tid + 512 * i, row = c >> 5, c16 = c & 31;
            *(LAS u32x4*)(lds + X_T + row * X_TS + c16 * 16) = *(const u32x4*)(xkv + ((size_t)b * 256 + mt * 128 + row) * 2048 + h * 256 + c16 * 8); }
        lds_barrier();
#pragma unroll
        for (int mf = 0; mf < 8; ++mf) {
            f32x4 a4 = (f32x4){0.f, 0.f, 0.f, 0.f};
#pragma unroll
            for (int s = 0; s < 8; ++s) {
                const bf16x8 kf = *(const LAS bf16x8*)(lds + X_T + (mf * 16 + fr) * X_TS + (s * 32 + fg * 8) * 2);
                a4 = __builtin_amdgcn_mfma_f32_16x16x32_bf16(kf, qf[s], a4, 0, 0, 0);
            }
            sc[mt * 8 + mf] = a4;
        }
    }
    float mx = -3.0e38f;
#pragma unroll
    for (int f = 0; f < 16; ++f) mx = fmaxf(mx, fmaxf(fmaxf(sc[f][0], sc[f][1]), fmaxf(sc[f][2], sc[f][3])));
    volatile LAS float* scr = (volatile LAS float*)(lds + X_SCR) + wid * 64;
    scr[lane] = mx;
    { const float m0 = scr[fr], m1 = scr[fr + 16], m2 = scr[fr + 32], m3 = scr[fr + 48]; mx = fmaxf(fmaxf(m0, m1), fmaxf(m2, m3)); }
    float sum = 0.f;
#pragma unroll
    for (int f = 0; f < 16; ++f)
#pragma unroll
        for (int r = 0; r < 4; ++r) { const float pe = __expf(sc[f][r] - mx); sc[f][r] = pe; sum += pe; }
    scr[lane] = sum;
    { const float m0 = scr[fr], m1 = scr[fr + 16], m2 = scr[fr + 32], m3 = scr[fr + 48]; sum = (m0 + m1) + (m2 + m3); }
    const float inv = 1.0f / sum;
    f32x4 o[16];
#pragma unroll
    for (int f = 0; f < 16; ++f) o[f] = (f32x4){0.f, 0.f, 0.f, 0.f};
#pragma unroll
    for (int mt = 0; mt < 2; ++mt) {
        lds_barrier();
#pragma unroll
        for (int i = 0; i < 8; ++i) { const int c = tid + 512 * i, m = c & 127, c16 = c >> 7;
            const u32x4 w = *(const u32x4*)(xkv + ((size_t)b * 256 + mt * 128 + m) * 2048 + 1024 + h * 256 + c16 * 8);
            LAS unsigned char* dp = lds + X_T + (c16 * 8) * X_VS + m * 2;
            *(LAS bf16_t*)(dp + 0 * X_VS) = (bf16_t)(w.x & 0xffffu); *(LAS bf16_t*)(dp + 1 * X_VS) = (bf16_t)(w.x >> 16);
            *(LAS bf16_t*)(dp + 2 * X_VS) = (bf16_t)(w.y & 0xffffu); *(LAS bf16_t*)(dp + 3 * X_VS) = (bf16_t)(w.y >> 16);
            *(LAS bf16_t*)(dp + 4 * X_VS) = (bf16_t)(w.z & 0xffffu); *(LAS bf16_t*)(dp + 5 * X_VS) = (bf16_t)(w.z >> 16);
            *(LAS bf16_t*)(dp + 6 * X_VS) = (bf16_t)(w.w & 0xffffu); *(LAS bf16_t*)(dp + 7 * X_VS) = (bf16_t)(w.w >> 16); }
#pragma unroll
        for (int f = 0; f < 8; ++f) { const f32x4 pv = sc[mt * 8 + f] * inv; u32x2 w; w.x = cvt_pk_bf16(pv[0], pv[1]); w.y = cvt_pk_bf16(pv[2], pv[3]);
            *(LAS u32x2*)(Pw + fr * 272 + (f * 16 + fg * 4) * 2) = w; }
        lds_barrier();
#pragma unroll
        for (int s = 0; s < 4; ++s) {
            const bf16x8 pf = *(const LAS bf16x8*)(Pw + fr * 272 + (s * 32 + fg * 8) * 2);
#pragma unroll
            for (int df = 0; df < 16; ++df) {
                const bf16x8 vf = *(const LAS bf16x8*)(lds + X_T + (df * 16 + fr) * X_VS + (s * 32 + fg * 8) * 2);
                o[df] = __builtin_amdgcn_mfma_f32_16x16x32_bf16(vf, pf, o[df], 0, 0, 0);
            }
        }
    }
#pragma unroll
    for (int df = 0; df < 16; ++df) { u32x2 w; w.x = cvt_pk_bf16(o[df][0], o[df][1]); w.y = cvt_pk_bf16(o[df][2], o[df][3]);
        *(u32x2*)(xo + tok * DM + h * 256 + df * 16 + fg * 4) = w; }
    lds_barrier();
}

struct Ptrs {
    unsigned char* ws; float *ss1, *ss2, *ss3, *ss4, *ss5, *ssm, *stats, *rcos, *rsin; bf16_t *mb, *xkv, *B0, *B1, *B2, *B3, *B4, *qbuf, *kbuf;
    __device__ __forceinline__ explicit Ptrs(unsigned char* w) {
        size_t z = 0; asm volatile("" : "+s"(z));
        ws = w + z; ss1 = (float*)(ws + S_SS); ss2 = ss1 + T_TOK; ss3 = ss2 + T_TOK; ss4 = ss3 + T_TOK; ss5 = ss4 + T_TOK;
        ssm = (float*)(ws + S_SSM); stats = (float*)(ws + S_STATS); rcos = (float*)(ws + S_COS); rsin = (float*)(ws + S_SIN);
        mb = (bf16_t*)(ws + A_MB); xkv = (bf16_t*)(ws + A_XKV);
        B0 = (bf16_t*)(ws + A_B0); B1 = (bf16_t*)(ws + A_B1); B2 = (bf16_t*)(ws + A_B2); B3 = (bf16_t*)(ws + A_B3); B4 = (bf16_t*)(ws + A_B4);
        qbuf = B1; kbuf = B1 + (size_t)T_TOK * 512;
    }
    __device__ __forceinline__ const bf16_t* w(size_t off) const { return (const bf16_t*)(ws + off); }
};
template <class Epi>
__device__ __forceinline__ void run_gemm(LAS unsigned char* lds, const bf16_t* A, int lda, const bf16_t* Bt, int M, int N, int K, int c, const Epi& E) {
    pg8::StaticOrder S; S.init(M, N, (int)gridDim.x, c);
    pg8::gemm_phase(lds, pg8::Gemm{A, Bt, M, N, K, lda, K}, S, E);
}
__device__ __forceinline__ void phase_prep(const Params& p, LAS unsigned char* lds) {
    const Ptrs P(p.ws); unsigned char* ws = P.ws;
    const int G = (int)gridDim.x, bid = (int)blockIdx.x, tid = threadIdx.x;
    for (int i = bid * 512 + tid; i < 4 * T_TOK; i += G * 512) P.ss2[i] = 0.f;
    for (int i = bid * 512 + tid; i < T_TOK * 8; i += G * 512) P.stats[i] = 0.f;
    for (int i = bid * 512 + tid; i < SEQ * 64; i += G * 512) {
        const int pos = i >> 6, d = i & 63;
        const float invf = exp2f(-(float)d * (13.287712379549449f / 64.0f));
        const float ang = (float)pos * invf;
        const float nrev = rintf(ang * 0.15915494309189535f);
        float r = fmaf(-nrev, 6.2831854820251465f, ang); r = fmaf(-nrev, -1.7484555314695172e-07f, r);
        P.rcos[i] = __builtin_amdgcn_cosf(r * 0.15915494309189535f); P.rsin[i] = __builtin_amdgcn_sinf(r * 0.15915494309189535f);
    }
    rows_prep(p.in[0], P.B0, P.ss1, T_TOK);
    rows_prep(p.in[1], P.mb, P.ssm, MEMT);
    const float* w1a = p.in[3]; const float* w3a = p.in[4];
    wprep(lds, (bf16_t*)(ws + W_13A), 5632, 1024, p.in[2], [=](int r) { const int pn = r >> 8, bj = (r >> 7) & 1, pp = r & 127; return RowSrc{(bj ? w3a : w1a) + pn * 128 + pp, DFF}; });
    const float* w2a = p.in[5];
    wprep(lds, (bf16_t*)(ws + W_2A), 1024, 2816, nullptr, [=](int r) { return RowSrc{w2a + r, 1024}; });
    const float* win = p.in[7];
    wprep(lds, (bf16_t*)(ws + W_IN), 4096, 1024, p.in[6], [=](int r) {
        int col;
        if (r < 1024) { const int seg = r >> 9, rr = r & 511, pnl = rr >> 8, bj = (rr >> 7) & 1, pp = rr & 127; const int head = 2 * pnl + (pp >> 6), d = pp & 63; col = seg * 512 + head * 128 + 64 * bj + d; }
        else if (r < 2048) col = 3072 + (r - 1024);
        else if (r < 3072) col = 1024 + (r - 2048);
        else col = 4096 + (r - 3072);
        return RowSrc{win + col, 5120}; });
    const float* wxk = p.in[24]; const float* wxv = p.in[25];
    wprep(lds, (bf16_t*)(ws + W_XKV), 2048, 1024, p.in[22], [=](int r) { return r < 1024 ? RowSrc{wxk + r, 1024} : RowSrc{wxv + (r - 1024), 1024}; });
    const float* wrg = p.in[12]; const float* wig = p.in[14];
    wprep(lds, (bf16_t*)(ws + W_LRU), 2048, 128, nullptr, [=](int r) { const int gi = (r >> 7) & 7, c = r & 127; return RowSrc{(r < 1024 ? wrg : wig) + gi * 16384 + c, 128}; });
}
__device__ __forceinline__ void phase1_late(const Params& p, LAS unsigned char* lds, unsigned char* ws) {
    const int G = (int)gridDim.x, bid = (int)blockIdx.x;
    const int nlate = G / 4, l0 = G - nlate;
    if (bid >= l0) {
        const float* w1b = p.in[28]; const float* w3b = p.in[29];
        wprep(lds, (bf16_t*)(ws + W_13B), 5632, 1024, p.in[27], [=](int r) { const int pn = r >> 8, bj = (r >> 7) & 1, pp = r & 127; return RowSrc{(bj ? w3b : w1b) + pn * 128 + pp, DFF}; }, bid - l0, nlate);
        const float* w2b = p.in[30];
        wprep(lds, (bf16_t*)(ws + W_2B), 1024, 2816, nullptr, [=](int r) { return RowSrc{w2b + r, 1024}; }, bid - l0, nlate);
    } else if (bid >= G / 2) {
        const int m0 = G / 2, nm = l0 - m0;
        const float* wout = p.in[20]; wprep(lds, (bf16_t*)(ws + W_OUT), 1024, 1024, nullptr, [=](int r) { return RowSrc{wout + r, 1024}; }, bid - m0, nm);
        const float* wxq = p.in[23]; wprep(lds, (bf16_t*)(ws + W_XQ), 1024, 1024, p.in[21], [=](int r) { return RowSrc{wxq + r, 1024}; }, bid - m0, nm);
        const float* wxo = p.in[26]; wprep(lds, (bf16_t*)(ws + W_XO), 1024, 1024, nullptr, [=](int r) { return RowSrc{wxo + r, 1024}; }, bid - m0, nm);
    }
}
__device__ __forceinline__ void phase_mix(const Params& p, LAS unsigned char* lds, int mode = 0) {
    const Ptrs P(p.ws); const int G = (int)gridDim.x, bid = (int)blockIdx.x;
    if (G == 256) {
        if (bid < 128) { retention_item(lds, bid, P.qbuf, P.kbuf, P.B3, P.stats);
            unsigned char* ws = P.ws; const float* win = p.in[7]; const float* wbg = p.in[18];
            wprep(lds, (bf16_t*)(ws + W_GG), 3072, 1024, p.in[6], [=](int r) { return r < 1024 ? RowSrc{win + 2048 + r, 5120} : RowSrc{wbg + (r - 1024), 2048}; }, bid, 128);
            const float* wro = p.in[9]; wprep(lds, (bf16_t*)(ws + W_RO), 1024, 1024, nullptr, [=](int r) { return RowSrc{wro + r, 1024}; }, bid, 128);
            const float* wlo = p.in[17]; wprep(lds, (bf16_t*)(ws + W_LO), 1024, 1024, nullptr, [=](int r) { return RowSrc{wlo + r, 1024}; }, bid, 128); }
        else lru_item(lds, bid - 128, P.B2, P.B4, P.w(W_LRU), p.in[10], p.in[11], p.in[13], p.in[15], p.in[16]);
    } else {
        { unsigned char* ws = P.ws; const float* win = p.in[7]; const float* wbg = p.in[18];
          wprep(lds, (bf16_t*)(ws + W_GG), 3072, 1024, p.in[6], [=](int r) { return r < 1024 ? RowSrc{win + 2048 + r, 5120} : RowSrc{wbg + (r - 1024), 2048}; });
          const float* wro = p.in[9]; wprep(lds, (bf16_t*)(ws + W_RO), 1024, 1024, nullptr, [=](int r) { return RowSrc{wro + r, 1024}; });
          const float* wlo = p.in[17]; wprep(lds, (bf16_t*)(ws + W_LO), 1024, 1024, nullptr, [=](int r) { return RowSrc{wlo + r, 1024}; }); }
        for (int it = bid; it < 256; it += G) {
            if (it < 128) retention_item(lds, it, P.qbuf, P.kbuf, P.B3, P.stats);
            else lru_item(lds, it - 128, P.B2, P.B4, P.w(W_LRU), p.in[10], p.in[11], p.in[13], p.in[15], p.in[16]);
        }
    }
}
__device__ __forceinline__ void phase_final(const Params& p) {
    const Ptrs P(p.ws); const int G = (int)gridDim.x, bid = (int)blockIdx.x, tid = threadIdx.x;
    const float* gf = p.in[31]; float* X = p.out;
    for (int i = bid * 512 + tid; i < T_TOK * 256; i += G * 512) {
        const int row = i >> 8, c = (i & 255) * 4; const float rs = rs_of(P.ss5[row]);
        f32x4 v = *(f32x4*)(X + (size_t)row * DM + c); const f32x4 gv = *(const f32x4*)(gf + c);
        v = v * rs * gv; *(f32x4*)(X + (size_t)row * DM + c) = v;
    }
}

__global__ __launch_bounds__(512, 2) void fwd_mega(Params p) {
    extern __shared__ __attribute__((aligned(16))) unsigned char shm[];
    LAS unsigned char* lds = (LAS unsigned char*)shm;
    cg::grid_group grid = cg::this_grid();
    const int bid = (int)blockIdx.x, G = (int)gridDim.x;
    unsigned* bar = (unsigned*)(p.ws + S_BAR);
    volatile LAS unsigned* xst = (volatile LAS unsigned*)(lds + LDS_BYTES - 16);
    if (threadIdx.x == 0) { xst[0] = 0u; xst[1] = 0u; }
    __syncthreads();
    const XcdBarrier xb = xcd_barrier_post(bar, xst);
    if (p.ph_lo > 1000) grid.sync();
#ifndef PHMASK
#define PHMASK 0x7fff
#endif
#ifndef REPMASK
#define REPMASK 0
#endif
#define PHASE(k, body) if (((PHMASK >> (k)) & 1) && p.ph_lo <= (k) && (k) < p.ph_hi) { if ((k) > p.ph_lo) xcd_barrier(xb); { body } if ((REPMASK >> (k)) & 1) { xcd_barrier(xb); { body } } }
    PHASE(0, phase_prep(p, lds);)
    PHASE(1, { const Ptrs P(p.ws);
        run_gemm(lds, P.B0, 1024, P.w(W_13A), T_TOK, 5632, 1024, bid, EpiSwiglu{P.B1, P.ss1});
        run_gemm(lds, P.mb, 1024, P.w(W_XKV), MEMT, 2048, 1024, (bid + G / 2) % G, EpiScale{P.xkv, 2048, P.ssm, 1.0f});
        phase1_late(p, lds, P.ws); })
    PHASE(2, { const Ptrs P(p.ws);
        run_gemm(lds, P.B1, DFF, P.w(W_2A), T_TOK, 1024, DFF, bid, EpiResid<true>{p.in[0], p.out, P.B0, P.ss2, 0.5f}); })
    PHASE(3, { const Ptrs P(p.ws);
        run_gemm(lds, P.B0, 1024, P.w(W_IN), T_TOK, 4096, 1024, bid, EpiInproj{P.qbuf, P.B2, P.ss2, P.rcos, P.rsin}); })
    PHASE(4, phase_mix(p, lds);)
    PHASE(5, { const Ptrs P(p.ws);
        run_gemm(lds, P.B0, 1024, P.w(W_GG), T_TOK, 3072, 1024, bid, EpiGG{P.B3, P.B1, P.ss2, P.stats, p.in[8], p.in[19]}); })
    PHASE(6, { const Ptrs P(p.ws);
        run_gemm(lds, P.B3, 1024, P.w(W_RO), T_TOK, 1024, 1024, bid, EpiMerge<false>{P.B0, P.B1}); })
    if (((PHMASK >> 7) & 1) && p.ph_lo <= 7 && 7 < p.ph_hi) { const Ptrs P(p.ws);
        run_gemm(lds, P.B4, 1024, P.w(W_LO), T_TOK, 1024, 1024, bid, EpiMerge<true>{P.B0, P.B1}); }
    PHASE(8, { const Ptrs P(p.ws);
        run_gemm(lds, P.B0, 1024, P.w(W_OUT), T_TOK, 1024, 1024, bid, EpiResid<true>{p.out, p.out, P.B3, P.ss3, 1.0f}); })
    PHASE(9, { const Ptrs P(p.ws);
        run_gemm(lds, P.B3, 1024, P.w(W_XQ), T_TOK, 1024, 1024, bid, EpiScale{P.B4, 1024, P.ss3, 0.0625f});
        if (G == 256) {
            pg8::StaticOrder S; S.init(T_TOK, 1024, G, bid); Unit u; S.next(0, u);
            asm volatile("s_waitcnt vmcnt(0)" ::: "memory"); __syncthreads();
            for (int j = 0; j < 2; ++j) xattn_item(lds, ((u.pm >> 3) << 6) | (u.pn << 4) | ((u.pm & 7) * 2 + j), P.B4, P.xkv, P.B0);
        } })
    if (G != 256) { PHASE(10, { const Ptrs P(p.ws);
        for (int it = bid; it < 512; it += G) xattn_item(lds, it, P.B4, P.xkv, P.B0); }) }
    PHASE(11, { const Ptrs P(p.ws);
        run_gemm(lds, P.B0, 1024, P.w(W_XO), T_TOK, 1024, 1024, bid, EpiResid<true>{p.out, p.out, P.B4, P.ss4, 1.0f}); })
    PHASE(12, { const Ptrs P(p.ws);
        run_gemm(lds, P.B4, 1024, P.w(W_13B), T_TOK, 5632, 1024, bid, EpiSwiglu{P.B1, P.ss4}); })
    if (G == 256) {
        PHASE(13, { const Ptrs P(p.ws);
            run_gemm(lds, P.B1, DFF, P.w(W_2B), T_TOK, 1024, DFF, bid, EpiFinal{p.out, P.ss5, p.in[31], xb}); })
    } else {
        PHASE(13, { const Ptrs P(p.ws);
            run_gemm(lds, P.B1, DFF, P.w(W_2B), T_TOK, 1024, DFF, bid, EpiResid<false>{p.out, p.out, nullptr, P.ss5, 0.5f}); })
        PHASE(14, phase_final(p);)
    }
#undef PHASE
}

constexpr int N_PHASES = 15;
#ifndef DBG_HI
#define DBG_HI N_PHASES
#endif
extern "C" void kernel_launch(void* const* d_in, const int* in_sizes, int n_in, void* d_out, int out_size, void* d_ws, size_t ws_size, hipStream_t stream) {
    static int grid = 0;
    if (grid == 0) {
        if (n_in != 32 || out_size != T_TOK * DM || ws_size < WS_NEED) { fprintf(stderr, "kernel_launch: unexpected shapes (n_in %d out %d ws %zu)\n", n_in, out_size, ws_size); grid = -1; return; }
        int dev = 0, cus = 0, per_cu = 0;
        hipGetDevice(&dev); hipDeviceGetAttribute(&cus, hipDeviceAttributeMultiprocessorCount, dev);
        hipFuncSetAttribute((const void*)fwd_mega, hipFuncAttributeMaxDynamicSharedMemorySize, LDS_BYTES);
        hipOccupancyMaxActiveBlocksPerMultiprocessor(&per_cu, (const void*)fwd_mega, 512, LDS_BYTES);
        if (per_cu < 1) { fprintf(stderr, "kernel_launch: occupancy query says %d blocks/CU\n", per_cu); per_cu = 1; }
        (void)hipGetLastError();
        grid = cus;
    }
    if (grid < 0) return;
    Params p{};
    for (int i = 0; i < 32; ++i) p.in[i] = (const float*)d_in[i];
    p.out = (float*)d_out; p.ws = (unsigned char*)d_ws;
#ifndef N_CUTS
#define N_CUTS 1
#endif
    if (hipMemsetAsync((unsigned char*)d_ws + S_BAR, 0, 16384, stream) != hipSuccess) { fprintf(stderr, "kernel_launch: memset of the barrier word failed\n"); return; }
    for (int li = 0; li < N_CUTS; ++li) {
        p.ph_lo = li * DBG_HI / N_CUTS; p.ph_hi = (li + 1) * DBG_HI / N_CUTS;
        void* args[] = {&p};
        hipError_t e = hipLaunchCooperativeKernel((const void*)fwd_mega, dim3(grid), dim3(512), args, LDS_BYTES, stream);
        if (e != hipSuccess) fprintf(stderr, "cooperative launch failed: %s (grid %d)\n", hipGetErrorString(e), grid);
    }
}
```

```cpp
#include <hip/hip_runtime.h>
#include <hip/hip_cooperative_groups.h>
#include <cstdio>
namespace cg = cooperative_groups;

#define LAS __attribute__((address_space(3)))
typedef unsigned short bf16_t;
typedef short bf16x8 __attribute__((ext_vector_type(8)));
typedef short s16x4 __attribute__((ext_vector_type(4)));
typedef float f32x4 __attribute__((ext_vector_type(4)));
typedef unsigned u32x4 __attribute__((ext_vector_type(4)));
typedef unsigned u32x2 __attribute__((ext_vector_type(2)));

constexpr int T_TOK = 16384, DM = 1024, SEQ = 2048, NB = 8, DFF = 2816, MEMT = 2048;
constexpr float EPS = 1e-6f;
constexpr int LDS_BYTES = 140 * 1024;

constexpr size_t MiB = 1024 * 1024;
constexpr size_t W_13A = 0;
constexpr size_t W_2A = W_13A + (size_t)5632 * 1024 * 2;
constexpr size_t W_IN = W_2A + (size_t)1024 * 2816 * 2;
constexpr size_t W_GG = W_IN + (size_t)4096 * 1024 * 2;
constexpr size_t W_RO = W_GG + (size_t)3072 * 1024 * 2;
constexpr size_t W_LO = W_RO + (size_t)1024 * 1024 * 2;
constexpr size_t W_OUT = W_LO + (size_t)1024 * 1024 * 2;
constexpr size_t W_XQ = W_OUT + (size_t)1024 * 1024 * 2;
constexpr size_t W_XKV = W_XQ + (size_t)1024 * 1024 * 2;
constexpr size_t W_XO = W_XKV + (size_t)2048 * 1024 * 2;
constexpr size_t W_13B = W_XO + (size_t)1024 * 1024 * 2;
constexpr size_t W_2B = W_13B + (size_t)5632 * 1024 * 2;
constexpr size_t W_LRU = W_2B + (size_t)1024 * 2816 * 2;
constexpr size_t W_END = W_LRU + (size_t)2 * 1024 * 128 * 2;
static_assert(W_END <= 62 * MiB, "weights");
constexpr size_t S_SS = 62 * MiB;
constexpr size_t S_SSM = S_SS + 5 * 65536;
constexpr size_t S_STATS = S_SSM + 8192;
constexpr size_t S_COS = S_STATS + 524288;
constexpr size_t S_SIN = S_COS + 524288;
constexpr size_t S_BAR = S_SIN + 524288;
static_assert(S_BAR + 16384 <= 64 * MiB && S_BAR % 256 == 0, "small");
constexpr size_t A_MB = 64 * MiB;
constexpr size_t A_XKV = 68 * MiB;
constexpr size_t A_B0 = 76 * MiB, A_B1 = 108 * MiB, A_B2 = 140 * MiB, A_B3 = 172 * MiB, A_B4 = 204 * MiB;
constexpr size_t WS_NEED = 236 * MiB;

struct Params { const float* in[32]; float* out; unsigned char* ws; int ph_lo, ph_hi; };

typedef float f32x2v __attribute__((ext_vector_type(2)));
typedef __bf16 bf16x2v __attribute__((ext_vector_type(2)));
__device__ __forceinline__ unsigned cvt_pk_bf16(float lo, float hi) { const f32x2v v = {lo, hi}; return __builtin_bit_cast(unsigned, __builtin_convertvector(v, bf16x2v)); }
__device__ __forceinline__ float bflo(unsigned w) { return __uint_as_float(w << 16); }
__device__ __forceinline__ float bfhi(unsigned w) { return __uint_as_float(w & 0xffff0000u); }
__device__ __forceinline__ float bf2f(bf16_t b) { return __uint_as_float((unsigned)b << 16); }
__device__ __forceinline__ u32x4 pack8(const float* o) { u32x4 w; w.x = cvt_pk_bf16(o[0], o[1]); w.y = cvt_pk_bf16(o[2], o[3]); w.z = cvt_pk_bf16(o[4], o[5]); w.w = cvt_pk_bf16(o[6], o[7]); return w; }
__device__ __forceinline__ void unpack8(u32x4 w, float* o) { o[0] = bflo(w.x); o[1] = bfhi(w.x); o[2] = bflo(w.y); o[3] = bfhi(w.y); o[4] = bflo(w.z); o[5] = bfhi(w.z); o[6] = bflo(w.w); o[7] = bfhi(w.w); }
__device__ __forceinline__ float sigmoidf_(float x) { return __builtin_amdgcn_rcpf(1.0f + __expf(-x)); }
__device__ __forceinline__ void sigmoid2(float x0, float x1, float& s0, float& s1) {
    const float d0 = 1.0f + __expf(-fmaxf(x0, -40.f)), d1 = 1.0f + __expf(-fmaxf(x1, -40.f)); const float r = __builtin_amdgcn_rcpf(d0 * d1); s0 = r * d1; s1 = r * d0; }
__device__ __forceinline__ float rs_of(float ss) { return rsqrtf(ss * (1.0f / 1024.0f) + EPS); }
__device__ __forceinline__ void lds_barrier() { asm volatile("s_waitcnt lgkmcnt(0)" ::: "memory"); __builtin_amdgcn_s_barrier(); asm volatile("" ::: "memory"); }

namespace pg8 {
constexpr int BM = 256, BK = 64, HALF = 128, HTB = HALF * BK * 2, STAGE_BYTES = 8 * HTB, NXCD = 8, WGM = 8;
__host__ __device__ __forceinline__ int lds_byte(int r, int c) { const int st = (r >> 4) * 2 + (c >> 5), rr = r & 15, cc = c & 31, ob = rr * 64 + cc * 2; return st * 1024 + (ob ^ (((ob >> 9) & 1) << 5)); }
__host__ __device__ __forceinline__ void stage_rc(int b, int& R, int& C) { const int st = b / 1024, sb = b % 1024, swz = sb ^ (((sb >> 9) & 1) << 5); R = (st >> 1) * 16 + swz / 64; C = (st & 1) * 32 + (swz % 64) / 2; }
__host__ __device__ __forceinline__ int perm32(int rho) { const int n = rho >> 4, i = rho & 15; return 8 * (i >> 2) + 4 * n + (i & 3); }
struct Unit { int pm, pn; };
struct Gemm { const bf16_t* A; const bf16_t* Bt; int M, N, K, lda, ldb; };
struct StaticOrder {
    int nM, nN, nwg, G, c;
    __device__ __forceinline__ void init(int M, int N, int G_, int c_) { nM = M / BM; nN = N / BM; nwg = nM * nN; G = G_; c = c_; }
    __device__ __forceinline__ bool next(int i, Unit& u) const {
        const long L = (long)i * G + c; if (L >= nwg) return false;
        int wgid = (int)L; { const int q = nwg / NXCD, r = nwg % NXCD, xcd = wgid % NXCD, off = wgid / NXCD; wgid = (xcd < r ? xcd * (q + 1) : r * (q + 1) + (xcd - r) * q) + off; }
        const int nig = WGM * nN, gid = wgid / nig, fm = gid * WGM, gsz = (nM - fm) < WGM ? (nM - fm) : WGM;
        u.pm = fm + ((wgid % nig) % gsz); u.pn = (wgid % nig) / gsz; return true;
    }
};
template <class Epi>
__device__ __forceinline__ void gemm_phase(LAS unsigned char* lds, const Gemm g, const StaticOrder& S, const Epi& E) {
    const int tid = threadIdx.x, wid = __builtin_amdgcn_readfirstlane(tid >> 6), lane = tid & 63, wr = wid >> 2, wc = wid & 3, fr = lane & 15, fq = lane >> 4;
    const int K = g.K, nt = K / BK;
    unsigned voffA[2], voffB[2];
#pragma unroll
    for (int i = 0; i < 2; ++i) { int R, C; stage_rc(tid * 16 + i * 8192, R, C); const int Rb = Epi::PERM ? ((R & ~31) + perm32(R & 31)) : R;
        voffA[i] = (unsigned)(R * g.lda + C) * 2u; voffB[i] = (unsigned)(Rb * g.ldb + C) * 2u; }
    const size_t kstep = (size_t)(BK * 2);
    const size_t hstepA = (size_t)HALF * g.lda * 2, hstepB = (size_t)HALF * g.ldb * 2;
    const size_t tstepA = 2 * hstepA, tstepB = 2 * hstepB;
    const unsigned ldsw = (unsigned)wid * 1024u;
    const int aoff = lds_byte(wr * 64 + fr, fq * 8), boff = lds_byte(wc * 32 + fr, fq * 8);
#define PG8_SA(b, h) (((b) * 2 + (h)) * HTB)
#define PG8_SB(b, h) ((4 + (b) * 2 + (h)) * HTB)
#define PG8_STAGE(bufoff, gbase, voff) do { _Pragma("unroll") for (int _i = 0; _i < 2; ++_i) \
        __builtin_amdgcn_global_load_lds((const unsigned*)((const char*)(gbase) + (voff)[_i]), (LAS unsigned*)(lds + (bufoff) + ldsw + _i * 8192), 16, 0, 0); } while (0)
#define PG8_LDA(dst, b, h) do { _Pragma("unroll") for (int m = 0; m < 4; ++m) _Pragma("unroll") for (int k = 0; k < 2; ++k) dst[m][k] = *(const LAS bf16x8*)(lds + PG8_SA(b, h) + aoff + m * 2048 + k * 1024); } while (0)
#define PG8_LDB(dst, b, h) do { _Pragma("unroll") for (int n = 0; n < 2; ++n) _Pragma("unroll") for (int k = 0; k < 2; ++k) dst[n][k] = *(const LAS bf16x8*)(lds + PG8_SB(b, h) + boff + n * 2048 + k * 1024); } while (0)
#define PG8_MMA(ai, bj, At, Bt) do { __builtin_amdgcn_s_setprio(1); _Pragma("unroll") for (int m = 0; m < 4; ++m) _Pragma("unroll") for (int n = 0; n < 2; ++n) _Pragma("unroll") for (int k = 0; k < 2; ++k) \
        acc[ai][bj][m][n] = __builtin_amdgcn_mfma_f32_16x16x32_bf16(Bt[n][k], At[m][k], acc[ai][bj][m][n], 0, 0, 0); __builtin_amdgcn_s_setprio(0); } while (0)
#define PG8_WAIT_V(n) asm volatile("s_waitcnt vmcnt(" #n ")" ::: "memory")
#define PG8_WAIT_L(n) asm volatile("s_waitcnt lgkmcnt(" #n ")" ::: "memory")
#define PG8_BAR __builtin_amdgcn_s_barrier()
#define PG8_SCHED __builtin_amdgcn_sched_barrier(0)
    Unit cur, nxt; int ui = 0;
    if (!S.next(0, cur)) return;
    f32x4 acc[2][2][4][2];
#pragma unroll
    for (int a = 0; a < 2; ++a)
#pragma unroll
        for (int b = 0; b < 2; ++b)
#pragma unroll
            for (int m = 0; m < 4; ++m)
#pragma unroll
                for (int n = 0; n < 2; ++n) acc[a][b][m][n] = (f32x4){0.f, 0.f, 0.f, 0.f};
    bf16x8 At[4][2], B0[2][2], B1[2][2];
    const char* cA = (const char*)g.A + (size_t)cur.pm * tstepA; const char* cB = (const char*)g.Bt + (size_t)cur.pn * tstepB;
    PG8_STAGE(PG8_SB(0, 0), cB, voffB); PG8_STAGE(PG8_SA(0, 0), cA, voffA); PG8_STAGE(PG8_SB(0, 1), cB + hstepB, voffB); PG8_STAGE(PG8_SA(0, 1), cA + hstepA, voffA);
    if (wr == 1) PG8_BAR;
    PG8_WAIT_V(4); PG8_BAR;
    PG8_STAGE(PG8_SB(1, 0), cB + kstep, voffB); PG8_STAGE(PG8_SA(1, 0), cA + kstep, voffA); PG8_STAGE(PG8_SB(1, 1), cB + hstepB + kstep, voffB);
    PG8_WAIT_V(6); PG8_BAR;
    for (;;) {
        const bool has_next = S.next(ui + 1, nxt);
        const char* nA = has_next ? (const char*)g.A + (size_t)nxt.pm * tstepA : cA; const char* nB = has_next ? (const char*)g.Bt + (size_t)nxt.pn * tstepB : cB;
        for (int t = 0; t < nt; t += 2) {
            const bool last = (t == nt - 2);
            const char* a1 = cA + (size_t)(t + 1) * kstep;
            const char* a2 = last ? nA : cA + (size_t)(t + 2) * kstep; const char* b2 = last ? nB : cB + (size_t)(t + 2) * kstep;
            const char* a3 = a2 + kstep; const char* b3 = b2 + kstep;
            PG8_LDB(B0, 0, 0); PG8_SCHED; PG8_LDA(At, 0, 0); PG8_STAGE(PG8_SA(1, 1), a1 + hstepA, voffA);
            PG8_WAIT_L(8); PG8_BAR; PG8_WAIT_L(0); PG8_MMA(0, 0, At, B0); PG8_BAR; PG8_SCHED;
            PG8_LDB(B1, 0, 1); PG8_STAGE(PG8_SB(0, 0), b2, voffB);
            PG8_BAR; PG8_WAIT_L(0); PG8_MMA(0, 1, At, B1); PG8_BAR;
            PG8_LDA(At, 0, 1); PG8_STAGE(PG8_SA(0, 0), a2, voffA);
            PG8_BAR; PG8_WAIT_L(0); PG8_MMA(1, 0, At, B0); PG8_BAR; PG8_SCHED;
            PG8_STAGE(PG8_SB(0, 1), b2 + hstepB, voffB);
            PG8_WAIT_V(6); PG8_BAR; PG8_MMA(1, 1, At, B1); PG8_BAR;
            PG8_LDB(B0, 1, 0); PG8_SCHED; PG8_LDA(At, 1, 0); PG8_STAGE(PG8_SA(0, 1), a2 + hstepA, voffA);
            PG8_WAIT_L(8); PG8_BAR; PG8_WAIT_L(0); PG8_MMA(0, 0, At, B0); PG8_BAR; PG8_SCHED;
            PG8_LDB(B1, 1, 1); PG8_STAGE(PG8_SB(1, 0), b3, voffB);
            PG8_BAR; PG8_WAIT_L(0); PG8_MMA(0, 1, At, B1); PG8_BAR;
            PG8_LDA(At, 1, 1); PG8_STAGE(PG8_SA(1, 0), a3, voffA);
            PG8_BAR; PG8_WAIT_L(0); PG8_MMA(1, 0, At, B0); PG8_BAR; PG8_SCHED;
            PG8_STAGE(PG8_SB(1, 1), b3 + hstepB, voffB);
            PG8_WAIT_V(6); PG8_BAR; PG8_MMA(1, 1, At, B1); PG8_BAR;
        }
        if constexpr (!Epi::AFTER_DRAIN) E(acc, cur, wr, wc, fr, fq);
        if (!has_next) break;
#pragma unroll
        for (int a = 0; a < 2; ++a)
#pragma unroll
            for (int b = 0; b < 2; ++b)
#pragma unroll
                for (int m = 0; m < 4; ++m)
#pragma unroll
                    for (int n = 0; n < 2; ++n) acc[a][b][m][n] = (f32x4){0.f, 0.f, 0.f, 0.f};
        cur = nxt; cA = nA; cB = nB; ++ui;
    }
    PG8_WAIT_V(0);
    if (wr == 0) PG8_BAR;
    PG8_BAR;
    if constexpr (Epi::AFTER_DRAIN) E.fused(acc, cur, wr, wc, fr, fq);
#undef PG8_SA
#undef PG8_SB
#undef PG8_STAGE
#undef PG8_LDA
#undef PG8_LDB
#undef PG8_MMA
#undef PG8_WAIT_V
#undef PG8_WAIT_L
#undef PG8_BAR
#undef PG8_SCHED
}
}
using pg8::Unit;
typedef f32x4 AccT[2][2][4][2];

#define XB_TMO      128
#define XB_XCNT(j)  (256  + 64 * (j))
#define XB_XSUB(j)  (1280 + 64 * (j))
#define XB_XGEN(j)  (2304 + 64 * (j))
#define XB_TOP      3328
#define XB_TOPGEN   3392
#define XCD_BAR_WORDS 3456
#define XB_SPIN_CAP (1u << 18)

__device__ __forceinline__ unsigned xb_ld(unsigned* p)              { return __hip_atomic_load(p, __ATOMIC_RELAXED, __HIP_MEMORY_SCOPE_AGENT); }
__device__ __forceinline__ unsigned xb_add(unsigned* p, unsigned v) { return __hip_atomic_fetch_add(p, v, __ATOMIC_RELAXED, __HIP_MEMORY_SCOPE_AGENT); }
__device__ __forceinline__ unsigned xb_xcc_id() { return (unsigned)__builtin_amdgcn_s_getreg((3 << 11) | 20) & 0xFu; }
#define XB_SPIN(cond, bar) do { unsigned _sp = 0; while (cond) { __builtin_amdgcn_s_sleep(1); \
    if ((++_sp & 255u) == 0u) { if (xb_ld(&(bar)[XB_TMO])) break; if (_sp > XB_SPIN_CAP) { atomicAdd(&(bar)[XB_TMO], 1u); break; } } } } while (0)

struct XcdBarrier {
    unsigned* bar; unsigned x;
    volatile LAS unsigned* st;
};

__device__ __forceinline__ XcdBarrier xcd_barrier_post(unsigned* bar, volatile LAS unsigned* st) {
    XcdBarrier b; b.bar = bar; b.x = xb_xcc_id(); b.st = st;
    if (threadIdx.x == 0) (void)xb_add(&bar[XB_XCNT(b.x)], 1u);
    return b;
}
__device__ __forceinline__ void xcd_barrier_complete(unsigned* bar, unsigned x, unsigned& nloc, unsigned& nx) {
    const unsigned G = gridDim.x * gridDim.y * gridDim.z;
    unsigned sum, cnt, mine, sp = 0u;
    for (;;) {
        sum = 0u; cnt = 0u; mine = 0u;
#pragma unroll
        for (unsigned j = 0; j < 16; ++j) { const unsigned c = xb_ld(&bar[XB_XCNT(j)]); sum += c; cnt += (c > 0u) ? 1u : 0u; mine = (j == x) ? c : mine; }
        if (sum == G) break;
        __builtin_amdgcn_s_sleep(1);
        if ((++sp & 255u) == 0u) { if (xb_ld(&bar[XB_TMO])) break; if (sp > XB_SPIN_CAP) { atomicAdd(&bar[XB_TMO], 1u); break; } }
    }
    nloc = mine > 0u ? mine : 1u; nx = cnt > 0u ? cnt : 1u;
}

__device__ __forceinline__ void xcd_barrier(const XcdBarrier& b) {
    asm volatile("s_waitcnt vmcnt(0)" ::: "memory");
    __syncthreads();
    if (threadIdx.x == 0) {
        unsigned* bar = b.bar;
        __builtin_amdgcn_s_waitcnt(0);
        unsigned nloc = b.st[0], nx = b.st[1];
        if (nloc == 0u) { xcd_barrier_complete(bar, b.x, nloc, nx); b.st[0] = nloc; b.st[1] = nx; }
        const unsigned old = xb_add(&bar[XB_XSUB(b.x)], 1u);
        const unsigned gen = old / nloc;
        if (old + 1u == (gen + 1u) * nloc) {
            __builtin_amdgcn_fence(__ATOMIC_RELEASE, "agent");
            asm volatile("s_waitcnt vmcnt(0)" ::: "memory");
            const unsigned og = xb_add(&bar[XB_TOP], 1u);
            const unsigned tg = og / nx;
            if (og + 1u == (tg + 1u) * nx) xb_add(&bar[XB_TOPGEN], 1u);
            else XB_SPIN(xb_ld(&bar[XB_TOPGEN]) == tg, bar);
            __builtin_amdgcn_fence(__ATOMIC_ACQUIRE, "agent");
            xb_add(&bar[XB_XGEN(b.x)], 1u);
            asm volatile("s_waitcnt vmcnt(0)" ::: "memory");
        } else {
            XB_SPIN(xb_ld(&bar[XB_XGEN(b.x)]) == gen, bar);
            __builtin_amdgcn_fence(__ATOMIC_ACQUIRE, "agent");
            asm volatile("s_waitcnt vmcnt(0)" ::: "memory");
        }
    }
    __syncthreads();
}


struct EpiSwiglu {
    static constexpr bool PERM = true, AFTER_DRAIN = false;
    bf16_t* G; const float* ss;
    __device__ __forceinline__ void operator()(const AccT& acc, const Unit& u, int wr, int wc, int fr, int fq) const {
        const int row0 = u.pm * 256 + wr * 64 + fr, col0 = u.pn * 128 + wc * 32 + 8 * fq;
#pragma unroll
        for (int ai = 0; ai < 2; ++ai)
#pragma unroll
            for (int m = 0; m < 4; ++m) {
                const int row = row0 + ai * 128 + m * 16; const float rs = rs_of(ss[row]); float o[8];
#pragma unroll
                for (int n = 0; n < 2; ++n)
#pragma unroll
                    for (int j = 0; j < 4; j += 2) {
                        const float a1 = acc[ai][0][m][n][j] * rs, b1 = acc[ai][0][m][n][j + 1] * rs;
                        const float d0 = 1.0f + __expf(-fmaxf(a1, -40.f)), d1 = 1.0f + __expf(-fmaxf(b1, -40.f));
                        const float r = __builtin_amdgcn_rcpf(d0 * d1);
                        o[4 * n + j] = a1 * (r * d1) * (acc[ai][1][m][n][j] * rs); o[4 * n + j + 1] = b1 * (r * d0) * (acc[ai][1][m][n][j + 1] * rs); }
                *(u32x4*)(G + (size_t)row * DFF + col0) = pack8(o);
            }
    }
};
template <bool WB> struct EpiResid {
    static constexpr bool PERM = true, AFTER_DRAIN = false;
    const float* base; float* X; bf16_t* Xb; float* ss; float scale;
    __device__ __forceinline__ void operator()(const AccT& acc, const Unit& u, int wr, int wc, int fr, int fq) const {
        const int row0 = u.pm * 256 + wr * 64 + fr, col0 = u.pn * 256 + wc * 32 + 8 * fq;
#pragma unroll
        for (int ai = 0; ai < 2; ++ai)
#pragma unroll
            for (int m = 0; m < 4; ++m) {
                const int row = row0 + ai * 128 + m * 16; float sq = 0.f;
#pragma unroll
                for (int bj = 0; bj < 2; ++bj) {
                    const size_t off = (size_t)row * DM + col0 + bj * 128;
                    const f32x4 b0 = *(const f32x4*)(base + off), b1 = *(const f32x4*)(base + off + 4);
                    const f32x4 v0 = b0 + scale * acc[ai][bj][m][0], v1 = b1 + scale * acc[ai][bj][m][1];
                    *(f32x4*)(X + off) = v0; *(f32x4*)(X + off + 4) = v1;
                    sq += (v0[0] * v0[0] + v0[1] * v0[1]) + (v0[2] * v0[2] + v0[3] * v0[3]) + (v1[0] * v1[0] + v1[1] * v1[1]) + (v1[2] * v1[2] + v1[3] * v1[3]);
                    if (WB) { u32x4 w; w.x = cvt_pk_bf16(v0[0], v0[1]); w.y = cvt_pk_bf16(v0[2], v0[3]); w.z = cvt_pk_bf16(v1[0], v1[1]); w.w = cvt_pk_bf16(v1[2], v1[3]); *(u32x4*)(Xb + off) = w; }
                }
                sq += __shfl_xor(sq, 16); sq += __shfl_xor(sq, 32);
                if (fq == 0) unsafeAtomicAdd(ss + row, sq);
            }
    }
};
struct EpiInproj {
    static constexpr bool PERM = true, AFTER_DRAIN = false;
    bf16_t *q, *xl; const float *ss, *cs, *sn;
    __device__ __forceinline__ void operator()(const AccT& acc, const Unit& u, int wr, int wc, int fr, int fq) const {
        const int row0 = u.pm * 256 + wr * 64 + fr, p0 = wc * 32 + 8 * fq, pn = u.pn;
        if (pn < 4) {
            bf16_t* dst = q + (size_t)(pn >> 1) * ((size_t)T_TOK * 512); const float sc = pn < 2 ? 1.0f : 0.08838834764831845f;
            const int head = 2 * (pn & 1) + (p0 >> 6), d0 = p0 & 63;
#pragma unroll
            for (int ai = 0; ai < 2; ++ai)
#pragma unroll
                for (int m = 0; m < 4; ++m) {
                    const int row = row0 + ai * 128 + m * 16; const float rs = rs_of(ss[row]) * sc; const int pos = row & (SEQ - 1);
                    const float* cp = cs + pos * 64 + d0; const float* sp = sn + pos * 64 + d0;
                    bf16_t* dp = dst + (size_t)row * 512 + head * 128 + d0;
#pragma unroll
                    for (int n = 0; n < 2; ++n) {
                        const f32x4 c = *(const f32x4*)(cp + 4 * n), s = *(const f32x4*)(sp + 4 * n);
                        const f32x4 t1 = acc[ai][0][m][n] * rs, t2 = acc[ai][1][m][n] * rs;
                        const f32x4 o1 = t1 * c - t2 * s, o2 = t2 * c + t1 * s;
                        u32x2 w1, w2; w1.x = cvt_pk_bf16(o1[0], o1[1]); w1.y = cvt_pk_bf16(o1[2], o1[3]); w2.x = cvt_pk_bf16(o2[0], o2[1]); w2.y = cvt_pk_bf16(o2[2], o2[3]);
                        *(u32x2*)(dp + 4 * n) = w1; *(u32x2*)(dp + 64 + 4 * n) = w2;
                    }
                    __builtin_amdgcn_sched_barrier(0);
                }
        } else {
            const int seg = (pn - 4) >> 2; bf16_t* dst = xl + (size_t)seg * ((size_t)T_TOK * DM); const int colb = ((pn - 4) & 3) * 256 + p0;
#pragma unroll
            for (int ai = 0; ai < 2; ++ai)
#pragma unroll
                for (int m = 0; m < 4; ++m) {
                    const int row = row0 + ai * 128 + m * 16; const float rs = rs_of(ss[row]);
#pragma unroll
                    for (int bj = 0; bj < 2; ++bj) {
                        float o[8];
#pragma unroll
                        for (int n = 0; n < 2; ++n)
#pragma unroll
                            for (int j = 0; j < 4; j += 2) { float a = acc[ai][bj][m][n][j] * rs, b = acc[ai][bj][m][n][j + 1] * rs;
                                if (seg == 2) { const float ua = 1.5957691216057308f * (a + 0.044715f * a * a * a), ub = 1.5957691216057308f * (b + 0.044715f * b * b * b);
                                    float sa, sb; sigmoid2(ua, ub, sa, sb); a *= sa; b *= sb; }
                                o[4 * n + j] = a; o[4 * n + j + 1] = b; }
                        *(u32x4*)(dst + (size_t)row * DM + colb + bj * 128) = pack8(o);
                    }
                }
        }
    }
};
struct EpiGG {
    static constexpr bool PERM = true, AFTER_DRAIN = false;
    bf16_t* aret; bf16_t* gates; const float *ss, *stats, *gn, *bg;
    __device__ __forceinline__ void operator()(const AccT& acc, const Unit& u, int wr, int wc, int fr, int fq) const {
        const int row0 = u.pm * 256 + wr * 64 + fr, p0 = wc * 32 + 8 * fq, pn = u.pn;
        if (pn < 4) {
#pragma unroll
            for (int ai = 0; ai < 2; ++ai)
#pragma unroll
                for (int m = 0; m < 4; ++m) {
                    const int row = row0 + ai * 128 + m * 16; const float rs = rs_of(ss[row]);
                    const float s1 = stats[((size_t)row * 4 + pn) * 2], s2 = stats[((size_t)row * 4 + pn) * 2 + 1];
                    const float mu = s1 * (1.0f / 256.0f); const float var = fmaxf(s2 * (1.0f / 256.0f) - mu * mu, 0.f); const float rstd = rsqrtf(var + EPS);
#pragma unroll
                    for (int bj = 0; bj < 2; ++bj) {
                        const int col = pn * 256 + bj * 128 + p0; bf16_t* rp = aret + (size_t)row * DM + col;
                        float r[8], o[8]; unpack8(*(const u32x4*)rp, r);
                        const f32x4 g0 = *(const f32x4*)(gn + col), g1 = *(const f32x4*)(gn + col + 4);
#pragma unroll
                        for (int n = 0; n < 2; ++n)
#pragma unroll
                            for (int j = 0; j < 4; j += 2) { const float a = acc[ai][bj][m][n][j] * rs, b = acc[ai][bj][m][n][j + 1] * rs; float sa, sb; sigmoid2(a, b, sa, sb);
                                o[4 * n + j] = a * sa * (n ? g1[j] : g0[j]) * (r[4 * n + j] - mu) * rstd; o[4 * n + j + 1] = b * sb * (n ? g1[j + 1] : g0[j + 1]) * (r[4 * n + j + 1] - mu) * rstd; }
                        *(u32x4*)rp = pack8(o);
                    }
                }
        } else {
#pragma unroll
            for (int ai = 0; ai < 2; ++ai)
#pragma unroll
                for (int m = 0; m < 4; ++m) {
                    const int row = row0 + ai * 128 + m * 16; const float rs = rs_of(ss[row]);
#pragma unroll
                    for (int bj = 0; bj < 2; ++bj) {
                        const int col = (pn - 4) * 256 + bj * 128 + p0; float o[8];
                        const f32x4 b0 = *(const f32x4*)(bg + col), b1 = *(const f32x4*)(bg + col + 4);
#pragma unroll
                        for (int n = 0; n < 2; ++n)
#pragma unroll
                            for (int j = 0; j < 4; j += 2) sigmoid2(acc[ai][bj][m][n][j] * rs + (n ? b1[j] : b0[j]), acc[ai][bj][m][n][j + 1] * rs + (n ? b1[j + 1] : b0[j + 1]), o[4 * n + j], o[4 * n + j + 1]);
                        *(u32x4*)(gates + (size_t)row * 2048 + col) = pack8(o);
                    }
                }
        }
    }
};
template <bool SECOND> struct EpiMerge {
    static constexpr bool PERM = true, AFTER_DRAIN = false;
    bf16_t* merged; const bf16_t* gates;
    __device__ __forceinline__ void operator()(const AccT& acc, const Unit& u, int wr, int wc, int fr, int fq) const {
        const int row0 = u.pm * 256 + wr * 64 + fr, col0 = u.pn * 256 + wc * 32 + 8 * fq;
#pragma unroll
        for (int ai = 0; ai < 2; ++ai)
#pragma unroll
            for (int m = 0; m < 4; ++m) {
                const int row = row0 + ai * 128 + m * 16;
#pragma unroll
                for (int bj = 0; bj < 2; ++bj) {
                    const int col = col0 + bj * 128; float g[8], o[8];
                    unpack8(*(const u32x4*)(gates + (size_t)row * 2048 + (SECOND ? 1024 : 0) + col), g);
                    bf16_t* mp = merged + (size_t)row * DM + col;
                    if (SECOND) unpack8(*(const u32x4*)mp, o);
#pragma unroll
                    for (int n = 0; n < 2; ++n)
#pragma unroll
                        for (int j = 0; j < 4; ++j) { const float t = g[4 * n + j] * acc[ai][bj][m][n][j]; o[4 * n + j] = SECOND ? o[4 * n + j] + t : t; }
                    *(u32x4*)mp = pack8(o);
                }
            }
    }
};
struct EpiScale {
    static constexpr bool PERM = true, AFTER_DRAIN = false;
    bf16_t* O; int ldc; const float* ss; float sc;
    __device__ __forceinline__ void operator()(const AccT& acc, const Unit& u, int wr, int wc, int fr, int fq) const {
        const int row0 = u.pm * 256 + wr * 64 + fr, col0 = u.pn * 256 + wc * 32 + 8 * fq;
#pragma unroll
        for (int ai = 0; ai < 2; ++ai)
#pragma unroll
            for (int m = 0; m < 4; ++m) {
                const int row = row0 + ai * 128 + m * 16; const float rs = rs_of(ss[row]) * sc;
#pragma unroll
                for (int bj = 0; bj < 2; ++bj) { float o[8];
#pragma unroll
                    for (int n = 0; n < 2; ++n)
#pragma unroll
                        for (int j = 0; j < 4; ++j) o[4 * n + j] = acc[ai][bj][m][n][j] * rs;
                    *(u32x4*)(O + (size_t)row * ldc + col0 + bj * 128) = pack8(o); }
            }
    }
};

struct EpiFinal {
    static constexpr bool PERM = true, AFTER_DRAIN = true;
    float* X; float* ss; const float* gfin; XcdBarrier xb;
    __device__ __forceinline__ void fused(AccT& acc, const Unit& u, int wr, int wc, int fr, int fq) const {
        const int row0 = u.pm * 256 + wr * 64 + fr, col0 = u.pn * 256 + wc * 32 + 8 * fq;
#pragma unroll
        for (int ai = 0; ai < 2; ++ai)
#pragma unroll
            for (int m = 0; m < 4; ++m) {
                const int row = row0 + ai * 128 + m * 16; float sq = 0.f;
#pragma unroll
                for (int bj = 0; bj < 2; ++bj) {
                    const size_t off = (size_t)row * DM + col0 + bj * 128;
                    const f32x4 v0 = *(const f32x4*)(X + off) + 0.5f * acc[ai][bj][m][0], v1 = *(const f32x4*)(X + off + 4) + 0.5f * acc[ai][bj][m][1];
                    acc[ai][bj][m][0] = v0; acc[ai][bj][m][1] = v1;
                    sq += (v0[0] * v0[0] + v0[1] * v0[1]) + (v0[2] * v0[2] + v0[3] * v0[3]) + (v1[0] * v1[0] + v1[1] * v1[1]) + (v1[2] * v1[2] + v1[3] * v1[3]);
                }
                sq += __shfl_xor(sq, 16); sq += __shfl_xor(sq, 32);
                if (fq == 0) unsafeAtomicAdd(ss + row, sq);
            }
        xcd_barrier(xb);
#pragma unroll
        for (int ai = 0; ai < 2; ++ai)
#pragma unroll
            for (int m = 0; m < 4; ++m) {
                const int row = row0 + ai * 128 + m * 16; const float rs = rs_of(ss[row]);
#pragma unroll
                for (int bj = 0; bj < 2; ++bj) {
                    const size_t off = (size_t)row * DM + col0 + bj * 128; const int col = col0 + bj * 128;
                    const f32x4 g0 = *(const f32x4*)(gfin + col), g1 = *(const f32x4*)(gfin + col + 4);
                    *(f32x4*)(X + off) = acc[ai][bj][m][0] * rs * g0; *(f32x4*)(X + off + 4) = acc[ai][bj][m][1] * rs * g1;
                }
            }
    }
};
struct RowSrc { const float* p; int ld; };
template <class F>
__device__ __forceinline__ void wprep(LAS unsigned char* lds, bf16_t* dst, int nrows, int K, const float* gain, F rowsrc, int b0 = (int)blockIdx.x, int nb = (int)gridDim.x) {
    LAS float* tile = (LAS float*)lds;
    const int tid = threadIdx.x, kk = tid >> 4, r4 = (tid & 15) * 4;
    const int ntk = K / 128, ntiles = (nrows / 64) * ntk;
    f32x4 cur[4], nxt[4];
    auto fetch = [&](int t, f32x4 (&v)[4]) {
        const int r0 = (t / ntk) * 64, k0 = (t % ntk) * 128; const RowSrc rs = rowsrc(r0 + r4);
#pragma unroll
        for (int it = 0; it < 4; ++it) { const int k = k0 + kk + 32 * it; f32x4 x = *(const f32x4*)(rs.p + (size_t)k * rs.ld); if (gain) x *= gain[k]; v[it] = x; }
    };
    int t = b0;
    if (t < ntiles) fetch(t, cur);
    for (; t < ntiles; t += nb) {
        const int tn = t + nb;
        if (tn < ntiles) fetch(tn, nxt);
        const int r0 = (t / ntk) * 64, k0 = (t % ntk) * 128;
        __syncthreads();
#pragma unroll
        for (int it = 0; it < 4; ++it)
#pragma unroll
            for (int j = 0; j < 4; ++j) tile[(r4 + j) * 129 + kk + 32 * it] = cur[it][j];
        __syncthreads();
        const int row = tid >> 3, ch = tid & 7;
#pragma unroll
        for (int hf = 0; hf < 2; ++hf) { float o[8];
#pragma unroll
            for (int j = 0; j < 8; ++j) o[j] = tile[row * 129 + hf * 64 + ch * 8 + j];
            *(u32x4*)(dst + (size_t)(r0 + row) * K + k0 + hf * 64 + ch * 8) = pack8(o); }
#pragma unroll
        for (int it = 0; it < 4; ++it) cur[it] = nxt[it];
    }
    __syncthreads();
}

__device__ __forceinline__ void rows_prep(const float* src, bf16_t* dst, float* ss, int nrows) {
    const int lane = threadIdx.x & 63, gw = blockIdx.x * 8 + (threadIdx.x >> 6), nw = gridDim.x * 8;
    for (int r = gw; r < nrows; r += nw) {
        const float* sp = src + (size_t)r * DM; float sq = 0.f;
#pragma unroll
        for (int i = 0; i < 2; ++i) {
            const int c = (i * 64 + lane) * 8;
            const f32x4 a = *(const f32x4*)(sp + c), b = *(const f32x4*)(sp + c + 4);
            sq += (a[0] * a[0] + a[1] * a[1]) + (a[2] * a[2] + a[3] * a[3]) + (b[0] * b[0] + b[1] * b[1]) + (b[2] * b[2] + b[3] * b[3]);
            u32x4 w; w.x = cvt_pk_bf16(a[0], a[1]); w.y = cvt_pk_bf16(a[2], a[3]); w.z = cvt_pk_bf16(b[0], b[1]); w.w = cvt_pk_bf16(b[2], b[3]);
            *(u32x4*)(dst + (size_t)r * DM + c) = w;
        }
#pragma unroll
        for (int o = 32; o >= 1; o >>= 1) sq += __shfl_xor(sq, o);
        if (lane == 0) ss[r] = sq;
    }
}

__device__ __forceinline__ bf16x8 tr_frag(LAS unsigned char* tile, int stride, int k0, int x0, int lane) {
    const int g = lane >> 4, ii = lane & 15, q = ii >> 2, p = ii & 3;
    LAS unsigned char* a = tile + (k0 + 8 * g + q) * stride + (x0 + 4 * p) * 2;
    const s16x4 lo = __builtin_amdgcn_ds_read_tr16_b64_v4i16((LAS s16x4*)a);
    const s16x4 hi = __builtin_amdgcn_ds_read_tr16_b64_v4i16((LAS s16x4*)(a + 4 * stride));
    bf16x8 r; r[0] = lo[0]; r[1] = lo[1]; r[2] = lo[2]; r[3] = lo[3]; r[4] = hi[0]; r[5] = hi[1]; r[6] = hi[2]; r[7] = hi[3]; return r;
}
__device__ __forceinline__ bf16x8 scale_frag(bf16x8 f, const float* s) {
    u32x4 w = __builtin_bit_cast(u32x4, f); float o[8]; unpack8(w, o);
#pragma unroll
    for (int j = 0; j < 8; ++j) o[j] *= s[j];
    return __builtin_bit_cast(bf16x8, pack8(o));
}

constexpr int R_KT = 0, R_KS = 272;
constexpr int R_VT = 128 * 272, R_VS = 144;
constexpr int R_SB = R_VT + 128 * 144;
constexpr int R_PW = R_SB + 128 * 144;
static_assert(R_PW + 8 * 16 * 272 <= LDS_BYTES, "ret lds");
__device__ __forceinline__ void retention_item(LAS unsigned char* lds, int item, const bf16_t* qb, const bf16_t* kb, bf16_t* vb  , float* stats) {
    int tid = threadIdx.x; asm volatile("" : "+v"(tid));
    const int wid = tid >> 6, lane = tid & 63, fr = lane & 15, fg = lane >> 4;
    const int widu = __builtin_amdgcn_readfirstlane(tid >> 6);
    const int b = item >> 4, h = (item >> 2) & 3, es = item & 3;
    const float l2g = __log2f(1.0f - exp2f(-5.0f - (float)h));
    const float cd = exp2f(128.0f * l2g);
    const size_t tok0 = (size_t)b * SEQ;
    LAS unsigned char* Pw = lds + R_PW + wid * (16 * 272);
    f32x4 st[4];
#pragma unroll
    for (int e = 0; e < 4; ++e) st[e] = (f32x4){0.f, 0.f, 0.f, 0.f};
    u32x4 kreg[4], vreg[2], qnext[4], qf[4];
    auto issue = [&](int n) {
        const size_t t0 = tok0 + (size_t)n * 128;
#pragma unroll
        for (int i = 0; i < 4; ++i) { const int c = tid + 512 * i, row = c >> 4, c16 = c & 15; kreg[i] = *(const u32x4*)(kb + (t0 + row) * 512 + h * 128 + c16 * 8); }
#pragma unroll
        for (int i = 0; i < 2; ++i) { const int c = tid + 512 * i, row = c >> 3, c8 = c & 7; vreg[i] = *(const u32x4*)(vb + (t0 + row) * DM + h * 256 + es * 64 + c8 * 8); }
#pragma unroll
        for (int s = 0; s < 4; ++s) qnext[s] = *(const u32x4*)(qb + (t0 + wid * 16 + fr) * 512 + h * 128 + s * 32 + fg * 8);
    };
    issue(0);
    const float qdec = exp2f((float)(wid * 16 + fr + 1) * l2g);
    for (int n = 0; n < 16; ++n) {
        float l2 = l2g; asm volatile("" : "+v"(l2));
        int irow = wid * 16 + fr, fgl = fg; asm volatile("" : "+v"(irow), "+v"(fgl));
        lds_barrier();
#pragma unroll
        for (int i = 0; i < 4; ++i) { const int c = tid + 512 * i, row = c >> 4, c16 = c & 15; *(LAS u32x4*)(lds + R_KT + row * R_KS + c16 * 16) = kreg[i]; }
#pragma unroll
        for (int i = 0; i < 2; ++i) { const int c = tid + 512 * i, row = c >> 3, c8 = c & 7; *(LAS u32x4*)(lds + R_VT + row * R_VS + c8 * 16) = vreg[i]; }
#pragma unroll
        for (int e = 0; e < 4; ++e) { u32x2 w; w.x = cvt_pk_bf16(st[e][0], st[e][1]); w.y = cvt_pk_bf16(st[e][2], st[e][3]);
            *(LAS u32x2*)(lds + R_SB + (wid * 16 + fr) * R_VS + (e * 16 + fg * 4) * 2) = w; }
#pragma unroll
        for (int s = 0; s < 4; ++s) qf[s] = qnext[s];
        if (n + 1 < 16) issue(n + 1);
        lds_barrier();
        {
#pragma unroll
            for (int jf = 0; jf < 8; ++jf) {
                if (jf > (widu | 1)) break;
                f32x4 sc = (f32x4){0.f, 0.f, 0.f, 0.f};
#pragma unroll
                for (int s = 0; s < 4; ++s) {
                    const bf16x8 a = *(const LAS bf16x8*)(lds + R_KT + (jf * 16 + fr) * R_KS + (s * 32 + fg * 8) * 2);
                    sc = __builtin_amdgcn_mfma_f32_16x16x32_bf16(a, __builtin_bit_cast(bf16x8, qf[s]), sc, 0, 0, 0);
                }
                float pv[4];
#pragma unroll
                for (int r = 0; r < 4; ++r) { const int j = jf * 16 + fgl * 4 + r; const int dlt = irow - j; pv[r] = dlt >= 0 ? sc[r] * __builtin_amdgcn_exp2f((float)dlt * l2) : 0.f; }
                u32x2 w; w.x = cvt_pk_bf16(pv[0], pv[1]); w.y = cvt_pk_bf16(pv[2], pv[3]);
                *(LAS u32x2*)(Pw + fr * 272 + (jf * 16 + fg * 4) * 2) = w;
                __builtin_amdgcn_sched_barrier(0);
            }
        }
        asm volatile("s_waitcnt lgkmcnt(0)" ::: "memory");
        {
            f32x4 o[4];
#pragma unroll
            for (int e = 0; e < 4; ++e) { o[e] = (f32x4){0.f, 0.f, 0.f, 0.f}; st[e] *= cd; }
#pragma unroll
            for (int s = 0; s < 4; ++s) {
                const bf16x8 pf = *(const LAS bf16x8*)(Pw + fr * 272 + (s * 32 + fg * 8) * 2);
                float kd[8];
#pragma unroll
                for (int j = 0; j < 8; ++j) kd[j] = __builtin_amdgcn_exp2f((float)(127 - (s * 32 + fgl * 8 + j)) * l2);
                const bf16x8 kf = scale_frag(tr_frag(lds + R_KT, R_KS, s * 32, wid * 16, lane), kd);
                float qs[8];
#pragma unroll
                for (int j = 0; j < 8; ++j) qs[j] = qdec;
                const bf16x8 qsf = scale_frag(__builtin_bit_cast(bf16x8, qf[s]), qs);
#pragma unroll
                for (int e = 0; e < 4; ++e) {
                    const bf16x8 vf = tr_frag(lds + R_VT, R_VS, s * 32, e * 16, lane);
                    if (s <= (widu >> 1)) o[e] = __builtin_amdgcn_mfma_f32_16x16x32_bf16(vf, pf, o[e], 0, 0, 0);
                    st[e] = __builtin_amdgcn_mfma_f32_16x16x32_bf16(vf, kf, st[e], 0, 0, 0);
                    const bf16x8 sf = tr_frag(lds + R_SB, R_VS, s * 32, e * 16, lane);
                    o[e] = __builtin_amdgcn_mfma_f32_16x16x32_bf16(sf, qsf, o[e], 0, 0, 0);
                }
                __builtin_amdgcn_sched_barrier(0);
            }
            const size_t tok = tok0 + (size_t)n * 128 + wid * 16 + fr;
            float s1 = 0.f, s2 = 0.f;
#pragma unroll
            for (int e = 0; e < 4; ++e) {
                u32x2 w; w.x = cvt_pk_bf16(o[e][0], o[e][1]); w.y = cvt_pk_bf16(o[e][2], o[e][3]);
                *(u32x2*)(vb + tok * DM + h * 256 + es * 64 + e * 16 + fg * 4) = w;
                s1 += (o[e][0] + o[e][1]) + (o[e][2] + o[e][3]);
                s2 += (o[e][0] * o[e][0] + o[e][1] * o[e][1]) + (o[e][2] * o[e][2] + o[e][3] * o[e][3]);
            }
            s1 += __shfl_xor(s1, 16); s1 += __shfl_xor(s1, 32); s2 += __shfl_xor(s2, 16); s2 += __shfl_xor(s2, 32);
            if (fg == 0) { unsafeAtomicAdd(stats + (tok * 4 + h) * 2, s1); unsafeAtomicAdd(stats + (tok * 4 + h) * 2 + 1, s2); }
        }
    }
    lds_barrier();
}

constexpr int L_XC = 0;
constexpr int L_WL = 128 * 272;
constexpr int L_SA = L_WL + 128 * 272;
constexpr int L_SBX = L_SA + 32768;
constexpr int L_SEGA = L_SBX + 32768;
constexpr int L_SEGB = L_SEGA + 2048;
constexpr int L_CARRY = L_SEGB + 2048;
constexpr int L_CW = L_CARRY + 512;
static_assert(L_CW + 5 * 512 <= LDS_BYTES - 16, "lru lds");
__device__ __forceinline__ void lru_item(LAS unsigned char* lds, int item, const bf16_t* xl, bf16_t* gg  , const bf16_t* wlru,
                                         const float* conv_w, const float* conv_b, const float* b_r, const float* b_i, const float* lam) {
    int tid = threadIdx.x; asm volatile("" : "+v"(tid));
    const int wid = tid >> 6, lane = tid & 63, fr = lane & 15, fg = lane >> 4;
    const int b = item >> 4, g = (item >> 1) & 7, hf2 = item & 1;
    const int chg = g * 128, c0 = chg + hf2 * 64;
    const size_t tok0 = (size_t)b * SEQ;
    for (int c = tid; c < 128 * 16; c += 512) { const int n = c >> 4, c16 = c & 15; const bf16_t* src = wlru + ((size_t)(n >> 6) * 1024 + c0 + (n & 63)) * 128 + c16 * 8;
        *(LAS u32x4*)(lds + L_WL + n * 272 + c16 * 16) = *(const u32x4*)src; }
    if (tid < 64) ((LAS float*)(lds + L_CARRY))[tid] = 0.f;
    const int ch8 = tid & 15;
    for (int c = tid; c < 5 * 128; c += 512) ((LAS float*)(lds + L_CW))[c] = c < 512 ? conv_w[(c >> 7) * DM + chg + (c & 127)] : conv_b[chg + (c & 127)];
    float br_[4], bi_[4], sp_[4];
#pragma unroll
    for (int hf = 0; hf < 4; ++hf) { const int ch = c0 + hf * 16 + fr; br_[hf] = b_r[ch]; bi_[hf] = b_i[ch]; sp_[hf] = log1pf(__expf(-lam[ch])); }
    u32x4 rwn[7];
    auto load_rows = [&](int T0n) {
        const int tk0 = (tid >> 4) * 4;
#pragma unroll
        for (int q = 0; q < 7; ++q) { const int ts = T0n + tk0 - 3 + q; rwn[q] = ts >= 0 ? *(const u32x4*)(xl + (tok0 + ts) * DM + chg + ch8 * 8) : (u32x4){0u, 0u, 0u, 0u}; }
    };
    load_rows(0);
    for (int tile = 0; tile < 16; ++tile) {
        const int T0 = tile * 128;
        bf16_t gpre[16];
#pragma unroll
        for (int t = 0; t < 16; ++t) gpre[t] = gg[(tok0 + T0 + wid * 16 + t) * DM + c0 + lane];
        {
            const int tk0 = (tid >> 4) * 4;
            float acc8[4][8], cw[4][8];
            { const f32x4 b0 = *(const LAS f32x4*)(lds + L_CW + 2048 + ch8 * 32), b1 = *(const LAS f32x4*)(lds + L_CW + 2048 + ch8 * 32 + 16);
#pragma unroll
              for (int i = 0; i < 4; ++i)
#pragma unroll
                for (int j = 0; j < 4; ++j) { acc8[i][j] = b0[j]; acc8[i][4 + j] = b1[j]; } }
#pragma unroll
            for (int t = 0; t < 4; ++t) { const f32x4 w0 = *(const LAS f32x4*)(lds + L_CW + t * 512 + ch8 * 32), w1 = *(const LAS f32x4*)(lds + L_CW + t * 512 + ch8 * 32 + 16);
#pragma unroll
                for (int j = 0; j < 4; ++j) { cw[t][j] = w0[j]; cw[t][4 + j] = w1[j]; } }
#pragma unroll
            for (int q = 0; q < 7; ++q) { float x[8]; unpack8(rwn[q], x);
#pragma unroll
                for (int i = 0; i < 4; ++i) { const int tap = q - i;
                    if (tap >= 0 && tap < 4) {
#pragma unroll
                        for (int j = 0; j < 8; ++j) acc8[i][j] += cw[tap][j] * x[j]; } } }
#pragma unroll
            for (int i = 0; i < 4; ++i) *(LAS u32x4*)(lds + L_XC + (tk0 + i) * 272 + ch8 * 16) = pack8(acc8[i]);
            if (tile + 1 < 16) load_rows(T0 + 128);
        }
        lds_barrier();
        {
            f32x4 ga[8];
#pragma unroll
            for (int nf = 0; nf < 8; ++nf) ga[nf] = (f32x4){0.f, 0.f, 0.f, 0.f};
#pragma unroll
            for (int s = 0; s < 4; ++s) {
                const bf16x8 af = *(const LAS bf16x8*)(lds + L_XC + (wid * 16 + fr) * 272 + (s * 32 + fg * 8) * 2);
#pragma unroll
                for (int nf = 0; nf < 8; ++nf) {
                    const bf16x8 bfr = *(const LAS bf16x8*)(lds + L_WL + (nf * 16 + fr) * 272 + (s * 32 + fg * 8) * 2);
                    ga[nf] = __builtin_amdgcn_mfma_f32_16x16x32_bf16(af, bfr, ga[nf], 0, 0, 0);
                }
            }
#pragma unroll
            for (int hf = 0; hf < 4; ++hf)
#pragma unroll
                for (int r = 0; r < 4; ++r) {
                    const int tk = wid * 16 + fg * 4 + r, cl = hf * 16 + fr;
                    float rg, ig; sigmoid2(ga[hf][r] + br_[hf], ga[4 + hf][r] + bi_[hf], rg, ig);
                    const float la = -8.0f * rg * sp_[hf]; const float a = __expf(la); const float mult = __builtin_amdgcn_sqrtf(fmaxf(fmaf(-a, a, 1.0f), 0.f));
                    const float x = bf2f(*(const LAS bf16_t*)(lds + L_XC + tk * 272 + (hf2 * 64 + cl) * 2));
                    ((LAS float*)(lds + L_SA))[tk * 64 + cl] = a; ((LAS float*)(lds + L_SBX))[tk * 64 + cl] = mult * ig * x;
                }
        }
        asm volatile("s_waitcnt lgkmcnt(0)" ::: "memory");
        {
            const int c = lane, sg = wid;
            float A = 1.f, B = 0.f;
#pragma unroll
            for (int t = 0; t < 16; ++t) { const float a_ = ((LAS float*)(lds + L_SA))[(sg * 16 + t) * 64 + c], b_ = ((LAS float*)(lds + L_SBX))[(sg * 16 + t) * 64 + c]; A *= a_; B = a_ * B + b_; }
            ((LAS float*)(lds + L_SEGA))[sg * 64 + c] = A; ((LAS float*)(lds + L_SEGB))[sg * 64 + c] = B;
            lds_barrier();
            float hst = ((LAS float*)(lds + L_CARRY))[(tile & 1) * 64 + c];
            { float sa_[7], sb_[7];
#pragma unroll
              for (int s2 = 0; s2 < 7; ++s2) { sa_[s2] = ((LAS float*)(lds + L_SEGA))[s2 * 64 + c]; sb_[s2] = ((LAS float*)(lds + L_SEGB))[s2 * 64 + c]; }
#pragma unroll
              for (int s2 = 0; s2 < 7; ++s2) hst = s2 < sg ? sa_[s2] * hst + sb_[s2] : hst; }
#pragma unroll
            for (int t = 0; t < 16; ++t) {
                hst = ((LAS float*)(lds + L_SA))[(sg * 16 + t) * 64 + c] * hst + ((LAS float*)(lds + L_SBX))[(sg * 16 + t) * 64 + c];
                gg[(tok0 + T0 + sg * 16 + t) * DM + c0 + c] = (bf16_t)(cvt_pk_bf16(hst * bf2f(gpre[t]), 0.f) & 0xffffu);
            }
            if (sg == 7) ((LAS float*)(lds + L_CARRY))[((tile + 1) & 1) * 64 + c] = hst;
        }
    }
    lds_barrier();
}

constexpr int X_T = 0, X_TS = 528;
constexpr int X_VS = 272;
constexpr int X_PW = 256 * 272;
constexpr int X_SCR = X_PW + 8 * 16 * 272;
static_assert(128 * 528 <= X_PW && X_SCR + 8 * 256 <= 128 * 1024, "xattn lds");
__device__ __forceinline__ void xattn_item(LAS unsigned char* lds, int item, const bf16_t* xq, const bf16_t* xkv, bf16_t* xo) {
    const int tid = threadIdx.x, wid = tid >> 6, lane = tid & 63, fr = lane & 15, fg = lane >> 4;
    const int b = item >> 6, h = (item >> 4) & 3, qt = item & 15;
    const size_t tok = (size_t)b * SEQ + qt * 128 + wid * 16 + fr;
    LAS unsigned char* Pw = lds + X_PW + wid * (16 * 272);
    bf16x8 qf[8];
#pragma unroll
    for (int s = 0; s < 8; ++s) qf[s] = __builtin_bit_cast(bf16x8, *(const u32x4*)(xq + tok * DM + h * 256 + s * 32 + fg * 8));
    f32x4 sc[16];
#pragma unroll
    for (int mt = 0; mt < 2; ++mt) {
        lds_barrier();
#pragma unroll
        for (int i = 0; i < 8; ++i) { const int c = tid + 512 * i, row = c >> 5, c16 = c & 31;
            *(LAS u32x4*)(lds + X_T + row * X_TS + c16 * 16) = *(const u32x4*)(xkv + ((size_t)b * 256 + mt * 128 + row) * 2048 + h * 256 + c16 * 8); }
        lds_barrier();
#pragma unroll
        for (int mf = 0; mf < 8; ++mf) {
            f32x4 a4 = (f32x4){0.f, 0.f, 0.f, 0.f};
#pragma unroll
            for (int s = 0; s < 8; ++s) {
                const bf16x8 kf = *(const LAS bf16x8*)(lds + X_T + (mf * 16 + fr) * X_TS + (s * 32 + fg * 8) * 2);
                a4 = __builtin_amdgcn_mfma_f32_16x16x32_bf16(kf, qf[s], a4, 0, 0, 0);
            }
            sc[mt * 8 + mf] = a4;
        }
    }
    float mx = -3.0e38f;
#pragma unroll
    for (int f = 0; f < 16; ++f) mx = fmaxf(mx, fmaxf(fmaxf(sc[f][0], sc[f][1]), fmaxf(sc[f][2], sc[f][3])));
    volatile LAS float* scr = (volatile LAS float*)(lds + X_SCR) + wid * 64;
    scr[lane] = mx;
    { const float m0 = scr[fr], m1 = scr[fr + 16], m2 = scr[fr + 32], m3 = scr[fr + 48]; mx = fmaxf(fmaxf(m0, m1), fmaxf(m2, m3)); }
    float sum = 0.f;
#pragma unroll
    for (int f = 0; f < 16; ++f)
#pragma unroll
        for (int r = 0; r < 4; ++r) { const float pe = __expf(sc[f][r] - mx); sc[f][r] = pe; sum += pe; }
    scr[lane] = sum;
    { const float m0 = scr[fr], m1 = scr[fr + 16], m2 = scr[fr + 32], m3 = scr[fr + 48]; sum = (m0 + m1) + (m2 + m3); }
    const float inv = 1.0f / sum;
    f32x4 o[16];
#pragma unroll
    for (int f = 0; f < 16; ++f) o[f] = (f32x4){0.f, 0.f, 0.f, 0.f};
#pragma unroll
    for (int mt = 0; mt < 2; ++mt) {
        lds_barrier();
#pragma unroll
        for (int i = 0; i < 8; ++i) { const int c = tid + 512 * i, m = c & 127, c16 = c >> 7;
            const u32x4 w = *(const u32x4*)(xkv + ((size_t)b * 256 + mt * 128 + m) * 2048 + 1024 + h * 256 + c16 * 8);
            LAS unsigned char* dp = lds + X_T + (c16 * 8) * X_VS + m * 2;
            *(LAS bf16_t*)(dp + 0 * X_VS) = (bf16_t)(w.x & 0xffffu); *(LAS bf16_t*)(dp + 1 * X_VS) = (bf16_t)(w.x >> 16);
            *(LAS bf16_t*)(dp + 2 * X_VS) = (bf16_t)(w.y & 0xffffu); *(LAS bf16_t*)(dp + 3 * X_VS) = (bf16_t)(w.y >> 16);
            *(LAS bf16_t*)(dp + 4 * X_VS) = (bf16_t)(w.z & 0xffffu); *(LAS bf16_t*)(dp + 5 * X_VS) = (bf16_t)(w.z >> 16);
            *(LAS bf16_t*)(dp + 6 * X_VS) = (bf16_t)(w.w & 0xffffu); *(LAS bf16_t*)(dp + 7 * X_VS) = (bf16_t)(w.w >> 16); }
#pragma unroll
        for (int f = 0; f < 8; ++f) { const f32x4 pv = sc[mt * 8 + f] * inv; u32x2 w; w.x = cvt_pk_bf16(pv[0], pv[1]); w.y = cvt_pk_bf16(pv[2], pv[3]);
            *(LAS u32x2*)(Pw + fr * 272 + (f * 16 + fg * 4) * 2) = w; }
        lds_barrier();
#pragma unroll
        for (int s = 0; s < 4; ++s) {
            const bf16x8 pf = *(const LAS bf16x8*)(Pw + fr * 272 + (s * 32 + fg * 8) * 2);
#pragma unroll
            for (int df = 0; df < 16; ++df) {
                const bf16x8 vf = *(const LAS bf16x8*)(lds + X_T + (df * 16 + fr) * X_VS + (s * 32 + fg * 8) * 2);
                o[df] = __builtin_amdgcn_mfma_f32_16x16x32_bf16(vf, pf, o[df], 0, 0, 0);
            }
        }
    }
#pragma unroll
    for (int df = 0; df < 16; ++df) { u32x2 w; w.x = cvt_pk_bf16(o[df][0], o[df][1]); w.y = cvt_pk_bf16(o[df][2], o[df][3]);
        *(u32x2*)(xo + tok * DM + h * 256 + df * 16 + fg * 4) = w; }
    lds_barrier();
}

struct Ptrs {
    unsigned char* ws; float *ss1, *ss2, *ss3, *ss4, *ss5, *ssm, *stats, *rcos, *rsin; bf16_t *mb, *xkv, *B0, *B1, *B2, *B3, *B4, *qbuf, *kbuf;
    __device__ __forceinline__ explicit Ptrs(unsigned char* w) {
        size_t z = 0; asm volatile("" : "+s"(z));
        ws = w + z; ss1 = (float*)(ws + S_SS); ss2 = ss1 + T_TOK; ss3 = ss2 + T_TOK; ss4 = ss3 + T_TOK; ss5 = ss4 + T_TOK;
        ssm = (float*)(ws + S_SSM); stats = (float*)(ws + S_STATS); rcos = (float*)(ws + S_COS); rsin = (float*)(ws + S_SIN);
        mb = (bf16_t*)(ws + A_MB); xkv = (bf16_t*)(ws + A_XKV);
        B0 = (bf16_t*)(ws + A_B0); B1 = (bf16_t*)(ws + A_B1); B2 = (bf16_t*)(ws + A_B2); B3 = (bf16_t*)(ws + A_B3); B4 = (bf16_t*)(ws + A_B4);
        qbuf = B1; kbuf = B1 + (size_t)T_TOK * 512;
    }
    __device__ __forceinline__ const bf16_t* w(size_t off) const { return (const bf16_t*)(ws + off); }
};
template <class Epi>
__device__ __forceinline__ void run_gemm(LAS unsigned char* lds, const bf16_t* A, int lda, const bf16_t* Bt, int M, int N, int K, int c, const Epi& E) {
    pg8::StaticOrder S; S.init(M, N, (int)gridDim.x, c);
    pg8::gemm_phase(lds, pg8::Gemm{A, Bt, M, N, K, lda, K}, S, E);
}
__device__ __forceinline__ void phase_prep(const Params& p, LAS unsigned char* lds) {
    const Ptrs P(p.ws); unsigned char* ws = P.ws;
    const int G = (int)gridDim.x, bid = (int)blockIdx.x, tid = threadIdx.x;
    for (int i = bid * 512 + tid; i < 4 * T_TOK; i += G * 512) P.ss2[i] = 0.f;
    for (int i = bid * 512 + tid; i < T_TOK * 8; i += G * 512) P.stats[i] = 0.f;
    for (int i = bid * 512 + tid; i < SEQ * 64; i += G * 512) {
        const int pos = i >> 6, d = i & 63;
        const float invf = exp2f(-(float)d * (13.287712379549449f / 64.0f));
        const float ang = (float)pos * invf;
        const float nrev = rintf(ang * 0.15915494309189535f);
        float r = fmaf(-nrev, 6.2831854820251465f, ang); r = fmaf(-nrev, -1.7484555314695172e-07f, r);
        P.rcos[i] = __builtin_amdgcn_cosf(r * 0.15915494309189535f); P.rsin[i] = __builtin_amdgcn_sinf(r * 0.15915494309189535f);
    }
    rows_prep(p.in[0], P.B0, P.ss1, T_TOK);
    rows_prep(p.in[1], P.mb, P.ssm, MEMT);
    const float* w1a = p.in[3]; const float* w3a = p.in[4];
    wprep(lds, (bf16_t*)(ws + W_13A), 5632, 1024, p.in[2], [=](int r) { const int pn = r >> 8, bj = (r >> 7) & 1, pp = r & 127; return RowSrc{(bj ? w3a : w1a) + pn * 128 + pp, DFF}; });
    const float* w2a = p.in[5];
    wprep(lds, (bf16_t*)(ws + W_2A), 1024, 2816, nullptr, [=](int r) { return RowSrc{w2a + r, 1024}; });
    const float* win = p.in[7];
    wprep(lds, (bf16_t*)(ws + W_IN), 4096, 1024, p.in[6], [=](int r) {
        int col;
        if (r < 1024) { const int seg = r >> 9, rr = r & 511, pnl = rr >> 8, bj = (rr >> 7) & 1, pp = rr & 127; const int head = 2 * pnl + (pp >> 6), d = pp & 63; col = seg * 512 + head * 128 + 64 * bj + d; }
        else if (r < 2048) col = 3072 + (r - 1024);
        else if (r < 3072) col = 1024 + (r - 2048);
        else col = 4096 + (r - 3072);
        return RowSrc{win + col, 5120}; });
    const float* wxk = p.in[24]; const float* wxv = p.in[25];
    wprep(lds, (bf16_t*)(ws + W_XKV), 2048, 1024, p.in[22], [=](int r) { return r < 1024 ? RowSrc{wxk + r, 1024} : RowSrc{wxv + (r - 1024), 1024}; });
    const float* wrg = p.in[12]; const float* wig = p.in[14];
    wprep(lds, (bf16_t*)(ws + W_LRU), 2048, 128, nullptr, [=](int r) { const int gi = (r >> 7) & 7, c = r & 127; return RowSrc{(r < 1024 ? wrg : wig) + gi * 16384 + c, 128}; });
}
__device__ __forceinline__ void phase1_late(const Params& p, LAS unsigned char* lds, unsigned char* ws) {
    const int G = (int)gridDim.x, bid = (int)blockIdx.x;
    const int nlate = G / 4, l0 = G - nlate;
    if (bid >= l0) {
        const float* w1b = p.in[28]; const float* w3b = p.in[29];
        wprep(lds, (bf16_t*)(ws + W_13B), 5632, 1024, p.in[27], [=](int r) { const int pn = r >> 8, bj = (r >> 7) & 1, pp = r & 127; return RowSrc{(bj ? w3b : w1b) + pn * 128 + pp, DFF}; }, bid - l0, nlate);
        const float* w2b = p.in[30];
        wprep(lds, (bf16_t*)(ws + W_2B), 1024, 2816, nullptr, [=](int r) { return RowSrc{w2b + r, 1024}; }, bid - l0, nlate);
    } else if (bid >= G / 2) {
        const int m0 = G / 2, nm = l0 - m0;
        const float* wout = p.in[20]; wprep(lds, (bf16_t*)(ws + W_OUT), 1024, 1024, nullptr, [=](int r) { return RowSrc{wout + r, 1024}; }, bid - m0, nm);
        const float* wxq = p.in[23]; wprep(lds, (bf16_t*)(ws + W_XQ), 1024, 1024, p.in[21], [=](int r) { return RowSrc{wxq + r, 1024}; }, bid - m0, nm);
        const float* wxo = p.in[26]; wprep(lds, (bf16_t*)(ws + W_XO), 1024, 1024, nullptr, [=](int r) { return RowSrc{wxo + r, 1024}; }, bid - m0, nm);
    }
}
__device__ __forceinline__ void phase_mix(const Params& p, LAS unsigned char* lds, int mode = 0) {
    const Ptrs P(p.ws); const int G = (int)gridDim.x, bid = (int)blockIdx.x;
    if (G == 256) {
        if (bid < 128) { retention_item(lds, bid, P.qbuf, P.kbuf, P.B3, P.stats);
            unsigned char* ws = P.ws; const float* win = p.in[7]; const float* wbg = p.in[18];
            wprep(lds, (bf16_t*)(ws + W_GG), 3072, 1024, p.in[6], [=](int r) { return r < 1024 ? RowSrc{win + 2048 + r, 5120} : RowSrc{wbg + (r - 1024), 2048}; }, bid, 128);
            const float* wro = p.in[9]; wprep(lds, (bf16_t*)(ws + W_RO), 1024, 1024, nullptr, [=](int r) { return RowSrc{wro + r, 1024}; }, bid, 128);
            const float* wlo = p.in[17]; wprep(lds, (bf16_t*)(ws + W_LO), 1024, 1024, nullptr, [=](int r) { return RowSrc{wlo + r, 1024}; }, bid, 128); }
        else lru_item(lds, bid - 128, P.B2, P.B4, P.w(W_LRU), p.in[10], p.in[11], p.in[13], p.in[15], p.in[16]);
    } else {
        { unsigned char* ws = P.ws; const float* win = p.in[7]; const float* wbg = p.in[18];
          wprep(lds, (bf16_t*)(ws + W_GG), 3072, 1024, p.in[6], [=](int r) { return r < 1024 ? RowSrc{win + 2048 + r, 5120} : RowSrc{wbg + (r - 1024), 2048}; });
          const float* wro = p.in[9]; wprep(lds, (bf16_t*)(ws + W_RO), 1024, 1024, nullptr, [=](int r) { return RowSrc{wro + r, 1024}; });
          const float* wlo = p.in[17]; wprep(lds, (bf16_t*)(ws + W_LO), 1024, 1024, nullptr, [=](int r) { return RowSrc{wlo + r, 1024}; }); }
        for (int it = bid; it < 256; it += G) {
            if (it < 128) retention_item(lds, it, P.qbuf, P.kbuf, P.B3, P.stats);
            else lru_item(lds, it - 128, P.B2, P.B4, P.w(W_LRU), p.in[10], p.in[11], p.in[13], p.in[15], p.in[16]);
        }
    }
}
__device__ __forceinline__ void phase_final(const Params& p) {
    const Ptrs P(p.ws); const int G = (int)gridDim.x, bid = (int)blockIdx.x, tid = threadIdx.x;
    const float* gf = p.in[31]; float* X = p.out;
    for (int i = bid * 512 + tid; i < T_TOK * 256; i += G * 512) {
        const int row = i >> 8, c = (i & 255) * 4; const float rs = rs_of(P.ss5[row]);
        f32x4 v = *(f32x4*)(X + (size_t)row * DM + c); const f32x4 gv = *(const f32x4*)(gf + c);
        v = v * rs * gv; *(f32x4*)(X + (size_t)row * DM + c) = v;
    }
}

__global__ __launch_bounds__(512, 2) void fwd_mega(Params p) {
    extern __shared__ __attribute__((aligned(16))) unsigned char shm[];
    LAS unsigned char* lds = (LAS unsigned char*)shm;
    cg::grid_group grid = cg::this_grid();
    const int bid = (int)blockIdx.x, G = (int)gridDim.x;
    unsigned* bar = (unsigned*)(p.ws + S_BAR);
    volatile LAS unsigned* xst = (volatile LAS unsigned*)(lds + LDS_BYTES - 16);
    if (threadIdx.x == 0) { xst[0] = 0u; xst[1] = 0u; }
    __syncthreads();
    const XcdBarrier xb = xcd_barrier_post(bar, xst);
    if (p.ph_lo > 1000) grid.sync();
#ifndef PHMASK
#define PHMASK 0x7fff
#endif
#ifndef REPMASK
#define REPMASK 0
#endif
#define PHASE(k, body) if (((PHMASK >> (k)) & 1) && p.ph_lo <= (k) && (k) < p.ph_hi) { if ((k) > p.ph_lo) xcd_barrier(xb); { body } if ((REPMASK >> (k)) & 1) { xcd_barrier(xb); { body } } }
    PHASE(0, phase_prep(p, lds);)
    PHASE(1, { const Ptrs P(p.ws);
        run_gemm(lds, P.B0, 1024, P.w(W_13A), T_TOK, 5632, 1024, bid, EpiSwiglu{P.B1, P.ss1});
        run_gemm(lds, P.mb, 1024, P.w(W_XKV), MEMT, 2048, 1024, (bid + G / 2) % G, EpiScale{P.xkv, 2048, P.ssm, 1.0f});
        phase1_late(p, lds, P.ws); })
    PHASE(2, { const Ptrs P(p.ws);
        run_gemm(lds, P.B1, DFF, P.w(W_2A), T_TOK, 1024, DFF, bid, EpiResid<true>{p.in[0], p.out, P.B0, P.ss2, 0.5f}); })
    PHASE(3, { const Ptrs P(p.ws);
        run_gemm(lds, P.B0, 1024, P.w(W_IN), T_TOK, 4096, 1024, bid, EpiInproj{P.qbuf, P.B2, P.ss2, P.rcos, P.rsin}); })
    PHASE(4, phase_mix(p, lds);)
    PHASE(5, { const Ptrs P(p.ws);
        run_gemm(lds, P.B0, 1024, P.w(W_GG), T_TOK, 3072, 1024, bid, EpiGG{P.B3, P.B1, P.ss2, P.stats, p.in[8], p.in[19]}); })
    PHASE(6, { const Ptrs P(p.ws);
        run_gemm(lds, P.B3, 1024, P.w(W_RO), T_TOK, 1024, 1024, bid, EpiMerge<false>{P.B0, P.B1}); })
    if (((PHMASK >> 7) & 1) && p.ph_lo <= 7 && 7 < p.ph_hi) { const Ptrs P(p.ws);
        run_gemm(lds, P.B4, 1024, P.w(W_LO), T_TOK, 1024, 1024, bid, EpiMerge<true>{P.B0, P.B1}); }
    PHASE(8, { const Ptrs P(p.ws);
        run_gemm(lds, P.B0, 1024, P.w(W_OUT), T_TOK, 1024, 1024, bid, EpiResid<true>{p.out, p.out, P.B3, P.ss3, 1.0f}); })
    PHASE(9, { const Ptrs P(p.ws);
        run_gemm(lds, P.B3, 1024, P.w(W_XQ), T_TOK, 1024, 1024, bid, EpiScale{P.B4, 1024, P.ss3, 0.0625f});
        if (G == 256) {
            pg8::StaticOrder S; S.init(T_TOK, 1024, G, bid); Unit u; S.next(0, u);
            asm volatile("s_waitcnt vmcnt(0)" ::: "memory"); __syncthreads();
            for (int j = 0; j < 2; ++j) xattn_item(lds, ((u.pm >> 3) << 6) | (u.pn << 4) | ((u.pm & 7) * 2 + j), P.B4, P.xkv, P.B0);
        } })
    if (G != 256) { PHASE(10, { const Ptrs P(p.ws);
        for (int it = bid; it < 512; it += G) xattn_item(lds, it, P.B4, P.xkv, P.B0); }) }
    PHASE(11, { const Ptrs P(p.ws);
        run_gemm(lds, P.B0, 1024, P.w(W_XO), T_TOK, 1024, 1024, bid, EpiResid<true>{p.out, p.out, P.B4, P.ss4, 1.0f}); })
    PHASE(12, { const Ptrs P(p.ws);
        run_gemm(lds, P.B4, 1024, P.w(W_13B), T_TOK, 5632, 1024, bid, EpiSwiglu{P.B1, P.ss4}); })
    if (G == 256) {
        PHASE(13, { const Ptrs P(p.ws);
            run_gemm(lds, P.B1, DFF, P.w(W_2B), T_TOK, 1024, DFF, bid, EpiFinal{p.out, P.ss5, p.in[31], xb}); })
    } else {
        PHASE(13, { const Ptrs P(p.ws);
            run_gemm(lds, P.B1, DFF, P.w(W_2B), T_TOK, 1024, DFF, bid, EpiResid<false>{p.out, p.out, nullptr, P.ss5, 0.5f}); })
        PHASE(14, phase_final(p);)
    }
#undef PHASE
}

constexpr int N_PHASES = 15;
#ifndef DBG_HI
#define DBG_HI N_PHASES
#endif
extern "C" void kernel_launch(void* const* d_in, const int* in_sizes, int n_in, void* d_out, int out_size, void* d_ws, size_t ws_size, hipStream_t stream) {
    static int grid = 0;
    if (grid == 0) {
        if (n_in != 32 || out_size != T_TOK * DM || ws_size < WS_NEED) { fprintf(stderr, "kernel_launch: unexpected shapes (n_in %d out %d ws %zu)\n", n_in, out_size, ws_size); grid = -1; return; }
        int dev = 0, cus = 0, per_cu = 0;
        hipGetDevice(&dev); hipDeviceGetAttribute(&cus, hipDeviceAttributeMultiprocessorCount, dev);
        hipFuncSetAttribute((const void*)fwd_mega, hipFuncAttributeMaxDynamicSharedMemorySize, LDS_BYTES);
        hipOccupancyMaxActiveBlocksPerMultiprocessor(&per_cu, (const void*)fwd_mega, 512, LDS_BYTES);
        if (per_cu < 1) { fprintf(stderr, "kernel_launch: occupancy query says %d blocks/CU\n", per_cu); per_cu = 1; }
        (void)hipGetLastError();
        grid = cus;
    }
    if (grid < 0) return;
    Params p{};
    for (int i = 0; i < 32; ++i) p.in[i] = (const float*)d_in[i];
    p.out = (float*)d_out; p.ws = (unsigned char*)d_ws;
#ifndef N_CUTS
#define N_CUTS 1
#endif
    if (hipMemsetAsync((unsigned char*)d_ws + S_BAR, 0, 16384, stream) != hipSuccess) { fprintf(stderr, "kernel_launch: memset of the barrier word failed\n"); return; }
    for (int li = 0; li < N_CUTS; ++li) {
        p.ph_lo = li * DBG_HI / N_CUTS; p.ph_hi = (li + 1) * DBG_HI / N_CUTS;
        void* args[] = {&p};
        hipError_t e = hipLaunchCooperativeKernel((const void*)fwd_mega, dim3(grid), dim3(512), args, LDS_BYTES, stream);
        if (e != hipSuccess) fprintf(stderr, "cooperative launch failed: %s (grid %d)\n", hipGetErrorString(e), grid);
    }
}
```

```cpp
#include <hip/hip_runtime.h>
#include <hip/hip_cooperative_groups.h>
#include <cstdio>
namespace cg = cooperative_groups;

#define LAS __attribute__((address_space(3)))
typedef unsigned short bf16_t;
typedef short bf16x8 __attribute__((ext_vector_type(8)));
typedef short s16x4 __attribute__((ext_vector_type(4)));
typedef float f32x4 __attribute__((ext_vector_type(4)));
typedef unsigned u32x4 __attribute__((ext_vector_type(4)));
typedef unsigned u32x2 __attribute__((ext_vector_type(2)));

constexpr int T_TOK = 16384, DM = 1024, SEQ = 2048, NB = 8, DFF = 2816, MEMT = 2048;
constexpr float EPS = 1e-6f;
constexpr int LDS_BYTES = 140 * 1024;

constexpr size_t MiB = 1024 * 1024;
constexpr size_t W_13A = 0;
constexpr size_t W_2A = W_13A + (size_t)5632 * 1024 * 2;
constexpr size_t W_IN = W_2A + (size_t)1024 * 2816 * 2;
constexpr size_t W_GG = W_IN + (size_t)4096 * 1024 * 2;
constexpr size_t W_RO = W_GG + (size_t)3072 * 1024 * 2;
constexpr size_t W_LO = W_RO + (size_t)1024 * 1024 * 2;
constexpr size_t W_OUT = W_LO + (size_t)1024 * 1024 * 2;
constexpr size_t W_XQ = W_OUT + (size_t)1024 * 1024 * 2;
constexpr size_t W_XKV = W_XQ + (size_t)1024 * 1024 * 2;
constexpr size_t W_XO = W_XKV + (size_t)2048 * 1024 * 2;
constexpr size_t W_13B = W_XO + (size_t)1024 * 1024 * 2;
constexpr size_t W_2B = W_13B + (size_t)5632 * 1024 * 2;
constexpr size_t W_LRU = W_2B + (size_t)1024 * 2816 * 2;
constexpr size_t W_END = W_LRU + (size_t)2 * 1024 * 128 * 2;
static_assert(W_END <= 62 * MiB, "weights");
constexpr size_t S_SS = 62 * MiB;
constexpr size_t S_SSM = S_SS + 5 * 65536;
constexpr size_t S_STATS = S_SSM + 8192;
constexpr size_t S_COS = S_STATS + 524288;
constexpr size_t S_SIN = S_COS + 524288;
constexpr size_t S_BAR = S_SIN + 524288;
static_assert(S_BAR + 16384 <= 64 * MiB && S_BAR % 256 == 0, "small");
constexpr size_t A_MB = 64 * MiB;
constexpr size_t A_XKV = 68 * MiB;
constexpr size_t A_B0 = 76 * MiB, A_B1 = 108 * MiB, A_B2 = 140 * MiB, A_B3 = 172 * MiB, A_B4 = 204 * MiB;
constexpr size_t WS_NEED = 236 * MiB;

struct Params { const float* in[32]; float* out; unsigned char* ws; int ph_lo, ph_hi; };

typedef float f32x2v __attribute__((ext_vector_type(2)));
typedef __bf16 bf16x2v __attribute__((ext_vector_type(2)));
__device__ __forceinline__ unsigned cvt_pk_bf16(float lo, float hi) { const f32x2v v = {lo, hi}; return __builtin_bit_cast(unsigned, __builtin_convertvector(v, bf16x2v)); }
__device__ __forceinline__ float bflo(unsigned w) { return __uint_as_float(w << 16); }
__device__ __forceinline__ float bfhi(unsigned w) { return __uint_as_float(w & 0xffff0000u); }
__device__ __forceinline__ float bf2f(bf16_t b) { return __uint_as_float((unsigned)b << 16); }
__device__ __forceinline__ u32x4 pack8(const float* o) { u32x4 w; w.x = cvt_pk_bf16(o[0], o[1]); w.y = cvt_pk_bf16(o[2], o[3]); w.z = cvt_pk_bf16(o[4], o[5]); w.w = cvt_pk_bf16(o[6], o[7]); return w; }
__device__ __forceinline__ void unpack8(u32x4 w, float* o) { o[0] = bflo(w.x); o[1] = bfhi(w.x); o[2] = bflo(w.y); o[3] = bfhi(w.y); o[4] = bflo(w.z); o[5] = bfhi(w.z); o[6] = bflo(w.w); o[7] = bfhi(w.w); }
__device__ __forceinline__ float sigmoidf_(float x) { return __builtin_amdgcn_rcpf(1.0f + __expf(-x)); }
__device__ __forceinline__ void sigmoid2(float x0, float x1, float& s0, float& s1) {
    const float d0 = 1.0f + __expf(-fmaxf(x0, -40.f)), d1 = 1.0f + __expf(-fmaxf(x1, -40.f)); const float r = __builtin_amdgcn_rcpf(d0 * d1); s0 = r * d1; s1 = r * d0; }
__device__ __forceinline__ float rs_of(float ss) { return rsqrtf(ss * (1.0f / 1024.0f) + EPS); }
__device__ __forceinline__ void lds_barrier() { asm volatile("s_waitcnt lgkmcnt(0)" ::: "memory"); __builtin_amdgcn_s_barrier(); asm volatile("" ::: "memory"); }

namespace pg8 {
constexpr int BM = 256, BK = 64, HALF = 128, HTB = HALF * BK * 2, STAGE_BYTES = 8 * HTB, NXCD = 8, WGM = 8;
__host__ __device__ __forceinline__ int lds_byte(int r, int c) { const int st = (r >> 4) * 2 + (c >> 5), rr = r & 15, cc = c & 31, ob = rr * 64 + cc * 2; return st * 1024 + (ob ^ (((ob >> 9) & 1) << 5)); }
__host__ __device__ __forceinline__ void stage_rc(int b, int& R, int& C) { const int st = b / 1024, sb = b % 1024, swz = sb ^ (((sb >> 9) & 1) << 5); R = (st >> 1) * 16 + swz / 64; C = (st & 1) * 32 + (swz % 64) / 2; }
__host__ __device__ __forceinline__ int perm32(int rho) { const int n = rho >> 4, i = rho & 15; return 8 * (i >> 2) + 4 * n + (i & 3); }
struct Unit { int pm, pn; };
struct Gemm { const bf16_t* A; const bf16_t* Bt; int M, N, K, lda, ldb; };
struct StaticOrder {
    int nM, nN, nwg, G, c;
    __device__ __forceinline__ void init(int M, int N, int G_, int c_) { nM = M / BM; nN = N / BM; nwg = nM * nN; G = G_; c = c_; }
    __device__ __forceinline__ bool next(int i, Unit& u) const {
        const long L = (long)i * G + c; if (L >= nwg) return false;
        int wgid = (int)L; { const int q = nwg / NXCD, r = nwg % NXCD, xcd = wgid % NXCD, off = wgid / NXCD; wgid = (xcd < r ? xcd * (q + 1) : r * (q + 1) + (xcd - r) * q) + off; }
        const int nig = WGM * nN, gid = wgid / nig, fm = gid * WGM, gsz = (nM - fm) < WGM ? (nM - fm) : WGM;
        u.pm = fm + ((wgid % nig) % gsz); u.pn = (wgid % nig) / gsz; return true;
    }
};
template <class Epi>
__device__ __forceinline__ void gemm_phase(LAS unsigned char* lds, const Gemm g, const StaticOrder& S, const Epi& E) {
    const int tid = threadIdx.x, wid = __builtin_amdgcn_readfirstlane(tid >> 6), lane = tid & 63, wr = wid >> 2, wc = wid & 3, fr = lane & 15, fq = lane >> 4;
    const int K = g.K, nt = K / BK;
    unsigned voffA[2], voffB[2];
#pragma unroll
    for (int i = 0; i < 2; ++i) { int R, C; stage_rc(tid * 16 + i * 8192, R, C); const int Rb = Epi::PERM ? ((R & ~31) + perm32(R & 31)) : R;
        voffA[i] = (unsigned)(R * g.lda + C) * 2u; voffB[i] = (unsigned)(Rb * g.ldb + C) * 2u; }
    const size_t kstep = (size_t)(BK * 2);
    const size_t hstepA = (size_t)HALF * g.lda * 2, hstepB = (size_t)HALF * g.ldb * 2;
    const size_t tstepA = 2 * hstepA, tstepB = 2 * hstepB;
    const unsigned ldsw = (unsigned)wid * 1024u;
    const int aoff = lds_byte(wr * 64 + fr, fq * 8), boff = lds_byte(wc * 32 + fr, fq * 8);
#define PG8_SA(b, h) (((b) * 2 + (h)) * HTB)
#define PG8_SB(b, h) ((4 + (b) * 2 + (h)) * HTB)
#define PG8_STAGE(bufoff, gbase, voff) do { _Pragma("unroll") for (int _i = 0; _i < 2; ++_i) \
        __builtin_amdgcn_global_load_lds((const unsigned*)((const char*)(gbase) + (voff)[_i]), (LAS unsigned*)(lds + (bufoff) + ldsw + _i * 8192), 16, 0, 0); } while (0)
#define PG8_LDA(dst, b, h) do { _Pragma("unroll") for (int m = 0; m < 4; ++m) _Pragma("unroll") for (int k = 0; k < 2; ++k) dst[m][k] = *(const LAS bf16x8*)(lds + PG8_SA(b, h) + aoff + m * 2048 + k * 1024); } while (0)
#define PG8_LDB(dst, b, h) do { _Pragma("unroll") for (int n = 0; n < 2; ++n) _Pragma("unroll") for (int k = 0; k < 2; ++k) dst[n][k] = *(const LAS bf16x8*)(lds + PG8_SB(b, h) + boff + n * 2048 + k * 1024); } while (0)
#define PG8_MMA(ai, bj, At, Bt) do { __builtin_amdgcn_s_setprio(1); _Pragma("unroll") for (int m = 0; m < 4; ++m) _Pragma("unroll") for (int n = 0; n < 2; ++n) _Pragma("unroll") for (int k = 0; k < 2; ++k) \
        acc[ai][bj][m][n] = __builtin_amdgcn_mfma_f32_16x16x32_bf16(Bt[n][k], At[m][k], acc[ai][bj][m][n], 0, 0, 0); __builtin_amdgcn_s_setprio(0); } while (0)
#define PG8_WAIT_V(n) asm volatile("s_waitcnt vmcnt(" #n ")" ::: "memory")
#define PG8_WAIT_L(n) asm volatile("s_waitcnt lgkmcnt(" #n ")" ::: "memory")
#define PG8_BAR __builtin_amdgcn_s_barrier()
#define PG8_SCHED __builtin_amdgcn_sched_barrier(0)
    Unit cur, nxt; int ui = 0;
    if (!S.next(0, cur)) return;
    f32x4 acc[2][2][4][2];
#pragma unroll
    for (int a = 0; a < 2; ++a)
#pragma unroll
        for (int b = 0; b < 2; ++b)
#pragma unroll
            for (int m = 0; m < 4; ++m)
#pragma unroll
                for (int n = 0; n < 2; ++n) acc[a][b][m][n] = (f32x4){0.f, 0.f, 0.f, 0.f};
    bf16x8 At[4][2], B0[2][2], B1[2][2];
    const char* cA = (const char*)g.A + (size_t)cur.pm * tstepA; const char* cB = (const char*)g.Bt + (size_t)cur.pn * tstepB;
    PG8_STAGE(PG8_SB(0, 0), cB, voffB); PG8_STAGE(PG8_SA(0, 0), cA, voffA); PG8_STAGE(PG8_SB(0, 1), cB + hstepB, voffB); PG8_STAGE(PG8_SA(0, 1), cA + hstepA, voffA);
    if (wr == 1) PG8_BAR;
    PG8_WAIT_V(4); PG8_BAR;
    PG8_STAGE(PG8_SB(1, 0), cB + kstep, voffB); PG8_STAGE(PG8_SA(1, 0), cA + kstep, voffA); PG8_STAGE(PG8_SB(1, 1), cB + hstepB + kstep, voffB);
    PG8_WAIT_V(6); PG8_BAR;
    for (;;) {
        const bool has_next = S.next(ui + 1, nxt);
        const char* nA = has_next ? (const char*)g.A + (size_t)nxt.pm * tstepA : cA; const char* nB = has_next ? (const char*)g.Bt + (size_t)nxt.pn * tstepB : cB;
        for (int t = 0; t < nt; t += 2) {
            const bool last = (t == nt - 2);
            const char* a1 = cA + (size_t)(t + 1) * kstep;
            const char* a2 = last ? nA : cA + (size_t)(t + 2) * kstep; const char* b2 = last ? nB : cB + (size_t)(t + 2) * kstep;
            const char* a3 = a2 + kstep; const char* b3 = b2 + kstep;
            PG8_LDB(B0, 0, 0); PG8_SCHED; PG8_LDA(At, 0, 0); PG8_STAGE(PG8_SA(1, 1), a1 + hstepA, voffA);
            PG8_WAIT_L(8); PG8_BAR; PG8_WAIT_L(0); PG8_MMA(0, 0, At, B0); PG8_BAR; PG8_SCHED;
            PG8_LDB(B1, 0, 1); PG8_STAGE(PG8_SB(0, 0), b2, voffB);
            PG8_BAR; PG8_WAIT_L(0); PG8_MMA(0, 1, At, B1); PG8_BAR;
            PG8_LDA(At, 0, 1); PG8_STAGE(PG8_SA(0, 0), a2, voffA);
            PG8_BAR; PG8_WAIT_L(0); PG8_MMA(1, 0, At, B0); PG8_BAR; PG8_SCHED;
            PG8_STAGE(PG8_SB(0, 1), b2 + hstepB, voffB);
            PG8_WAIT_V(6); PG8_BAR; PG8_MMA(1, 1, At, B1); PG8_BAR;
            PG8_LDB(B0, 1, 0); PG8_SCHED; PG8_LDA(At, 1, 0); PG8_STAGE(PG8_SA(0, 1), a2 + hstepA, voffA);
            PG8_WAIT_L(8); PG8_BAR; PG8_WAIT_L(0); PG8_MMA(0, 0, At, B0); PG8_BAR; PG8_SCHED;
            PG8_LDB(B1, 1, 1); PG8_STAGE(PG8_SB(1, 0), b3, voffB);
            PG8_BAR; PG8_WAIT_L(0); PG8_MMA(0, 1, At, B1); PG8_BAR;
            PG8_LDA(At, 1, 1); PG8_STAGE(PG8_SA(1, 0), a3, voffA);
            PG8_BAR; PG8_WAIT_L(0); PG8_MMA(1, 0, At, B0); PG8_BAR; PG8_SCHED;
            PG8_STAGE(PG8_SB(1, 1), b3 + hstepB, voffB);
            PG8_WAIT_V(6); PG8_BAR; PG8_MMA(1, 1, At, B1); PG8_BAR;
        }
        if constexpr (!Epi::AFTER_DRAIN) E(acc, cur, wr, wc, fr, fq);
        if (!has_next) break;
#pragma unroll
        for (int a = 0; a < 2; ++a)
#pragma unroll
            for (int b = 0; b < 2; ++b)
#pragma unroll
                for (int m = 0; m < 4; ++m)
#pragma unroll
                    for (int n = 0; n < 2; ++n) acc[a][b][m][n] = (f32x4){0.f, 0.f, 0.f, 0.f};
        cur = nxt; cA = nA; cB = nB; ++ui;
    }
    PG8_WAIT_V(0);
    if (wr == 0) PG8_BAR;
    PG8_BAR;
    if constexpr (Epi::AFTER_DRAIN) E.fused(acc, cur, wr, wc, fr, fq);
#undef PG8_SA
#undef PG8_SB
#undef PG8_STAGE
#undef PG8_LDA
#undef PG8_LDB
#undef PG8_MMA
#undef PG8_WAIT_V
#undef PG8_WAIT_L
#undef PG8_BAR
#undef PG8_SCHED
}
}
using pg8::Unit;
typedef f32x4 AccT[2][2][4][2];

#define XB_TMO      128
#define XB_XCNT(j)  (256  + 64 * (j))
#define XB_XSUB(j)  (1280 + 64 * (j))
#define XB_XGEN(j)  (2304 + 64 * (j))
#define XB_TOP      3328
#define XB_TOPGEN   3392
#define XCD_BAR_WORDS 3456
#define XB_SPIN_CAP (1u << 18)

__device__ __forceinline__ unsigned xb_ld(unsigned* p)              { return __hip_atomic_load(p, __ATOMIC_RELAXED, __HIP_MEMORY_SCOPE_AGENT); }
__device__ __forceinline__ unsigned xb_add(unsigned* p, unsigned v) { return __hip_atomic_fetch_add(p, v, __ATOMIC_RELAXED, __HIP_MEMORY_SCOPE_AGENT); }
__device__ __forceinline__ unsigned xb_xcc_id() { return (unsigned)__builtin_amdgcn_s_getreg((3 << 11) | 20) & 0xFu; }
#define XB_SPIN(cond, bar) do { unsigned _sp = 0; while (cond) { __builtin_amdgcn_s_sleep(1); \
    if ((++_sp & 255u) == 0u) { if (xb_ld(&(bar)[XB_TMO])) break; if (_sp > XB_SPIN_CAP) { atomicAdd(&(bar)[XB_TMO], 1u); break; } } } } while (0)

struct XcdBarrier {
    unsigned* bar; unsigned x;
    volatile LAS unsigned* st;
};

__device__ __forceinline__ XcdBarrier xcd_barrier_post(unsigned* bar, volatile LAS unsigned* st) {
    XcdBarrier b; b.bar = bar; b.x = xb_xcc_id(); b.st = st;
    if (threadIdx.x == 0) (void)xb_add(&bar[XB_XCNT(b.x)], 1u);
    return b;
}
__device__ __forceinline__ void xcd_barrier_complete(unsigned* bar, unsigned x, unsigned& nloc, unsigned& nx) {
    const unsigned G = gridDim.x * gridDim.y * gridDim.z;
    unsigned sum, cnt, mine, sp = 0u;
    for (;;) {
        sum = 0u; cnt = 0u; mine = 0u;
#pragma unroll
        for (unsigned j = 0; j < 16; ++j) { const unsigned c = xb_ld(&bar[XB_XCNT(j)]); sum += c; cnt += (c > 0u) ? 1u : 0u; mine = (j == x) ? c : mine; }
        if (sum == G) break;
        __builtin_amdgcn_s_sleep(1);
        if ((++sp & 255u) == 0u) { if (xb_ld(&bar[XB_TMO])) break; if (sp > XB_SPIN_CAP) { atomicAdd(&bar[XB_TMO], 1u); break; } }
    }
    nloc = mine > 0u ? mine : 1u; nx = cnt > 0u ? cnt : 1u;
}

__device__ __forceinline__ void xcd_barrier(const XcdBarrier& b) {
    asm volatile("s_waitcnt vmcnt(0)" ::: "memory");
    __syncthreads();
    if (threadIdx.x == 0) {
        unsigned* bar = b.bar;
        __builtin_amdgcn_s_waitcnt(0);
        unsigned nloc = b.st[0], nx = b.st[1];
        if (nloc == 0u) { xcd_barrier_complete(bar, b.x, nloc, nx); b.st[0] = nloc; b.st[1] = nx; }
        const unsigned old = xb_add(&bar[XB_XSUB(b.x)], 1u);
        const unsigned gen = old / nloc;
        if (old + 1u == (gen + 1u) * nloc) {
            __builtin_amdgcn_fence(__ATOMIC_RELEASE, "agent");
            asm volatile("s_waitcnt vmcnt(0)" ::: "memory");
            const unsigned og = xb_add(&bar[XB_TOP], 1u);
            const unsigned tg = og / nx;
            if (og + 1u == (tg + 1u) * nx) xb_add(&bar[XB_TOPGEN], 1u);
            else XB_SPIN(xb_ld(&bar[XB_TOPGEN]) == tg, bar);
            __builtin_amdgcn_fence(__ATOMIC_ACQUIRE, "agent");
            xb_add(&bar[XB_XGEN(b.x)], 1u);
            asm volatile("s_waitcnt vmcnt(0)" ::: "memory");
        } else {
            XB_SPIN(xb_ld(&bar[XB_XGEN(b.x)]) == gen, bar);
            __builtin_amdgcn_fence(__ATOMIC_ACQUIRE, "agent");
            asm volatile("s_waitcnt vmcnt(0)" ::: "memory");
        }
    }
    __syncthreads();
}


struct EpiSwiglu {
    static constexpr bool PERM = true, AFTER_DRAIN = false;
    bf16_t* G; const float* ss;
    __device__ __forceinline__ void operator()(const AccT& acc, const Unit& u, int wr, int wc, int fr, int fq) const {
        const int row0 = u.pm * 256 + wr * 64 + fr, col0 = u.pn * 128 + wc * 32 + 8 * fq;
#pragma unroll
        for (int ai = 0; ai < 2; ++ai)
#pragma unroll
            for (int m = 0; m < 4; ++m) {
                const int row = row0 + ai * 128 + m * 16; const float rs = rs_of(ss[row]); float o[8];
#pragma unroll
                for (int n = 0; n < 2; ++n)
#pragma unroll
                    for (int j = 0; j < 4; j += 2) {
                        const float a1 = acc[ai][0][m][n][j] * rs, b1 = acc[ai][0][m][n][j + 1] * rs;
                        const float d0 = 1.0f + __expf(-fmaxf(a1, -40.f)), d1 = 1.0f + __expf(-fmaxf(b1, -40.f));
                        const float r = __builtin_amdgcn_rcpf(d0 * d1);
                        o[4 * n + j] = a1 * (r * d1) * (acc[ai][1][m][n][j] * rs); o[4 * n + j + 1] = b1 * (r * d0) * (acc[ai][1][m][n][j + 1] * rs); }
                *(u32x4*)(G + (size_t)row * DFF + col0) = pack8(o);
            }
    }
};
template <bool WB> struct EpiResid {
    static constexpr bool PERM = true, AFTER_DRAIN = false;
    const float* base; float* X; bf16_t* Xb; float* ss; float scale;
    __device__ __forceinline__ void operator()(const AccT& acc, const Unit& u, int wr, int wc, int fr, int fq) const {
        const int row0 = u.pm * 256 + wr * 64 + fr, col0 = u.pn * 256 + wc * 32 + 8 * fq;
#pragma unroll
        for (int ai = 0; ai < 2; ++ai)
#pragma unroll
            for (int m = 0; m < 4; ++m) {
                const int row = row0 + ai * 128 + m * 16; float sq = 0.f;
#pragma unroll
                for (int bj = 0; bj < 2; ++bj) {
                    const size_t off = (size_t)row * DM + col0 + bj * 128;
                    const f32x4 b0 = *(const f32x4*)(base + off), b1 = *(const f32x4*)(base + off + 4);
                    const f32x4 v0 = b0 + scale * acc[ai][bj][m][0], v1 = b1 + scale * acc[ai][bj][m][1];
                    *(f32x4*)(X + off) = v0; *(f32x4*)(X + off + 4) = v1;
                    sq += (v0[0] * v0[0] + v0[1] * v0[1]) + (v0[2] * v0[2] + v0[3] * v0[3]) + (v1[0] * v1[0] + v1[1] * v1[1]) + (v1[2] * v1[2] + v1[3] * v1[3]);
                    if (WB) { u32x4 w; w.x = cvt_pk_bf16(v0[0], v0[1]); w.y = cvt_pk_bf16(v0[2], v0[3]); w.z = cvt_pk_bf16(v1[0], v1[1]); w.w = cvt_pk_bf16(v1[2], v1[3]); *(u32x4*)(Xb + off) = w; }
                }
                sq += __shfl_xor(sq, 16); sq += __shfl_xor(sq, 32);
                if (fq == 0) unsafeAtomicAdd(ss + row, sq);
            }
    }
};
struct EpiInproj {
    static constexpr bool PERM = true, AFTER_DRAIN = false;
    bf16_t *q, *xl; const float *ss, *cs, *sn;
    __device__ __forceinline__ void operator()(const AccT& acc, const Unit& u, int wr, int wc, int fr, int fq) const {
        const int row0 = u.pm * 256 + wr * 64 + fr, p0 = wc * 32 + 8 * fq, pn = u.pn;
        if (pn < 4) {
            bf16_t* dst = q + (size_t)(pn >> 1) * ((size_t)T_TOK * 512); const float sc = pn < 2 ? 1.0f : 0.08838834764831845f;
            const int head = 2 * (pn & 1) + (p0 >> 6), d0 = p0 & 63;
#pragma unroll
            for (int ai = 0; ai < 2; ++ai)
#pragma unroll
                for (int m = 0; m < 4; ++m) {
                    const int row = row0 + ai * 128 + m * 16; const float rs = rs_of(ss[row]) * sc; const int pos = row & (SEQ - 1);
                    const float* cp = cs + pos * 64 + d0; const float* sp = sn + pos * 64 + d0;
                    bf16_t* dp = dst + (size_t)row * 512 + head * 128 + d0;
#pragma unroll
                    for (int n = 0; n < 2; ++n) {
                        const f32x4 c = *(const f32x4*)(cp + 4 * n), s = *(const f32x4*)(sp + 4 * n);
                        const f32x4 t1 = acc[ai][0][m][n] * rs, t2 = acc[ai][1][m][n] * rs;
                        const f32x4 o1 = t1 * c - t2 * s, o2 = t2 * c + t1 * s;
                        u32x2 w1, w2; w1.x = cvt_pk_bf16(o1[0], o1[1]); w1.y = cvt_pk_bf16(o1[2], o1[3]); w2.x = cvt_pk_bf16(o2[0], o2[1]); w2.y = cvt_pk_bf16(o2[2], o2[3]);
                        *(u32x2*)(dp + 4 * n) = w1; *(u32x2*)(dp + 64 + 4 * n) = w2;
                    }
                }
        } else {
            const int seg = (pn - 4) >> 2; bf16_t* dst = xl + (size_t)seg * ((size_t)T_TOK * DM); const int colb = ((pn - 4) & 3) * 256 + p0;
#pragma unroll
            for (int ai = 0; ai < 2; ++ai)
#pragma unroll
                for (int m = 0; m < 4; ++m) {
                    const int row = row0 + ai * 128 + m * 16; const float rs = rs_of(ss[row]);
#pragma unroll
                    for (int bj = 0; bj < 2; ++bj) {
                        float o[8];
#pragma unroll
                        for (int n = 0; n < 2; ++n)
#pragma unroll
                            for (int j = 0; j < 4; j += 2) { float a = acc[ai][bj][m][n][j] * rs, b = acc[ai][bj][m][n][j + 1] * rs;
                                if (seg == 2) { const float ua = 1.5957691216057308f * (a + 0.044715f * a * a * a), ub = 1.5957691216057308f * (b + 0.044715f * b * b * b);
                                    float sa, sb; sigmoid2(ua, ub, sa, sb); a *= sa; b *= sb; }
                                o[4 * n + j] = a; o[4 * n + j + 1] = b; }
                        *(u32x4*)(dst + (size_t)row * DM + colb + bj * 128) = pack8(o);
                    }
                }
        }
    }
};
struct EpiGG {
    static constexpr bool PERM = true, AFTER_DRAIN = false;
    bf16_t* aret; bf16_t* gates; const float *ss, *stats, *gn, *bg;
    __device__ __forceinline__ void operator()(const AccT& acc, const Unit& u, int wr, int wc, int fr, int fq) const {
        const int row0 = u.pm * 256 + wr * 64 + fr, p0 = wc * 32 + 8 * fq, pn = u.pn;
        if (pn < 4) {
#pragma unroll
            for (int ai = 0; ai < 2; ++ai)
#pragma unroll
                for (int m = 0; m < 4; ++m) {
                    const int row = row0 + ai * 128 + m * 16; const float rs = rs_of(ss[row]);
                    const float s1 = stats[((size_t)row * 4 + pn) * 2], s2 = stats[((size_t)row * 4 + pn) * 2 + 1];
                    const float mu = s1 * (1.0f / 256.0f); const float var = fmaxf(s2 * (1.0f / 256.0f) - mu * mu, 0.f); const float rstd = rsqrtf(var + EPS);
#pragma unroll
                    for (int bj = 0; bj < 2; ++bj) {
                        const int col = pn * 256 + bj * 128 + p0; bf16_t* rp = aret + (size_t)row * DM + col;
                        float r[8], o[8]; unpack8(*(const u32x4*)rp, r);
                        const f32x4 g0 = *(const f32x4*)(gn + col), g1 = *(const f32x4*)(gn + col + 4);
#pragma unroll
                        for (int n = 0; n < 2; ++n)
#pragma unroll
                            for (int j = 0; j < 4; j += 2) { const float a = acc[ai][bj][m][n][j] * rs, b = acc[ai][bj][m][n][j + 1] * rs; float sa, sb; sigmoid2(a, b, sa, sb);
                                o[4 * n + j] = a * sa * (n ? g1[j] : g0[j]) * (r[4 * n + j] - mu) * rstd; o[4 * n + j + 1] = b * sb * (n ? g1[j + 1] : g0[j + 1]) * (r[4 * n + j + 1] - mu) * rstd; }
                        *(u32x4*)rp = pack8(o);
                    }
                }
        } else {
#pragma unroll
            for (int ai = 0; ai < 2; ++ai)
#pragma unroll
                for (int m = 0; m < 4; ++m) {
                    const int row = row0 + ai * 128 + m * 16; const float rs = rs_of(ss[row]);
#pragma unroll
                    for (int bj = 0; bj < 2; ++bj) {
                        const int col = (pn - 4) * 256 + bj * 128 + p0; float o[8];
                        const f32x4 b0 = *(const f32x4*)(bg + col), b1 = *(const f32x4*)(bg + col + 4);
#pragma unroll
                        for (int n = 0; n < 2; ++n)
#pragma unroll
                            for (int j = 0; j < 4; j += 2) sigmoid2(acc[ai][bj][m][n][j] * rs + (n ? b1[j] : b0[j]), acc[ai][bj][m][n][j + 1] * rs + (n ? b1[j + 1] : b0[j + 1]), o[4 * n + j], o[4 * n + j + 1]);
                        *(u32x4*)(gates + (size_t)row * 2048 + col) = pack8(o);
                    }
                }
        }
    }
};
template <bool SECOND> struct EpiMerge {
    static constexpr bool PERM = true, AFTER_DRAIN = false;
    bf16_t* merged; const bf16_t* gates;
    __device__ __forceinline__ void operator()(const AccT& acc, const Unit& u, int wr, int wc, int fr, int fq) const {
        const int row0 = u.pm * 256 + wr * 64 + fr, col0 = u.pn * 256 + wc * 32 + 8 * fq;
#pragma unroll
        for (int ai = 0; ai < 2; ++ai)
#pragma unroll
            for (int m = 0; m < 4; ++m) {
                const int row = row0 + ai * 128 + m * 16;
#pragma unroll
                for (int bj = 0; bj < 2; ++bj) {
                    const int col = col0 + bj * 128; float g[8], o[8];
                    unpack8(*(const u32x4*)(gates + (size_t)row * 2048 + (SECOND ? 1024 : 0) + col), g);
                    bf16_t* mp = merged + (size_t)row * DM + col;
                    if (SECOND) unpack8(*(const u32x4*)mp, o);
#pragma unroll
                    for (int n = 0; n < 2; ++n)
#pragma unroll
                        for (int j = 0; j < 4; ++j) { const float t = g[4 * n + j] * acc[ai][bj][m][n][j]; o[4 * n + j] = SECOND ? o[4 * n + j] + t : t; }
                    *(u32x4*)mp = pack8(o);
                }
            }
    }
};
struct EpiScale {
    static constexpr bool PERM = true, AFTER_DRAIN = false;
    bf16_t* O; int ldc; const float* ss; float sc;
    __device__ __forceinline__ void operator()(const AccT& acc, const Unit& u, int wr, int wc, int fr, int fq) const {
        const int row0 = u.pm * 256 + wr * 64 + fr, col0 = u.pn * 256 + wc * 32 + 8 * fq;
#pragma unroll
        for (int ai = 0; ai < 2; ++ai)
#pragma unroll
            for (int m = 0; m < 4; ++m) {
                const int row = row0 + ai * 128 + m * 16; const float rs = rs_of(ss[row]) * sc;
#pragma unroll
                for (int bj = 0; bj < 2; ++bj) { float o[8];
#pragma unroll
                    for (int n = 0; n < 2; ++n)
#pragma unroll
                        for (int j = 0; j < 4; ++j) o[4 * n + j] = acc[ai][bj][m][n][j] * rs;
                    *(u32x4*)(O + (size_t)row * ldc + col0 + bj * 128) = pack8(o); }
            }
    }
};

struct EpiFinal {
    static constexpr bool PERM = true, AFTER_DRAIN = true;
    float* X; float* ss; const float* gfin; XcdBarrier xb;
    __device__ __forceinline__ void fused(AccT& acc, const Unit& u, int wr, int wc, int fr, int fq) const {
        const int row0 = u.pm * 256 + wr * 64 + fr, col0 = u.pn * 256 + wc * 32 + 8 * fq;
#pragma unroll
        for (int ai = 0; ai < 2; ++ai)
#pragma unroll
            for (int m = 0; m < 4; ++m) {
                const int row = row0 + ai * 128 + m * 16; float sq = 0.f;
#pragma unroll
                for (int bj = 0; bj < 2; ++bj) {
                    const size_t off = (size_t)row * DM + col0 + bj * 128;
                    const f32x4 v0 = *(const f32x4*)(X + off) + 0.5f * acc[ai][bj][m][0], v1 = *(const f32x4*)(X + off + 4) + 0.5f * acc[ai][bj][m][1];
                    acc[ai][bj][m][0] = v0; acc[ai][bj][m][1] = v1;
                    sq += (v0[0] * v0[0] + v0[1] * v0[1]) + (v0[2] * v0[2] + v0[3] * v0[3]) + (v1[0] * v1[0] + v1[1] * v1[1]) + (v1[2] * v1[2] + v1[3] * v1[3]);
                }
                sq += __shfl_xor(sq, 16); sq += __shfl_xor(sq, 32);
                if (fq == 0) unsafeAtomicAdd(ss + row, sq);
            }
        xcd_barrier(xb);
#pragma unroll
        for (int ai = 0; ai < 2; ++ai)
#pragma unroll
            for (int m = 0; m < 4; ++m) {
                const int row = row0 + ai * 128 + m * 16; const float rs = rs_of(ss[row]);
#pragma unroll
                for (int bj = 0; bj < 2; ++bj) {
                    const size_t off = (size_t)row * DM + col0 + bj * 128; const int col = col0 + bj * 128;
                    const f32x4 g0 = *(const f32x4*)(gfin + col), g1 = *(const f32x4*)(gfin + col + 4);
                    *(f32x4*)(X + off) = acc[ai][bj][m][0] * rs * g0; *(f32x4*)(X + off + 4) = acc[ai][bj][m][1] * rs * g1;
                }
            }
    }
};
struct RowSrc { const float* p; int ld; };
template <class F>
__device__ __forceinline__ void wprep(LAS unsigned char* lds, bf16_t* dst, int nrows, int K, const float* gain, F rowsrc, int b0 = (int)blockIdx.x, int nb = (int)gridDim.x) {
    LAS float* tile = (LAS float*)lds;
    const int tid = threadIdx.x, kk = tid >> 4, r4 = (tid & 15) * 4;
    const int ntk = K / 128, ntiles = (nrows / 64) * ntk;
    f32x4 cur[4], nxt[4];
    auto fetch = [&](int t, f32x4 (&v)[4]) {
        const int r0 = (t / ntk) * 64, k0 = (t % ntk) * 128; const RowSrc rs = rowsrc(r0 + r4);
#pragma unroll
        for (int it = 0; it < 4; ++it) { const int k = k0 + kk + 32 * it; f32x4 x = *(const f32x4*)(rs.p + (size_t)k * rs.ld); if (gain) x *= gain[k]; v[it] = x; }
    };
    int t = b0;
    if (t < ntiles) fetch(t, cur);
    for (; t < ntiles; t += nb) {
        const int tn = t + nb;
        if (tn < ntiles) fetch(tn, nxt);
        const int r0 = (t / ntk) * 64, k0 = (t % ntk) * 128;
        __syncthreads();
#pragma unroll
        for (int it = 0; it < 4; ++it)
#pragma unroll
            for (int j = 0; j < 4; ++j) tile[(r4 + j) * 129 + kk + 32 * it] = cur[it][j];
        __syncthreads();
        const int row = tid >> 3, ch = tid & 7;
#pragma unroll
        for (int hf = 0; hf < 2; ++hf) { float o[8];
#pragma unroll
            for (int j = 0; j < 8; ++j) o[j] = tile[row * 129 + hf * 64 + ch * 8 + j];
            *(u32x4*)(dst + (size_t)(r0 + row) * K + k0 + hf * 64 + ch * 8) = pack8(o); }
#pragma unroll
        for (int it = 0; it < 4; ++it) cur[it] = nxt[it];
    }
    __syncthreads();
}

__device__ __forceinline__ void rows_prep(const float* src, bf16_t* dst, float* ss, int nrows) {
    const int lane = threadIdx.x & 63, gw = blockIdx.x * 8 + (threadIdx.x >> 6), nw = gridDim.x * 8;
    for (int r = gw; r < nrows; r += nw) {
        const float* sp = src + (size_t)r * DM; float sq = 0.f;
#pragma unroll
        for (int i = 0; i < 2; ++i) {
            const int c = (i * 64 + lane) * 8;
            const f32x4 a = *(const f32x4*)(sp + c), b = *(const f32x4*)(sp + c + 4);
            sq += (a[0] * a[0] + a[1] * a[1]) + (a[2] * a[2] + a[3] * a[3]) + (b[0] * b[0] + b[1] * b[1]) + (b[2] * b[2] + b[3] * b[3]);
            u32x4 w; w.x = cvt_pk_bf16(a[0], a[1]); w.y = cvt_pk_bf16(a[2], a[3]); w.z = cvt_pk_bf16(b[0], b[1]); w.w = cvt_pk_bf16(b[2], b[3]);
            *(u32x4*)(dst + (size_t)r * DM + c) = w;
        }
#pragma unroll
        for (int o = 32; o >= 1; o >>= 1) sq += __shfl_xor(sq, o);
        if (lane == 0) ss[r] = sq;
    }
}

__device__ __forceinline__ bf16x8 tr_frag(LAS unsigned char* tile, int stride, int k0, int x0, int lane) {
    const int g = lane >> 4, ii = lane & 15, q = ii >> 2, p = ii & 3;
    LAS unsigned char* a = tile + (k0 + 8 * g + q) * stride + (x0 + 4 * p) * 2;
    const s16x4 lo = __builtin_amdgcn_ds_read_tr16_b64_v4i16((LAS s16x4*)a);
    const s16x4 hi = __builtin_amdgcn_ds_read_tr16_b64_v4i16((LAS s16x4*)(a + 4 * stride));
    bf16x8 r; r[0] = lo[0]; r[1] = lo[1]; r[2] = lo[2]; r[3] = lo[3]; r[4] = hi[0]; r[5] = hi[1]; r[6] = hi[2]; r[7] = hi[3]; return r;
}
__device__ __forceinline__ bf16x8 scale_frag(bf16x8 f, const float* s) {
    u32x4 w = __builtin_bit_cast(u32x4, f); float o[8]; unpack8(w, o);
#pragma unroll
    for (int j = 0; j < 8; ++j) o[j] *= s[j];
    return __builtin_bit_cast(bf16x8, pack8(o));
}

constexpr int R_KT = 0, R_KS = 272;
constexpr int R_VT = 128 * 272, R_VS = 144;
constexpr int R_SB = R_VT + 128 * 144;
constexpr int R_PW = R_SB + 128 * 144;
static_assert(R_PW + 8 * 16 * 272 <= LDS_BYTES, "ret lds");
__device__ __forceinline__ void retention_item(LAS unsigned char* lds, int item, const bf16_t* qb, const bf16_t* kb, bf16_t* vb  , float* stats) {
    int tid = threadIdx.x; asm volatile("" : "+v"(tid));
    const int wid = tid >> 6, lane = tid & 63, fr = lane & 15, fg = lane >> 4;
    const int widu = __builtin_amdgcn_readfirstlane(tid >> 6);
    const int b = item >> 4, h = (item >> 2) & 3, es = item & 3;
    const float l2g = __log2f(1.0f - exp2f(-5.0f - (float)h));
    const float cd = exp2f(128.0f * l2g);
    const size_t tok0 = (size_t)b * SEQ;
    LAS unsigned char* Pw = lds + R_PW + wid * (16 * 272);
    f32x4 st[4];
#pragma unroll
    for (int e = 0; e < 4; ++e) st[e] = (f32x4){0.f, 0.f, 0.f, 0.f};
    u32x4 kreg[4], vreg[2], qnext[4], qf[4];
    auto issue = [&](int n) {
        const size_t t0 = tok0 + (size_t)n * 128;
#pragma unroll
        for (int i = 0; i < 4; ++i) { const int c = tid + 512 * i, row = c >> 4, c16 = c & 15; kreg[i] = *(const u32x4*)(kb + (t0 + row) * 512 + h * 128 + c16 * 8); }
#pragma unroll
        for (int i = 0; i < 2; ++i) { const int c = tid + 512 * i, row = c >> 3, c8 = c & 7; vreg[i] = *(const u32x4*)(vb + (t0 + row) * DM + h * 256 + es * 64 + c8 * 8); }
#pragma unroll
        for (int s = 0; s < 4; ++s) qnext[s] = *(const u32x4*)(qb + (t0 + wid * 16 + fr) * 512 + h * 128 + s * 32 + fg * 8);
    };
    issue(0);
    const float qdec = exp2f((float)(wid * 16 + fr + 1) * l2g);
    for (int n = 0; n < 16; ++n) {
        float l2 = l2g; asm volatile("" : "+v"(l2));
        int irow = wid * 16 + fr, fgl = fg; asm volatile("" : "+v"(irow), "+v"(fgl));
        lds_barrier();
#pragma unroll
        for (int i = 0; i < 4; ++i) { const int c = tid + 512 * i, row = c >> 4, c16 = c & 15; *(LAS u32x4*)(lds + R_KT + row * R_KS + c16 * 16) = kreg[i]; }
#pragma unroll
        for (int i = 0; i < 2; ++i) { const int c = tid + 512 * i, row = c >> 3, c8 = c & 7; *(LAS u32x4*)(lds + R_VT + row * R_VS + c8 * 16) = vreg[i]; }
#pragma unroll
        for (int e = 0; e < 4; ++e) { u32x2 w; w.x = cvt_pk_bf16(st[e][0], st[e][1]); w.y = cvt_pk_bf16(st[e][2], st[e][3]);
            *(LAS u32x2*)(lds + R_SB + (wid * 16 + fr) * R_VS + (e * 16 + fg * 4) * 2) = w; }
#pragma unroll
        for (int s = 0; s < 4; ++s) qf[s] = qnext[s];
        if (n + 1 < 16) issue(n + 1);
        lds_barrier();
        {
#pragma unroll
            for (int jf = 0; jf < 8; ++jf) {
                if (jf > (widu | 1)) break;
                f32x4 sc = (f32x4){0.f, 0.f, 0.f, 0.f};
#pragma unroll
                for (int s = 0; s < 4; ++s) {
                    const bf16x8 a = *(const LAS bf16x8*)(lds + R_KT + (jf * 16 + fr) * R_KS + (s * 32 + fg * 8) * 2);
                    sc = __builtin_amdgcn_mfma_f32_16x16x32_bf16(a, __builtin_bit_cast(bf16x8, qf[s]), sc, 0, 0, 0);
                }
                float pv[4];
#pragma unroll
                for (int r = 0; r < 4; ++r) { const int j = jf * 16 + fgl * 4 + r; const int dlt = irow - j; pv[r] = dlt >= 0 ? sc[r] * __builtin_amdgcn_exp2f((float)dlt * l2) : 0.f; }
                u32x2 w; w.x = cvt_pk_bf16(pv[0], pv[1]); w.y = cvt_pk_bf16(pv[2], pv[3]);
                *(LAS u32x2*)(Pw + fr * 272 + (jf * 16 + fg * 4) * 2) = w;
                __builtin_amdgcn_sched_barrier(0);
            }
        }
        asm volatile("s_waitcnt lgkmcnt(0)" ::: "memory");
        {
            f32x4 o[4];
#pragma unroll
            for (int e = 0; e < 4; ++e) { o[e] = (f32x4){0.f, 0.f, 0.f, 0.f}; st[e] *= cd; }
#pragma unroll
            for (int s = 0; s < 4; ++s) {
                const bf16x8 pf = *(const LAS bf16x8*)(Pw + fr * 272 + (s * 32 + fg * 8) * 2);
                float kd[8];
#pragma unroll
                for (int j = 0; j < 8; ++j) kd[j] = __builtin_amdgcn_exp2f((float)(127 - (s * 32 + fgl * 8 + j)) * l2);
                const bf16x8 kf = scale_frag(tr_frag(lds + R_KT, R_KS, s * 32, wid * 16, lane), kd);
                float qs[8];
#pragma unroll
                for (int j = 0; j < 8; ++j) qs[j] = qdec;
                const bf16x8 qsf = scale_frag(__builtin_bit_cast(bf16x8, qf[s]), qs);
#pragma unroll
                for (int e = 0; e < 4; ++e) {
                    const bf16x8 vf = tr_frag(lds + R_VT, R_VS, s * 32, e * 16, lane);
                    if (s <= (widu >> 1)) o[e] = __builtin_amdgcn_mfma_f32_16x16x32_bf16(vf, pf, o[e], 0, 0, 0);
                    st[e] = __builtin_amdgcn_mfma_f32_16x16x32_bf16(vf, kf, st[e], 0, 0, 0);
                    const bf16x8 sf = tr_frag(lds + R_SB, R_VS, s * 32, e * 16, lane);
                    o[e] = __builtin_amdgcn_mfma_f32_16x16x32_bf16(sf, qsf, o[e], 0, 0, 0);
                }
                __builtin_amdgcn_sched_barrier(0);
            }
            const size_t tok = tok0 + (size_t)n * 128 + wid * 16 + fr;
            float s1 = 0.f, s2 = 0.f;
#pragma unroll
            for (int e = 0; e < 4; ++e) {
                u32x2 w; w.x = cvt_pk_bf16(o[e][0], o[e][1]); w.y = cvt_pk_bf16(o[e][2], o[e][3]);
                *(u32x2*)(vb + tok * DM + h * 256 + es * 64 + e * 16 + fg * 4) = w;
                s1 += (o[e][0] + o[e][1]) + (o[e][2] + o[e][3]);
                s2 += (o[e][0] * o[e][0] + o[e][1] * o[e][1]) + (o[e][2] * o[e][2] + o[e][3] * o[e][3]);
            }
            s1 += __shfl_xor(s1, 16); s1 += __shfl_xor(s1, 32); s2 += __shfl_xor(s2, 16); s2 += __shfl_xor(s2, 32);
            if (fg == 0) { unsafeAtomicAdd(stats + (tok * 4 + h) * 2, s1); unsafeAtomicAdd(stats + (tok * 4 + h) * 2 + 1, s2); }
        }
    }
    lds_barrier();
}

constexpr int L_XC = 0;
constexpr int L_WL = 128 * 272;
constexpr int L_SA = L_WL + 128 * 272;
constexpr int L_SBX = L_SA + 32768;
constexpr int L_SEGA = L_SBX + 32768;
constexpr int L_SEGB = L_SEGA + 2048;
constexpr int L_CARRY = L_SEGB + 2048;
constexpr int L_CW = L_CARRY + 512;
static_assert(L_CW + 5 * 512 <= LDS_BYTES - 16, "lru lds");
__device__ __forceinline__ void lru_item(LAS unsigned char* lds, int item, const bf16_t* xl, bf16_t* gg  , const bf16_t* wlru,
                                         const float* conv_w, const float* conv_b, const float* b_r, const float* b_i, const float* lam) {
    int tid = threadIdx.x; asm volatile("" : "+v"(tid));
    const int wid = tid >> 6, lane = tid & 63, fr = lane & 15, fg = lane >> 4;
    const int b = item >> 4, g = (item >> 1) & 7, hf2 = item & 1;
    const int chg = g * 128, c0 = chg + hf2 * 64;
    const size_t tok0 = (size_t)b * SEQ;
    for (int c = tid; c < 128 * 16; c += 512) { const int n = c >> 4, c16 = c & 15; const bf16_t* src = wlru + ((size_t)(n >> 6) * 1024 + c0 + (n & 63)) * 128 + c16 * 8;
        *(LAS u32x4*)(lds + L_WL + n * 272 + c16 * 16) = *(const u32x4*)src; }
    if (tid < 64) ((LAS float*)(lds + L_CARRY))[tid] = 0.f;
    const int ch8 = tid & 15;
    for (int c = tid; c < 5 * 128; c += 512) ((LAS float*)(lds + L_CW))[c] = c < 512 ? conv_w[(c >> 7) * DM + chg + (c & 127)] : conv_b[chg + (c & 127)];
    float br_[4], bi_[4], sp_[4];
#pragma unroll
    for (int hf = 0; hf < 4; ++hf) { const int ch = c0 + hf * 16 + fr; br_[hf] = b_r[ch]; bi_[hf] = b_i[ch]; sp_[hf] = log1pf(__expf(-lam[ch])); }
    u32x4 rwn[7];
    auto load_rows = [&](int T0n) {
        const int tk0 = (tid >> 4) * 4;
#pragma unroll
        for (int q = 0; q < 7; ++q) { const int ts = T0n + tk0 - 3 + q; rwn[q] = ts >= 0 ? *(const u32x4*)(xl + (tok0 + ts) * DM + chg + ch8 * 8) : (u32x4){0u, 0u, 0u, 0u}; }
    };
    load_rows(0);
    for (int tile = 0; tile < 16; ++tile) {
        const int T0 = tile * 128;
        bf16_t gpre[16];
#pragma unroll
        for (int t = 0; t < 16; ++t) gpre[t] = gg[(tok0 + T0 + wid * 16 + t) * DM + c0 + lane];
        {
            const int tk0 = (tid >> 4) * 4;
            float acc8[4][8], cw[4][8];
            { const f32x4 b0 = *(const LAS f32x4*)(lds + L_CW + 2048 + ch8 * 32), b1 = *(const LAS f32x4*)(lds + L_CW + 2048 + ch8 * 32 + 16);
#pragma unroll
              for (int i = 0; i < 4; ++i)
#pragma unroll
                for (int j = 0; j < 4; ++j) { acc8[i][j] = b0[j]; acc8[i][4 + j] = b1[j]; } }
#pragma unroll
            for (int t = 0; t < 4; ++t) { const f32x4 w0 = *(const LAS f32x4*)(lds + L_CW + t * 512 + ch8 * 32), w1 = *(const LAS f32x4*)(lds + L_CW + t * 512 + ch8 * 32 + 16);
#pragma unroll
                for (int j = 0; j < 4; ++j) { cw[t][j] = w0[j]; cw[t][4 + j] = w1[j]; } }
#pragma unroll
            for (int q = 0; q < 7; ++q) { float x[8]; unpack8(rwn[q], x);
#pragma unroll
                for (int i = 0; i < 4; ++i) { const int tap = q - i;
                    if (tap >= 0 && tap < 4) {
#pragma unroll
                        for (int j = 0; j < 8; ++j) acc8[i][j] += cw[tap][j] * x[j]; } } }
#pragma unroll
            for (int i = 0; i < 4; ++i) *(LAS u32x4*)(lds + L_XC + (tk0 + i) * 272 + ch8 * 16) = pack8(acc8[i]);
            if (tile + 1 < 16) load_rows(T0 + 128);
        }
        lds_barrier();
        {
            f32x4 ga[8];
#pragma unroll
            for (int nf = 0; nf < 8; ++nf) ga[nf] = (f32x4){0.f, 0.f, 0.f, 0.f};
#pragma unroll
            for (int s = 0; s < 4; ++s) {
                const bf16x8 af = *(const LAS bf16x8*)(lds + L_XC + (wid * 16 + fr) * 272 + (s * 32 + fg * 8) * 2);
#pragma unroll
                for (int nf = 0; nf < 8; ++nf) {
                    const bf16x8 bfr = *(const LAS bf16x8*)(lds + L_WL + (nf * 16 + fr) * 272 + (s * 32 + fg * 8) * 2);
                    ga[nf] = __builtin_amdgcn_mfma_f32_16x16x32_bf16(af, bfr, ga[nf], 0, 0, 0);
                }
            }
#pragma unroll
            for (int hf = 0; hf < 4; ++hf)
#pragma unroll
                for (int r = 0; r < 4; ++r) {
                    const int tk = wid * 16 + fg * 4 + r, cl = hf * 16 + fr;
                    float rg, ig; sigmoid2(ga[hf][r] + br_[hf], ga[4 + hf][r] + bi_[hf], rg, ig);
                    const float la = -8.0f * rg * sp_[hf]; const float a = __expf(la); const float mult = __builtin_amdgcn_sqrtf(fmaxf(fmaf(-a, a, 1.0f), 0.f));
                    const float x = bf2f(*(const LAS bf16_t*)(lds + L_XC + tk * 272 + (hf2 * 64 + cl) * 2));
                    ((LAS float*)(lds + L_SA))[tk * 64 + cl] = a; ((LAS float*)(lds + L_SBX))[tk * 64 + cl] = mult * ig * x;
                }
        }
        asm volatile("s_waitcnt lgkmcnt(0)" ::: "memory");
        {
            const int c = lane, sg = wid;
            float A = 1.f, B = 0.f;
#pragma unroll
            for (int t = 0; t < 16; ++t) { const float a_ = ((LAS float*)(lds + L_SA))[(sg * 16 + t) * 64 + c], b_ = ((LAS float*)(lds + L_SBX))[(sg * 16 + t) * 64 + c]; A *= a_; B = a_ * B + b_; }
            ((LAS float*)(lds + L_SEGA))[sg * 64 + c] = A; ((LAS float*)(lds + L_SEGB))[sg * 64 + c] = B;
            lds_barrier();
            float hst = ((LAS float*)(lds + L_CARRY))[(tile & 1) * 64 + c];
            { float sa_[7], sb_[7];
#pragma unroll
              for (int s2 = 0; s2 < 7; ++s2) { sa_[s2] = ((LAS float*)(lds + L_SEGA))[s2 * 64 + c]; sb_[s2] = ((LAS float*)(lds + L_SEGB))[s2 * 64 + c]; }
#pragma unroll
              for (int s2 = 0; s2 < 7; ++s2) hst = s2 < sg ? sa_[s2] * hst + sb_[s2] : hst; }
#pragma unroll
            for (int t = 0; t < 16; ++t) {
                hst = ((LAS float*)(lds + L_SA))[(sg * 16 + t) * 64 + c] * hst + ((LAS float*)(lds + L_SBX))[(sg * 16 + t) * 64 + c];
                gg[(tok0 + T0 + sg * 16 + t) * DM + c0 + c] = (bf16_t)(cvt_pk_bf16(hst * bf2f(gpre[t]), 0.f) & 0xffffu);
            }
            if (sg == 7) ((LAS float*)(lds + L_CARRY))[((tile + 1) & 1) * 64 + c] = hst;
        }
    }
    lds_barrier();
}

constexpr int X_T = 0, X_TS = 528;
constexpr int X_VS = 272;
constexpr int X_PW = 256 * 272;
constexpr int X_SCR = X_PW + 8 * 16 * 272;
static_assert(128 * 528 <= X_PW && X_SCR + 8 * 256 <= 128 * 1024, "xattn lds");
__device__ __forceinline__ void xattn_items(LAS unsigned char* lds, const int* items, int nitems, const bf16_t* xq, const bf16_t* xkv, bf16_t* xo) {
    int tid = threadIdx.x; asm volatile("" : "+v"(tid));
    const int wid = tid >> 6, lane = tid & 63, fr = lane & 15, fg = lane >> 4;
    LAS unsigned char* Pw = lds + X_PW + wid * (16 * 272);
    u32x4 pre[8];
    auto loadK = [&](int b, int h, int mt) {
#pragma unroll
        for (int i = 0; i < 8; ++i) { const int c = tid + 512 * i, row = c >> 5, c16 = c & 31; pre[i] = *(const u32x4*)(xkv + ((size_t)b * 256 + mt * 128 + row) * 2048 + h * 256 + c16 * 8); } };
    auto loadV = [&](int b, int h, int mt) {
#pragma unroll
        for (int i = 0; i < 8; ++i) { const int c = tid + 512 * i, m = c & 127, c16 = c >> 7; pre[i] = *(const u32x4*)(xkv + ((size_t)b * 256 + mt * 128 + m) * 2048 + 1024 + h * 256 + c16 * 8); } };
    auto putK = [&]() {
#pragma unroll
        for (int i = 0; i < 8; ++i) { const int c = tid + 512 * i, row = c >> 5, c16 = c & 31; *(LAS u32x4*)(lds + X_T + row * X_TS + c16 * 16) = pre[i]; } };
    auto putV = [&]() {
#pragma unroll
        for (int i = 0; i < 8; ++i) { const int c = tid + 512 * i, m = c & 127, c16 = c >> 7; const u32x4 w = pre[i];
            LAS unsigned char* dp = lds + X_T + (c16 * 8) * X_VS + m * 2;
            *(LAS bf16_t*)(dp + 0 * X_VS) = (bf16_t)(w.x & 0xffffu); *(LAS bf16_t*)(dp + 1 * X_VS) = (bf16_t)(w.x >> 16);
            *(LAS bf16_t*)(dp + 2 * X_VS) = (bf16_t)(w.y & 0xffffu); *(LAS bf16_t*)(dp + 3 * X_VS) = (bf16_t)(w.y >> 16);
            *(LAS bf16_t*)(dp + 4 * X_VS) = (bf16_t)(w.z & 0xffffu); *(LAS bf16_t*)(dp + 5 * X_VS) = (bf16_t)(w.z >> 16);
            *(LAS bf16_t*)(dp + 6 * X_VS) = (bf16_t)(w.w & 0xffffu); *(LAS bf16_t*)(dp + 7 * X_VS) = (bf16_t)(w.w >> 16); } };
    { const int it0 = items[0]; loadK(it0 >> 6, (it0 >> 4) & 3, 0); }
    for (int ii = 0; ii < nitems; ++ii) {
        const int item = items[ii];
        const int b = item >> 6, h = (item >> 4) & 3, qt = item & 15;
        const size_t tok = (size_t)b * SEQ + qt * 128 + wid * 16 + fr;
        bf16x8 qf[8];
#pragma unroll
        for (int s = 0; s < 8; ++s) qf[s] = __builtin_bit_cast(bf16x8, *(const u32x4*)(xq + tok * DM + h * 256 + s * 32 + fg * 8));
        f32x4 sc[16];
#pragma unroll
        for (int mt = 0; mt < 2; ++mt) {
            lds_barrier();
            putK();
            if (mt == 0) loadK(b, h, 1); else loadV(b, h, 0);
            lds_barrier();
#pragma unroll
            for (int mf = 0; mf < 8; ++mf) {
                f32x4 a4 = (f32x4){0.f, 0.f, 0.f, 0.f};
#pragma unroll
                for (int s = 0; s < 8; ++s) {
                    const bf16x8 kf = *(const LAS bf16x8*)(lds + X_T + (mf * 16 + fr) * X_TS + (s * 32 + fg * 8) * 2);
                    a4 = __builtin_amdgcn_mfma_f32_16x16x32_bf16(kf, qf[s], a4, 0, 0, 0);
                }
                sc[mt * 8 + mf] = a4;
            }
        }
        float mx = -3.0e38f;
#pragma unroll
        for (int f = 0; f < 16; ++f) mx = fmaxf(mx, fmaxf(fmaxf(sc[f][0], sc[f][1]), fmaxf(sc[f][2], sc[f][3])));
        volatile LAS float* scr = (volatile LAS float*)(lds + X_SCR) + wid * 64;
        scr[lane] = mx;
        { const float m0 = scr[fr], m1 = scr[fr + 16], m2 = scr[fr + 32], m3 = scr[fr + 48]; mx = fmaxf(fmaxf(m0, m1), fmaxf(m2, m3)); }
        float sum = 0.f;
#pragma unroll
        for (int f = 0; f < 16; ++f)
#pragma unroll
            for (int r = 0; r < 4; ++r) { const float pe = __expf(sc[f][r] - mx); sc[f][r] = pe; sum += pe; }
        scr[lane] = sum;
        { const float m0 = scr[fr], m1 = scr[fr + 16], m2 = scr[fr + 32], m3 = scr[fr + 48]; sum = (m0 + m1) + (m2 + m3); }
        const float inv = 1.0f / sum;
        f32x4 o[16];
#pragma unroll
        for (int f = 0; f < 16; ++f) o[f] = (f32x4){0.f, 0.f, 0.f, 0.f};
#pragma unroll
        for (int mt = 0; mt < 2; ++mt) {
            lds_barrier();
            putV();
            if (mt == 0) loadV(b, h, 1);
            else if (ii + 1 < nitems) { const int itn = items[ii + 1]; loadK(itn >> 6, (itn >> 4) & 3, 0); }
#pragma unroll
            for (int f = 0; f < 8; ++f) { const f32x4 pv = sc[mt * 8 + f] * inv; u32x2 w; w.x = cvt_pk_bf16(pv[0], pv[1]); w.y = cvt_pk_bf16(pv[2], pv[3]);
                *(LAS u32x2*)(Pw + fr * 272 + (f * 16 + fg * 4) * 2) = w; }
            lds_barrier();
#pragma unroll
            for (int s = 0; s < 4; ++s) {
                const bf16x8 pf = *(const LAS bf16x8*)(Pw + fr * 272 + (s * 32 + fg * 8) * 2);
#pragma unroll
                for (int df = 0; df < 16; ++df) {
                    const bf16x8 vf = *(const LAS bf16x8*)(lds + X_T + (df * 16 + fr) * X_VS + (s * 32 + fg * 8) * 2);
                    o[df] = __builtin_amdgcn_mfma_f32_16x16x32_bf16(vf, pf, o[df], 0, 0, 0);
                }
            }
        }
#pragma unroll
        for (int df = 0; df < 16; ++df) { u32x2 w; w.x = cvt_pk_bf16(o[df][0], o[df][1]); w.y = cvt_pk_bf16(o[df][2], o[df][3]);
            *(u32x2*)(xo + tok * DM + h * 256 + df * 16 + fg * 4) = w; }
    }
    lds_barrier();
}
__device__ __forceinline__ void xattn_pair(LAS unsigned char* lds, int i0, const bf16_t* xq, const bf16_t* xkv, bf16_t* xo) { const int it[2] = {i0, i0 + 1}; xattn_items(lds, it, 2, xq, xkv, xo); }
__device__ __forceinline__ void xattn_item(LAS unsigned char* lds, int item, const bf16_t* xq, const bf16_t* xkv, bf16_t* xo) { const int it[1] = {item}; xattn_items(lds, it, 1, xq, xkv, xo); }

struct Ptrs {
    unsigned char* ws; float *ss1, *ss2, *ss3, *ss4, *ss5, *ssm, *stats, *rcos, *rsin; bf16_t *mb, *xkv, *B0, *B1, *B2, *B3, *B4, *qbuf, *kbuf;
    __device__ __forceinline__ explicit Ptrs(unsigned char* w) {
        size_t z = 0; asm volatile("" : "+s"(z));
        ws = w + z; ss1 = (float*)(ws + S_SS); ss2 = ss1 + T_TOK; ss3 = ss2 + T_TOK; ss4 = ss3 + T_TOK; ss5 = ss4 + T_TOK;
        ssm = (float*)(ws + S_SSM); stats = (float*)(ws + S_STATS); rcos = (float*)(ws + S_COS); rsin = (float*)(ws + S_SIN);
        mb = (bf16_t*)(ws + A_MB); xkv = (bf16_t*)(ws + A_XKV);
        B0 = (bf16_t*)(ws + A_B0); B1 = (bf16_t*)(ws + A_B1); B2 = (bf16_t*)(ws + A_B2); B3 = (bf16_t*)(ws + A_B3); B4 = (bf16_t*)(ws + A_B4);
        qbuf = B1; kbuf = B1 + (size_t)T_TOK * 512;
    }
    __device__ __forceinline__ const bf16_t* w(size_t off) const { return (const bf16_t*)(ws + off); }
};
template <class Epi>
__device__ __forceinline__ void run_gemm(LAS unsigned char* lds, const bf16_t* A, int lda, const bf16_t* Bt, int M, int N, int K, int c, const Epi& E) {
    pg8::StaticOrder S; S.init(M, N, (int)gridDim.x, c);
    pg8::gemm_phase(lds, pg8::Gemm{A, Bt, M, N, K, lda, K}, S, E);
}
__device__ __forceinline__ void phase_prep(const Params& p, LAS unsigned char* lds) {
    const Ptrs P(p.ws); unsigned char* ws = P.ws;
    const int G = (int)gridDim.x, bid = (int)blockIdx.x, tid = threadIdx.x;
    for (int i = bid * 512 + tid; i < 4 * T_TOK; i += G * 512) P.ss2[i] = 0.f;
    for (int i = bid * 512 + tid; i < T_TOK * 8; i += G * 512) P.stats[i] = 0.f;
    for (int i = bid * 512 + tid; i < SEQ * 64; i += G * 512) {
        const int pos = i >> 6, d = i & 63;
        const float invf = exp2f(-(float)d * (13.287712379549449f / 64.0f));
        const float ang = (float)pos * invf;
        const float nrev = rintf(ang * 0.15915494309189535f);
        float r = fmaf(-nrev, 6.2831854820251465f, ang); r = fmaf(-nrev, -1.7484555314695172e-07f, r);
        P.rcos[i] = __builtin_amdgcn_cosf(r * 0.15915494309189535f); P.rsin[i] = __builtin_amdgcn_sinf(r * 0.15915494309189535f);
    }
    rows_prep(p.in[0], P.B0, P.ss1, T_TOK);
    rows_prep(p.in[1], P.mb, P.ssm, MEMT);
    const float* w1a = p.in[3]; const float* w3a = p.in[4];
    wprep(lds, (bf16_t*)(ws + W_13A), 5632, 1024, p.in[2], [=](int r) { const int pn = r >> 8, bj = (r >> 7) & 1, pp = r & 127; return RowSrc{(bj ? w3a : w1a) + pn * 128 + pp, DFF}; });
    const float* w2a = p.in[5];
    wprep(lds, (bf16_t*)(ws + W_2A), 1024, 2816, nullptr, [=](int r) { return RowSrc{w2a + r, 1024}; });
    const float* win = p.in[7];
    wprep(lds, (bf16_t*)(ws + W_IN), 4096, 1024, p.in[6], [=](int r) {
        int col;
        if (r < 1024) { const int seg = r >> 9, rr = r & 511, pnl = rr >> 8, bj = (rr >> 7) & 1, pp = rr & 127; const int head = 2 * pnl + (pp >> 6), d = pp & 63; col = seg * 512 + head * 128 + 64 * bj + d; }
        else if (r < 2048) col = 3072 + (r - 1024);
        else if (r < 3072) col = 1024 + (r - 2048);
        else col = 4096 + (r - 3072);
        return RowSrc{win + col, 5120}; });
    const float* wxk = p.in[24]; const float* wxv = p.in[25];
    wprep(lds, (bf16_t*)(ws + W_XKV), 2048, 1024, p.in[22], [=](int r) { return r < 1024 ? RowSrc{wxk + r, 1024} : RowSrc{wxv + (r - 1024), 1024}; });
    const float* wrg = p.in[12]; const float* wig = p.in[14];
    wprep(lds, (bf16_t*)(ws + W_LRU), 2048, 128, nullptr, [=](int r) { const int gi = (r >> 7) & 7, c = r & 127; return RowSrc{(r < 1024 ? wrg : wig) + gi * 16384 + c, 128}; });
}
__device__ __forceinline__ void phase1_late(const Params& p, LAS unsigned char* lds, unsigned char* ws) {
    const int G = (int)gridDim.x, bid = (int)blockIdx.x;
    const int nlate = G / 4, l0 = G - nlate;
    if (bid >= l0) {
        const float* w1b = p.in[28]; const float* w3b = p.in[29];
        wprep(lds, (bf16_t*)(ws + W_13B), 5632, 1024, p.in[27], [=](int r) { const int pn = r >> 8, bj = (r >> 7) & 1, pp = r & 127; return RowSrc{(bj ? w3b : w1b) + pn * 128 + pp, DFF}; }, bid - l0, nlate);
        const float* w2b = p.in[30];
        wprep(lds, (bf16_t*)(ws + W_2B), 1024, 2816, nullptr, [=](int r) { return RowSrc{w2b + r, 1024}; }, bid - l0, nlate);
    } else if (bid >= G / 2) {
        const int m0 = G / 2, nm = l0 - m0;
        const float* wout = p.in[20]; wprep(lds, (bf16_t*)(ws + W_OUT), 1024, 1024, nullptr, [=](int r) { return RowSrc{wout + r, 1024}; }, bid - m0, nm);
        const float* wxq = p.in[23]; wprep(lds, (bf16_t*)(ws + W_XQ), 1024, 1024, p.in[21], [=](int r) { return RowSrc{wxq + r, 1024}; }, bid - m0, nm);
        const float* wxo = p.in[26]; wprep(lds, (bf16_t*)(ws + W_XO), 1024, 1024, nullptr, [=](int r) { return RowSrc{wxo + r, 1024}; }, bid - m0, nm);
    }
}
__device__ __forceinline__ void phase_mix(const Params& p, LAS unsigned char* lds, int mode = 0) {
    const Ptrs P(p.ws); const int G = (int)gridDim.x, bid = (int)blockIdx.x;
    if (G == 256) {
        if (bid < 128) { retention_item(lds, bid, P.qbuf, P.kbuf, P.B3, P.stats);
            unsigned char* ws = P.ws; const float* win = p.in[7]; const float* wbg = p.in[18];
            wprep(lds, (bf16_t*)(ws + W_GG), 3072, 1024, p.in[6], [=](int r) { return r < 1024 ? RowSrc{win + 2048 + r, 5120} : RowSrc{wbg + (r - 1024), 2048}; }, bid, 128);
            const float* wro = p.in[9]; wprep(lds, (bf16_t*)(ws + W_RO), 1024, 1024, nullptr, [=](int r) { return RowSrc{wro + r, 1024}; }, bid, 128);
            const float* wlo = p.in[17]; wprep(lds, (bf16_t*)(ws + W_LO), 1024, 1024, nullptr, [=](int r) { return RowSrc{wlo + r, 1024}; }, bid, 128); }
        else lru_item(lds, bid - 128, P.B2, P.B4, P.w(W_LRU), p.in[10], p.in[11], p.in[13], p.in[15], p.in[16]);
    } else {
        { unsigned char* ws = P.ws; const float* win = p.in[7]; const float* wbg = p.in[18];
          wprep(lds, (bf16_t*)(ws + W_GG), 3072, 1024, p.in[6], [=](int r) { return r < 1024 ? RowSrc{win + 2048 + r, 5120} : RowSrc{wbg + (r - 1024), 2048}; });
          const float* wro = p.in[9]; wprep(lds, (bf16_t*)(ws + W_RO), 1024, 1024, nullptr, [=](int r) { return RowSrc{wro + r, 1024}; });
          const float* wlo = p.in[17]; wprep(lds, (bf16_t*)(ws + W_LO), 1024, 1024, nullptr, [=](int r) { return RowSrc{wlo + r, 1024}; }); }
        for (int it = bid; it < 256; it += G) {
            if (it < 128) retention_item(lds, it, P.qbuf, P.kbuf, P.B3, P.stats);
            else lru_item(lds, it - 128, P.B2, P.B4, P.w(W_LRU), p.in[10], p.in[11], p.in[13], p.in[15], p.in[16]);
        }
    }
}
__device__ __forceinline__ void phase_final(const Params& p) {
    const Ptrs P(p.ws); const int G = (int)gridDim.x, bid = (int)blockIdx.x, tid = threadIdx.x;
    const float* gf = p.in[31]; float* X = p.out;
    for (int i = bid * 512 + tid; i < T_TOK * 256; i += G * 512) {
        const int row = i >> 8, c = (i & 255) * 4; const float rs = rs_of(P.ss5[row]);
        f32x4 v = *(f32x4*)(X + (size_t)row * DM + c); const f32x4 gv = *(const f32x4*)(gf + c);
        v = v * rs * gv; *(f32x4*)(X + (size_t)row * DM + c) = v;
    }
}

__global__ __launch_bounds__(512, 2) void fwd_mega(Params p) {
    extern __shared__ __attribute__((aligned(16))) unsigned char shm[];
    LAS unsigned char* lds = (LAS unsigned char*)shm;
    cg::grid_group grid = cg::this_grid();
    const int bid = (int)blockIdx.x, G = (int)gridDim.x;
    unsigned* bar = (unsigned*)(p.ws + S_BAR);
    volatile LAS unsigned* xst = (volatile LAS unsigned*)(lds + LDS_BYTES - 16);
    if (threadIdx.x == 0) { xst[0] = 0u; xst[1] = 0u; }
    __syncthreads();
    const XcdBarrier xb = xcd_barrier_post(bar, xst);
    if (p.ph_lo > 1000) grid.sync();
#ifndef PHMASK
#define PHMASK 0x7fff
#endif
#ifndef REPMASK
#define REPMASK 0
#endif
#define PHASE(k, body) if (((PHMASK >> (k)) & 1) && p.ph_lo <= (k) && (k) < p.ph_hi) { if ((k) > p.ph_lo) xcd_barrier(xb); { body } if ((REPMASK >> (k)) & 1) { xcd_barrier(xb); { body } } }
    PHASE(0, phase_prep(p, lds);)
    PHASE(1, { const Ptrs P(p.ws);
        run_gemm(lds, P.B0, 1024, P.w(W_13A), T_TOK, 5632, 1024, bid, EpiSwiglu{P.B1, P.ss1});
        run_gemm(lds, P.mb, 1024, P.w(W_XKV), MEMT, 2048, 1024, (bid + G / 2) % G, EpiScale{P.xkv, 2048, P.ssm, 1.0f});
        phase1_late(p, lds, P.ws); })
    PHASE(2, { const Ptrs P(p.ws);
        run_gemm(lds, P.B1, DFF, P.w(W_2A), T_TOK, 1024, DFF, bid, EpiResid<true>{p.in[0], p.out, P.B0, P.ss2, 0.5f}); })
    PHASE(3, { const Ptrs P(p.ws);
        run_gemm(lds, P.B0, 1024, P.w(W_IN), T_TOK, 4096, 1024, bid, EpiInproj{P.qbuf, P.B2, P.ss2, P.rcos, P.rsin}); })
    PHASE(4, phase_mix(p, lds);)
    PHASE(5, { const Ptrs P(p.ws);
        run_gemm(lds, P.B0, 1024, P.w(W_GG), T_TOK, 3072, 1024, bid, EpiGG{P.B3, P.B1, P.ss2, P.stats, p.in[8], p.in[19]}); })
    PHASE(6, { const Ptrs P(p.ws);
        run_gemm(lds, P.B3, 1024, P.w(W_RO), T_TOK, 1024, 1024, bid, EpiMerge<false>{P.B0, P.B1}); })
    if (((PHMASK >> 7) & 1) && p.ph_lo <= 7 && 7 < p.ph_hi) { const Ptrs P(p.ws);
        run_gemm(lds, P.B4, 1024, P.w(W_LO), T_TOK, 1024, 1024, bid, EpiMerge<true>{P.B0, P.B1}); }
    PHASE(8, { const Ptrs P(p.ws);
        run_gemm(lds, P.B0, 1024, P.w(W_OUT), T_TOK, 1024, 1024, bid, EpiResid<true>{p.out, p.out, P.B3, P.ss3, 1.0f}); })
    PHASE(9, { const Ptrs P(p.ws);
        run_gemm(lds, P.B3, 1024, P.w(W_XQ), T_TOK, 1024, 1024, bid, EpiScale{P.B4, 1024, P.ss3, 0.0625f});
        if (G == 256) {
            pg8::StaticOrder S; S.init(T_TOK, 1024, G, bid); Unit u; S.next(0, u);
            asm volatile("s_waitcnt vmcnt(0)" ::: "memory"); __syncthreads();
            xattn_pair(lds, ((u.pm >> 3) << 6) | (u.pn << 4) | ((u.pm & 7) * 2), P.B4, P.xkv, P.B0);
        } })
    if (G != 256) { PHASE(10, { const Ptrs P(p.ws);
        for (int it = bid; it < 512; it += G) xattn_item(lds, it, P.B4, P.xkv, P.B0); }) }
    PHASE(11, { const Ptrs P(p.ws);
        run_gemm(lds, P.B0, 1024, P.w(W_XO), T_TOK, 1024, 1024, bid, EpiResid<true>{p.out, p.out, P.B4, P.ss4, 1.0f}); })
    PHASE(12, { const Ptrs P(p.ws);
        run_gemm(lds, P.B4, 1024, P.w(W_13B), T_TOK, 5632, 1024, bid, EpiSwiglu{P.B1, P.ss4}); })
    if (G == 256) {
        PHASE(13, { const Ptrs P(p.ws);
            run_gemm(lds, P.B1, DFF, P.w(W_2B), T_TOK, 1024, DFF, bid, EpiFinal{p.out, P.ss5, p.in[31], xb}); })
    } else {
        PHASE(13, { const Ptrs P(p.ws);
            run_gemm(lds, P.B1, DFF, P.w(W_2B), T_TOK, 1024, DFF, bid, EpiResid<false>{p.out, p.out, nullptr, P.ss5, 0.5f}); })
        PHASE(14, phase_final(p);)
    }
#undef PHASE
}

constexpr int N_PHASES = 15;
#ifndef DBG_HI
#define DBG_HI N_PHASES
#endif
extern "C" void kernel_launch(void* const* d_in, const int* in_sizes, int n_in, void* d_out, int out_size, void* d_ws, size_t ws_size, hipStream_t stream) {
    static int grid = 0;
    if (grid == 0) {
        if (n_in != 32 || out_size != T_TOK * DM || ws_size < WS_NEED) { fprintf(stderr, "kernel_launch: unexpected shapes (n_in %d out %d ws %zu)\n", n_in, out_size, ws_size); grid = -1; return; }
        int dev = 0, cus = 0, per_cu = 0;
        hipGetDevice(&dev); hipDeviceGetAttribute(&cus, hipDeviceAttributeMultiprocessorCount, dev);
        hipFuncSetAttribute((const void*)fwd_mega, hipFuncAttributeMaxDynamicSharedMemorySize, LDS_BYTES);
        hipOccupancyMaxActiveBlocksPerMultiprocessor(&per_cu, (const void*)fwd_mega, 512, LDS_BYTES);
        if (per_cu < 1) { fprintf(stderr, "kernel_launch: occupancy query says %d blocks/CU\n", per_cu); per_cu = 1; }
        (void)hipGetLastError();
        grid = cus;
    }
    if (grid < 0) return;
    Params p{};
    for (int i = 0; i < 32; ++i) p.in[i] = (const float*)d_in[i];
    p.out = (float*)d_out; p.ws = (unsigned char*)d_ws;
#ifndef N_CUTS
#define N_CUTS 1
#endif
    if (hipMemsetAsync((unsigned char*)d_ws + S_BAR, 0, 16384, stream) != hipSuccess) { fprintf(stderr, "kernel_launch: memset of the barrier word failed\n"); return; }
    for (int li = 0; li < N_CUTS; ++li) {
        p.ph_lo = li * DBG_HI / N_CUTS; p.ph_hi = (li + 1) * DBG_HI / N_CUTS;
        void* args[] = {&p};
        hipError_t e = hipLaunchCooperativeKernel((const void*)fwd_mega, dim3(grid), dim3(512), args, LDS_BYTES, stream);
        if (e != hipSuccess) fprintf(stderr, "cooperative launch failed: %s (grid %d)\n", hipGetErrorString(e), grid);
    }
}
```

```cpp
#include <hip/hip_runtime.h>
#include <hip/hip_cooperative_groups.h>
#include <cstdio>
namespace cg = cooperative_groups;

#define LAS __attribute__((address_space(3)))
typedef unsigned short bf16_t;
typedef short bf16x8 __attribute__((ext_vector_type(8)));
typedef short s16x4 __attribute__((ext_vector_type(4)));
typedef float f32x4 __attribute__((ext_vector_type(4)));
typedef unsigned u32x4 __attribute__((ext_vector_type(4)));
typedef unsigned u32x2 __attribute__((ext_vector_type(2)));

constexpr int T_TOK = 16384, DM = 1024, SEQ = 2048, NB = 8, DFF = 2816, MEMT = 2048;
constexpr float EPS = 1e-6f;
constexpr int LDS_BYTES = 140 * 1024;

constexpr size_t MiB = 1024 * 1024;
constexpr size_t W_13A = 0;
constexpr size_t W_2A = W_13A + (size_t)5632 * 1024 * 2;
constexpr size_t W_IN = W_2A + (size_t)1024 * 2816 * 2;
constexpr size_t W_GG = W_IN + (size_t)4096 * 1024 * 2;
constexpr size_t W_RO = W_GG + (size_t)3072 * 1024 * 2;
constexpr size_t W_LO = W_RO + (size_t)1024 * 1024 * 2;
constexpr size_t W_OUT = W_LO + (size_t)1024 * 1024 * 2;
constexpr size_t W_XQ = W_OUT + (size_t)1024 * 1024 * 2;
constexpr size_t W_XKV = W_XQ + (size_t)1024 * 1024 * 2;
constexpr size_t W_XO = W_XKV + (size_t)2048 * 1024 * 2;
constexpr size_t W_13B = W_XO + (size_t)1024 * 1024 * 2;
constexpr size_t W_2B = W_13B + (size_t)5632 * 1024 * 2;
constexpr size_t W_LRU = W_2B + (size_t)1024 * 2816 * 2;
constexpr size_t W_END = W_LRU + (size_t)2 * 1024 * 128 * 2;
static_assert(W_END <= 62 * MiB, "weights");
constexpr size_t S_SS = 62 * MiB;
constexpr size_t S_SSM = S_SS + 5 * 65536;
constexpr size_t S_STATS = S_SSM + 8192;
constexpr size_t S_COS = S_STATS + 524288;
constexpr size_t S_SIN = S_COS + 524288;
constexpr size_t S_BAR = S_SIN + 524288;
static_assert(S_BAR + 16384 <= 64 * MiB && S_BAR % 256 == 0, "small");
constexpr size_t A_MB = 64 * MiB;
constexpr size_t A_XKV = 68 * MiB;
constexpr size_t A_B0 = 76 * MiB, A_B1 = 108 * MiB, A_B2 = 140 * MiB, A_B3 = 172 * MiB, A_B4 = 204 * MiB;
constexpr size_t WS_NEED = 236 * MiB;

struct Params { const float* in[32]; float* out; unsigned char* ws; int ph_lo, ph_hi; };

typedef float f32x2v __attribute__((ext_vector_type(2)));
typedef __bf16 bf16x2v __attribute__((ext_vector_type(2)));
__device__ __forceinline__ unsigned cvt_pk_bf16(float lo, float hi) { const f32x2v v = {lo, hi}; return __builtin_bit_cast(unsigned, __builtin_convertvector(v, bf16x2v)); }
__device__ __forceinline__ float bflo(unsigned w) { return __uint_as_float(w << 16); }
__device__ __forceinline__ float bfhi(unsigned w) { return __uint_as_float(w & 0xffff0000u); }
__device__ __forceinline__ float bf2f(bf16_t b) { return __uint_as_float((unsigned)b << 16); }
__device__ __forceinline__ u32x4 pack8(const float* o) { u32x4 w; w.x = cvt_pk_bf16(o[0], o[1]); w.y = cvt_pk_bf16(o[2], o[3]); w.z = cvt_pk_bf16(o[4], o[5]); w.w = cvt_pk_bf16(o[6], o[7]); return w; }
__device__ __forceinline__ void unpack8(u32x4 w, float* o) { o[0] = bflo(w.x); o[1] = bfhi(w.x); o[2] = bflo(w.y); o[3] = bfhi(w.y); o[4] = bflo(w.z); o[5] = bfhi(w.z); o[6] = bflo(w.w); o[7] = bfhi(w.w); }
__device__ __forceinline__ float sigmoidf_(float x) { return __builtin_amdgcn_rcpf(1.0f + __expf(-x)); }
__device__ __forceinline__ void sigmoid2(float x0, float x1, float& s0, float& s1) {
    const float d0 = 1.0f + __expf(-fmaxf(x0, -40.f)), d1 = 1.0f + __expf(-fmaxf(x1, -40.f)); const float r = __builtin_amdgcn_rcpf(d0 * d1); s0 = r * d1; s1 = r * d0; }
__device__ __forceinline__ float rs_of(float ss) { return rsqrtf(ss * (1.0f / 1024.0f) + EPS); }
__device__ __forceinline__ void lds_barrier() { asm volatile("s_waitcnt lgkmcnt(0)" ::: "memory"); __builtin_amdgcn_s_barrier(); asm volatile("" ::: "memory"); }

namespace pg8 {
constexpr int BM = 256, BK = 64, HALF = 128, HTB = HALF * BK * 2, STAGE_BYTES = 8 * HTB, NXCD = 8, WGM = 8;
__host__ __device__ __forceinline__ int lds_byte(int r, int c) { const int st = (r >> 4) * 2 + (c >> 5), rr = r & 15, cc = c & 31, ob = rr * 64 + cc * 2; return st * 1024 + (ob ^ (((ob >> 9) & 1) << 5)); }
__host__ __device__ __forceinline__ void stage_rc(int b, int& R, int& C) { const int st = b / 1024, sb = b % 1024, swz = sb ^ (((sb >> 9) & 1) << 5); R = (st >> 1) * 16 + swz / 64; C = (st & 1) * 32 + (swz % 64) / 2; }
__host__ __device__ __forceinline__ int perm32(int rho) { const int n = rho >> 4, i = rho & 15; return 8 * (i >> 2) + 4 * n + (i & 3); }
struct Unit { int pm, pn; };
struct Gemm { const bf16_t* A; const bf16_t* Bt; int M, N, K, lda, ldb; };
struct StaticOrder {
    int nM, nN, nwg, G, c;
    __device__ __forceinline__ void init(int M, int N, int G_, int c_) { nM = M / BM; nN = N / BM; nwg = nM * nN; G = G_; c = c_; }
    __device__ __forceinline__ bool next(int i, Unit& u) const {
        const long L = (long)i * G + c; if (L >= nwg) return false;
        int wgid = (int)L; { const int q = nwg / NXCD, r = nwg % NXCD, xcd = wgid % NXCD, off = wgid / NXCD; wgid = (xcd < r ? xcd * (q + 1) : r * (q + 1) + (xcd - r) * q) + off; }
        const int nig = WGM * nN, gid = wgid / nig, fm = gid * WGM, gsz = (nM - fm) < WGM ? (nM - fm) : WGM;
        u.pm = fm + ((wgid % nig) % gsz); u.pn = (wgid % nig) / gsz; return true;
    }
};
template <class Epi>
__device__ __forceinline__ void gemm_phase(LAS unsigned char* lds, const Gemm g, const StaticOrder& S, const Epi& E) {
    const int tid = threadIdx.x, wid = __builtin_amdgcn_readfirstlane(tid >> 6), lane = tid & 63, wr = wid >> 2, wc = wid & 3, fr = lane & 15, fq = lane >> 4;
    const int K = g.K, nt = K / BK;
    unsigned voffA[2], voffB[2];
#pragma unroll
    for (int i = 0; i < 2; ++i) { int R, C; stage_rc(tid * 16 + i * 8192, R, C); const int Rb = Epi::PERM ? ((R & ~31) + perm32(R & 31)) : R;
        voffA[i] = (unsigned)(R * g.lda + C) * 2u; voffB[i] = (unsigned)(Rb * g.ldb + C) * 2u; }
    const size_t kstep = (size_t)(BK * 2);
    const size_t hstepA = (size_t)HALF * g.lda * 2, hstepB = (size_t)HALF * g.ldb * 2;
    const size_t tstepA = 2 * hstepA, tstepB = 2 * hstepB;
    const unsigned ldsw = (unsigned)wid * 1024u;
    const int aoff = lds_byte(wr * 64 + fr, fq * 8), boff = lds_byte(wc * 32 + fr, fq * 8);
#define PG8_SA(b, h) (((b) * 2 + (h)) * HTB)
#define PG8_SB(b, h) ((4 + (b) * 2 + (h)) * HTB)
#define PG8_STAGE(bufoff, gbase, voff) do { _Pragma("unroll") for (int _i = 0; _i < 2; ++_i) \
        __builtin_amdgcn_global_load_lds((const unsigned*)((const char*)(gbase) + (voff)[_i]), (LAS unsigned*)(lds + (bufoff) + ldsw + _i * 8192), 16, 0, 0); } while (0)
#define PG8_LDA(dst, b, h) do { _Pragma("unroll") for (int m = 0; m < 4; ++m) _Pragma("unroll") for (int k = 0; k < 2; ++k) dst[m][k] = *(const LAS bf16x8*)(lds + PG8_SA(b, h) + aoff + m * 2048 + k * 1024); } while (0)
#define PG8_LDB(dst, b, h) do { _Pragma("unroll") for (int n = 0; n < 2; ++n) _Pragma("unroll") for (int k = 0; k < 2; ++k) dst[n][k] = *(const LAS bf16x8*)(lds + PG8_SB(b, h) + boff + n * 2048 + k * 1024); } while (0)
#define PG8_MMA(ai, bj, At, Bt) do { __builtin_amdgcn_s_setprio(1); _Pragma("unroll") for (int m = 0; m < 4; ++m) _Pragma("unroll") for (int n = 0; n < 2; ++n) _Pragma("unroll") for (int k = 0; k < 2; ++k) \
        acc[ai][bj][m][n] = __builtin_amdgcn_mfma_f32_16x16x32_bf16(Bt[n][k], At[m][k], acc[ai][bj][m][n], 0, 0, 0); __builtin_amdgcn_s_setprio(0); } while (0)
#define PG8_WAIT_V(n) asm volatile("s_waitcnt vmcnt(" #n ")" ::: "memory")
#define PG8_WAIT_L(n) asm volatile("s_waitcnt lgkmcnt(" #n ")" ::: "memory")
#define PG8_BAR __builtin_amdgcn_s_barrier()
#define PG8_SCHED __builtin_amdgcn_sched_barrier(0)
    Unit cur, nxt; int ui = 0;
    if (!S.next(0, cur)) return;
    f32x4 acc[2][2][4][2];
#pragma unroll
    for (int a = 0; a < 2; ++a)
#pragma unroll
        for (int b = 0; b < 2; ++b)
#pragma unroll
            for (int m = 0; m < 4; ++m)
#pragma unroll
                for (int n = 0; n < 2; ++n) acc[a][b][m][n] = (f32x4){0.f, 0.f, 0.f, 0.f};
    bf16x8 At[4][2], B0[2][2], B1[2][2];
    const char* cA = (const char*)g.A + (size_t)cur.pm * tstepA; const char* cB = (const char*)g.Bt + (size_t)cur.pn * tstepB;
    PG8_STAGE(PG8_SB(0, 0), cB, voffB); PG8_STAGE(PG8_SA(0, 0), cA, voffA); PG8_STAGE(PG8_SB(0, 1), cB + hstepB, voffB); PG8_STAGE(PG8_SA(0, 1), cA + hstepA, voffA);
    if (wr == 1) PG8_BAR;
    PG8_WAIT_V(4); PG8_BAR;
    PG8_STAGE(PG8_SB(1, 0), cB + kstep, voffB); PG8_STAGE(PG8_SA(1, 0), cA + kstep, voffA); PG8_STAGE(PG8_SB(1, 1), cB + hstepB + kstep, voffB);
    PG8_WAIT_V(6); PG8_BAR;
    for (;;) {
        const bool has_next = S.next(ui + 1, nxt);
        const char* nA = has_next ? (const char*)g.A + (size_t)nxt.pm * tstepA : cA; const char* nB = has_next ? (const char*)g.Bt + (size_t)nxt.pn * tstepB : cB;
        for (int t = 0; t < nt; t += 2) {
            const bool last = (t == nt - 2);
            const char* a1 = cA + (size_t)(t + 1) * kstep;
            const char* a2 = last ? nA : cA + (size_t)(t + 2) * kstep; const char* b2 = last ? nB : cB + (size_t)(t + 2) * kstep;
            const char* a3 = a2 + kstep; const char* b3 = b2 + kstep;
            PG8_LDB(B0, 0, 0); PG8_SCHED; PG8_LDA(At, 0, 0); PG8_STAGE(PG8_SA(1, 1), a1 + hstepA, voffA);
            PG8_WAIT_L(8); PG8_BAR; PG8_WAIT_L(0); PG8_MMA(0, 0, At, B0); PG8_BAR; PG8_SCHED;
            PG8_LDB(B1, 0, 1); PG8_STAGE(PG8_SB(0, 0), b2, voffB);
            PG8_BAR; PG8_WAIT_L(0); PG8_MMA(0, 1, At, B1); PG8_BAR;
            PG8_LDA(At, 0, 1); PG8_STAGE(PG8_SA(0, 0), a2, voffA);
            PG8_BAR; PG8_WAIT_L(0); PG8_MMA(1, 0, At, B0); PG8_BAR; PG8_SCHED;
            PG8_STAGE(PG8_SB(0, 1), b2 + hstepB, voffB);
            PG8_WAIT_V(6); PG8_BAR; PG8_MMA(1, 1, At, B1); PG8_BAR;
            PG8_LDB(B0, 1, 0); PG8_SCHED; PG8_LDA(At, 1, 0); PG8_STAGE(PG8_SA(0, 1), a2 + hstepA, voffA);
            PG8_WAIT_L(8); PG8_BAR; PG8_WAIT_L(0); PG8_MMA(0, 0, At, B0); PG8_BAR; PG8_SCHED;
            PG8_LDB(B1, 1, 1); PG8_STAGE(PG8_SB(1, 0), b3, voffB);
            PG8_BAR; PG8_WAIT_L(0); PG8_MMA(0, 1, At, B1); PG8_BAR;
            PG8_LDA(At, 1, 1); PG8_STAGE(PG8_SA(1, 0), a3, voffA);
            PG8_BAR; PG8_WAIT_L(0); PG8_MMA(1, 0, At, B0); PG8_BAR; PG8_SCHED;
            PG8_STAGE(PG8_SB(1, 1), b3 + hstepB, voffB);
            PG8_WAIT_V(6); PG8_BAR; PG8_MMA(1, 1, At, B1); PG8_BAR;
        }
        if constexpr (!Epi::AFTER_DRAIN) E(acc, cur, wr, wc, fr, fq);
        if (!has_next) break;
#pragma unroll
        for (int a = 0; a < 2; ++a)
#pragma unroll
            for (int b = 0; b < 2; ++b)
#pragma unroll
                for (int m = 0; m < 4; ++m)
#pragma unroll
                    for (int n = 0; n < 2; ++n) acc[a][b][m][n] = (f32x4){0.f, 0.f, 0.f, 0.f};
        cur = nxt; cA = nA; cB = nB; ++ui;
    }
    PG8_WAIT_V(0);
    if (wr == 0) PG8_BAR;
    PG8_BAR;
    if constexpr (Epi::AFTER_DRAIN) E.fused(acc, cur, wr, wc, fr, fq);
#undef PG8_SA
#undef PG8_SB
#undef PG8_STAGE
#undef PG8_LDA
#undef PG8_LDB
#undef PG8_MMA
#undef PG8_WAIT_V
#undef PG8_WAIT_L
#undef PG8_BAR
#undef PG8_SCHED
}
}
using pg8::Unit;
typedef f32x4 AccT[2][2][4][2];

#define XB_TMO      128
#define XB_XCNT(j)  (256  + 64 * (j))
#define XB_XSUB(j)  (1280 + 64 * (j))
#define XB_XGEN(j)  (2304 + 64 * (j))
#define XB_TOP      3328
#define XB_TOPGEN   3392
#define XCD_BAR_WORDS 3456
#define XB_SPIN_CAP (1u << 18)

__device__ __forceinline__ unsigned xb_ld(unsigned* p)              { return __hip_atomic_load(p, __ATOMIC_RELAXED, __HIP_MEMORY_SCOPE_AGENT); }
__device__ __forceinline__ unsigned xb_add(unsigned* p, unsigned v) { return __hip_atomic_fetch_add(p, v, __ATOMIC_RELAXED, __HIP_MEMORY_SCOPE_AGENT); }
__device__ __forceinline__ unsigned xb_xcc_id() { return (unsigned)__builtin_amdgcn_s_getreg((3 << 11) | 20) & 0xFu; }
#define XB_SPIN(cond, bar) do { unsigned _sp = 0; while (cond) { __builtin_amdgcn_s_sleep(1); \
    if ((++_sp & 255u) == 0u) { if (xb_ld(&(bar)[XB_TMO])) break; if (_sp > XB_SPIN_CAP) { atomicAdd(&(bar)[XB_TMO], 1u); break; } } } } while (0)

struct XcdBarrier {
    unsigned* bar; unsigned x;
    volatile LAS unsigned* st;
};

__device__ __forceinline__ XcdBarrier xcd_barrier_post(unsigned* bar, volatile LAS unsigned* st) {
    XcdBarrier b; b.bar = bar; b.x = xb_xcc_id(); b.st = st;
    if (threadIdx.x == 0) (void)xb_add(&bar[XB_XCNT(b.x)], 1u);
    return b;
}
__device__ __forceinline__ void xcd_barrier_complete(unsigned* bar, unsigned x, unsigned& nloc, unsigned& nx) {
    const unsigned G = gridDim.x * gridDim.y * gridDim.z;
    unsigned sum, cnt, mine, sp = 0u;
    for (;;) {
        sum = 0u; cnt = 0u; mine = 0u;
#pragma unroll
        for (unsigned j = 0; j < 16; ++j) { const unsigned c = xb_ld(&bar[XB_XCNT(j)]); sum += c; cnt += (c > 0u) ? 1u : 0u; mine = (j == x) ? c : mine; }
        if (sum == G) break;
        __builtin_amdgcn_s_sleep(1);
        if ((++sp & 255u) == 0u) { if (xb_ld(&bar[XB_TMO])) break; if (sp > XB_SPIN_CAP) { atomicAdd(&bar[XB_TMO], 1u); break; } }
    }
    nloc = mine > 0u ? mine : 1u; nx = cnt > 0u ? cnt : 1u;
}

__device__ __forceinline__ void xcd_barrier(const XcdBarrier& b) {
    asm volatile("s_waitcnt vmcnt(0)" ::: "memory");
    __syncthreads();
    if (threadIdx.x == 0) {
        unsigned* bar = b.bar;
        __builtin_amdgcn_s_waitcnt(0);
        unsigned nloc = b.st[0], nx = b.st[1];
        if (nloc == 0u) { xcd_barrier_complete(bar, b.x, nloc, nx); b.st[0] = nloc; b.st[1] = nx; }
        const unsigned old = xb_add(&bar[XB_XSUB(b.x)], 1u);
        const unsigned gen = old / nloc;
        if (old + 1u == (gen + 1u) * nloc) {
            __builtin_amdgcn_fence(__ATOMIC_RELEASE, "agent");
            asm volatile("s_waitcnt vmcnt(0)" ::: "memory");
            const unsigned og = xb_add(&bar[XB_TOP], 1u);
            const unsigned tg = og / nx;
            if (og + 1u == (tg + 1u) * nx) xb_add(&bar[XB_TOPGEN], 1u);
            else XB_SPIN(xb_ld(&bar[XB_TOPGEN]) == tg, bar);
            __builtin_amdgcn_fence(__ATOMIC_ACQUIRE, "agent");
            xb_add(&bar[XB_XGEN(b.x)], 1u);
            asm volatile("s_waitcnt vmcnt(0)" ::: "memory");
        } else {
            XB_SPIN(xb_ld(&bar[XB_XGEN(b.x)]) == gen, bar);
            __builtin_amdgcn_fence(__ATOMIC_ACQUIRE, "agent");
            asm volatile("s_waitcnt vmcnt(0)" ::: "memory");
        }
    }
    __syncthreads();
}


struct EpiSwiglu {
    static constexpr bool PERM = true, AFTER_DRAIN = false;
    bf16_t* G; const float* ss;
    __device__ __forceinline__ void operator()(const AccT& acc, const Unit& u, int wr, int wc, int fr, int fq) const {
        const int row0 = u.pm * 256 + wr * 64 + fr, col0 = u.pn * 128 + wc * 32 + 8 * fq;
#pragma unroll
        for (int ai = 0; ai < 2; ++ai)
#pragma unroll
            for (int m = 0; m < 4; ++m) {
                const int row = row0 + ai * 128 + m * 16; const float rs = rs_of(ss[row]); float o[8];
#pragma unroll
                for (int n = 0; n < 2; ++n)
#pragma unroll
                    for (int j = 0; j < 4; j += 2) {
                        const float a1 = acc[ai][0][m][n][j] * rs, b1 = acc[ai][0][m][n][j + 1] * rs;
                        const float d0 = 1.0f + __expf(-fmaxf(a1, -40.f)), d1 = 1.0f + __expf(-fmaxf(b1, -40.f));
                        const float r = __builtin_amdgcn_rcpf(d0 * d1);
                        o[4 * n + j] = a1 * (r * d1) * (acc[ai][1][m][n][j] * rs); o[4 * n + j + 1] = b1 * (r * d0) * (acc[ai][1][m][n][j + 1] * rs); }
                *(u32x4*)(G + (size_t)row * DFF + col0) = pack8(o);
            }
    }
};
template <bool WB> struct EpiResid {
    static constexpr bool PERM = true, AFTER_DRAIN = false;
    const float* base; float* X; bf16_t* Xb; float* ss; float scale;
    __device__ __forceinline__ void operator()(const AccT& acc, const Unit& u, int wr, int wc, int fr, int fq) const {
        const int row0 = u.pm * 256 + wr * 64 + fr, col0 = u.pn * 256 + wc * 32 + 8 * fq;
#pragma unroll
        for (int ai = 0; ai < 2; ++ai)
#pragma unroll
            for (int m = 0; m < 4; ++m) {
                const int row = row0 + ai * 128 + m * 16; float sq = 0.f;
#pragma unroll
                for (int bj = 0; bj < 2; ++bj) {
                    const size_t off = (size_t)row * DM + col0 + bj * 128;
                    const f32x4 b0 = *(const f32x4*)(base + off), b1 = *(const f32x4*)(base + off + 4);
                    const f32x4 v0 = b0 + scale * acc[ai][bj][m][0], v1 = b1 + scale * acc[ai][bj][m][1];
                    *(f32x4*)(X + off) = v0; *(f32x4*)(X + off + 4) = v1;
                    sq += (v0[0] * v0[0] + v0[1] * v0[1]) + (v0[2] * v0[2] + v0[3] * v0[3]) + (v1[0] * v1[0] + v1[1] * v1[1]) + (v1[2] * v1[2] + v1[3] * v1[3]);
                    if (WB) { u32x4 w; w.x = cvt_pk_bf16(v0[0], v0[1]); w.y = cvt_pk_bf16(v0[2], v0[3]); w.z = cvt_pk_bf16(v1[0], v1[1]); w.w = cvt_pk_bf16(v1[2], v1[3]); *(u32x4*)(Xb + off) = w; }
                }
                sq += __shfl_xor(sq, 16); sq += __shfl_xor(sq, 32);
                if (fq == 0) unsafeAtomicAdd(ss + row, sq);
            }
    }
};
template <bool BASE_F32> struct EpiResidB {
    static constexpr bool PERM = true, AFTER_DRAIN = false;
    const void* base; bf16_t* Xb; float* ss; float scale;
    __device__ __forceinline__ void operator()(const AccT& acc, const Unit& u, int wr, int wc, int fr, int fq) const {
        const int row0 = u.pm * 256 + wr * 64 + fr, col0 = u.pn * 256 + wc * 32 + 8 * fq;
#pragma unroll
        for (int ai = 0; ai < 2; ++ai)
#pragma unroll
            for (int m = 0; m < 4; ++m) {
                const int row = row0 + ai * 128 + m * 16; float sq = 0.f;
#pragma unroll
                for (int bj = 0; bj < 2; ++bj) {
                    const size_t off = (size_t)row * DM + col0 + bj * 128; float bv[8];
                    if (BASE_F32) { const f32x4 b0 = *(const f32x4*)((const float*)base + off), b1 = *(const f32x4*)((const float*)base + off + 4);
#pragma unroll
                        for (int j = 0; j < 4; ++j) { bv[j] = b0[j]; bv[4 + j] = b1[j]; } }
                    else unpack8(*(const u32x4*)((const bf16_t*)base + off), bv);
                    float o[8];
#pragma unroll
                    for (int n = 0; n < 2; ++n)
#pragma unroll
                        for (int j = 0; j < 4; ++j) { const float v = bv[4 * n + j] + scale * acc[ai][bj][m][n][j]; o[4 * n + j] = v; sq += v * v; }
                    *(u32x4*)(Xb + off) = pack8(o);
                }
                sq += __shfl_xor(sq, 16); sq += __shfl_xor(sq, 32);
                if (fq == 0) unsafeAtomicAdd(ss + row, sq);
            }
    }
};
struct EpiInproj {
    static constexpr bool PERM = true, AFTER_DRAIN = false;
    bf16_t *q, *xl; const float *ss, *cs, *sn;
    __device__ __forceinline__ void operator()(const AccT& acc, const Unit& u, int wr, int wc, int fr, int fq) const {
        const int row0 = u.pm * 256 + wr * 64 + fr, p0 = wc * 32 + 8 * fq, pn = u.pn;
        if (pn < 4) {
            bf16_t* dst = q + (size_t)(pn >> 1) * ((size_t)T_TOK * 512); const float sc = pn < 2 ? 1.0f : 0.08838834764831845f;
            const int head = 2 * (pn & 1) + (p0 >> 6), d0 = p0 & 63;
#pragma unroll
            for (int ai = 0; ai < 2; ++ai)
#pragma unroll
                for (int m = 0; m < 4; ++m) {
                    const int row = row0 + ai * 128 + m * 16; const float rs = rs_of(ss[row]) * sc; const int pos = row & (SEQ - 1);
                    const float* cp = cs + pos * 64 + d0; const float* sp = sn + pos * 64 + d0;
                    bf16_t* dp = dst + (size_t)row * 512 + head * 128 + d0;
#pragma unroll
                    for (int n = 0; n < 2; ++n) {
                        const f32x4 c = *(const f32x4*)(cp + 4 * n), s = *(const f32x4*)(sp + 4 * n);
                        const f32x4 t1 = acc[ai][0][m][n] * rs, t2 = acc[ai][1][m][n] * rs;
                        const f32x4 o1 = t1 * c - t2 * s, o2 = t2 * c + t1 * s;
                        u32x2 w1, w2; w1.x = cvt_pk_bf16(o1[0], o1[1]); w1.y = cvt_pk_bf16(o1[2], o1[3]); w2.x = cvt_pk_bf16(o2[0], o2[1]); w2.y = cvt_pk_bf16(o2[2], o2[3]);
                        *(u32x2*)(dp + 4 * n) = w1; *(u32x2*)(dp + 64 + 4 * n) = w2;
                    }
                }
        } else {
            const int seg = (pn - 4) >> 2; bf16_t* dst = xl + (size_t)seg * ((size_t)T_TOK * DM); const int colb = ((pn - 4) & 3) * 256 + p0;
#pragma unroll
            for (int ai = 0; ai < 2; ++ai)
#pragma unroll
                for (int m = 0; m < 4; ++m) {
                    const int row = row0 + ai * 128 + m * 16; const float rs = rs_of(ss[row]);
#pragma unroll
                    for (int bj = 0; bj < 2; ++bj) {
                        float o[8];
#pragma unroll
                        for (int n = 0; n < 2; ++n)
#pragma unroll
                            for (int j = 0; j < 4; j += 2) { float a = acc[ai][bj][m][n][j] * rs, b = acc[ai][bj][m][n][j + 1] * rs;
                                if (seg == 2) { const float ua = 1.5957691216057308f * (a + 0.044715f * a * a * a), ub = 1.5957691216057308f * (b + 0.044715f * b * b * b);
                                    float sa, sb; sigmoid2(ua, ub, sa, sb); a *= sa; b *= sb; }
                                o[4 * n + j] = a; o[4 * n + j + 1] = b; }
                        *(u32x4*)(dst + (size_t)row * DM + colb + bj * 128) = pack8(o);
                    }
                }
        }
    }
};
struct EpiGG {
    static constexpr bool PERM = true, AFTER_DRAIN = false;
    bf16_t* aret; bf16_t* gates; const float *ss, *stats, *gn, *bg;
    __device__ __forceinline__ void operator()(const AccT& acc, const Unit& u, int wr, int wc, int fr, int fq) const {
        const int row0 = u.pm * 256 + wr * 64 + fr, p0 = wc * 32 + 8 * fq, pn = u.pn;
        if (pn < 4) {
#pragma unroll
            for (int ai = 0; ai < 2; ++ai)
#pragma unroll
                for (int m = 0; m < 4; ++m) {
                    const int row = row0 + ai * 128 + m * 16; const float rs = rs_of(ss[row]);
                    const float s1 = stats[((size_t)row * 4 + pn) * 2], s2 = stats[((size_t)row * 4 + pn) * 2 + 1];
                    const float mu = s1 * (1.0f / 256.0f); const float var = fmaxf(s2 * (1.0f / 256.0f) - mu * mu, 0.f); const float rstd = rsqrtf(var + EPS);
#pragma unroll
                    for (int bj = 0; bj < 2; ++bj) {
                        const int col = pn * 256 + bj * 128 + p0; bf16_t* rp = aret + (size_t)row * DM + col;
                        float r[8], o[8]; unpack8(*(const u32x4*)rp, r);
                        const f32x4 g0 = *(const f32x4*)(gn + col), g1 = *(const f32x4*)(gn + col + 4);
#pragma unroll
                        for (int n = 0; n < 2; ++n)
#pragma unroll
                            for (int j = 0; j < 4; j += 2) { const float a = acc[ai][bj][m][n][j] * rs, b = acc[ai][bj][m][n][j + 1] * rs; float sa, sb; sigmoid2(a, b, sa, sb);
                                o[4 * n + j] = a * sa * (n ? g1[j] : g0[j]) * (r[4 * n + j] - mu) * rstd; o[4 * n + j + 1] = b * sb * (n ? g1[j + 1] : g0[j + 1]) * (r[4 * n + j + 1] - mu) * rstd; }
                        *(u32x4*)rp = pack8(o);
                    }
                }
        } else {
#pragma unroll
            for (int ai = 0; ai < 2; ++ai)
#pragma unroll
                for (int m = 0; m < 4; ++m) {
                    const int row = row0 + ai * 128 + m * 16; const float rs = rs_of(ss[row]);
#pragma unroll
                    for (int bj = 0; bj < 2; ++bj) {
                        const int col = (pn - 4) * 256 + bj * 128 + p0; float o[8];
                        const f32x4 b0 = *(const f32x4*)(bg + col), b1 = *(const f32x4*)(bg + col + 4);
#pragma unroll
                        for (int n = 0; n < 2; ++n)
#pragma unroll
                            for (int j = 0; j < 4; j += 2) sigmoid2(acc[ai][bj][m][n][j] * rs + (n ? b1[j] : b0[j]), acc[ai][bj][m][n][j + 1] * rs + (n ? b1[j + 1] : b0[j + 1]), o[4 * n + j], o[4 * n + j + 1]);
                        *(u32x4*)(gates + (size_t)row * 2048 + col) = pack8(o);
                    }
                }
        }
    }
};
template <bool SECOND> struct EpiMerge {
    static constexpr bool PERM = true, AFTER_DRAIN = false;
    bf16_t* merged; const bf16_t* gates;
    __device__ __forceinline__ void operator()(const AccT& acc, const Unit& u, int wr, int wc, int fr, int fq) const {
        const int row0 = u.pm * 256 + wr * 64 + fr, col0 = u.pn * 256 + wc * 32 + 8 * fq;
#pragma unroll
        for (int ai = 0; ai < 2; ++ai)
#pragma unroll
            for (int m = 0; m < 4; ++m) {
                const int row = row0 + ai * 128 + m * 16;
#pragma unroll
                for (int bj = 0; bj < 2; ++bj) {
                    const int col = col0 + bj * 128; float g[8], o[8];
                    unpack8(*(const u32x4*)(gates + (size_t)row * 2048 + (SECOND ? 1024 : 0) + col), g);
                    bf16_t* mp = merged + (size_t)row * DM + col;
                    if (SECOND) unpack8(*(const u32x4*)mp, o);
#pragma unroll
                    for (int n = 0; n < 2; ++n)
#pragma unroll
                        for (int j = 0; j < 4; ++j) { const float t = g[4 * n + j] * acc[ai][bj][m][n][j]; o[4 * n + j] = SECOND ? o[4 * n + j] + t : t; }
                    *(u32x4*)mp = pack8(o);
                }
            }
    }
};
struct EpiScale {
    static constexpr bool PERM = true, AFTER_DRAIN = false;
    bf16_t* O; int ldc; const float* ss; float sc;
    __device__ __forceinline__ void operator()(const AccT& acc, const Unit& u, int wr, int wc, int fr, int fq) const {
        const int row0 = u.pm * 256 + wr * 64 + fr, col0 = u.pn * 256 + wc * 32 + 8 * fq;
#pragma unroll
        for (int ai = 0; ai < 2; ++ai)
#pragma unroll
            for (int m = 0; m < 4; ++m) {
                const int row = row0 + ai * 128 + m * 16; const float rs = rs_of(ss[row]) * sc;
#pragma unroll
                for (int bj = 0; bj < 2; ++bj) { float o[8];
#pragma unroll
                    for (int n = 0; n < 2; ++n)
#pragma unroll
                        for (int j = 0; j < 4; ++j) o[4 * n + j] = acc[ai][bj][m][n][j] * rs;
                    *(u32x4*)(O + (size_t)row * ldc + col0 + bj * 128) = pack8(o); }
            }
    }
};

struct EpiFinal {
    static constexpr bool PERM = true, AFTER_DRAIN = true;
    const bf16_t* base; float* X; float* ss; const float* gfin; XcdBarrier xb;
    __device__ __forceinline__ void fused(AccT& acc, const Unit& u, int wr, int wc, int fr, int fq) const {
        const int row0 = u.pm * 256 + wr * 64 + fr, col0 = u.pn * 256 + wc * 32 + 8 * fq;
#pragma unroll
        for (int ai = 0; ai < 2; ++ai)
#pragma unroll
            for (int m = 0; m < 4; ++m) {
                const int row = row0 + ai * 128 + m * 16; float sq = 0.f;
#pragma unroll
                for (int bj = 0; bj < 2; ++bj) {
                    const size_t off = (size_t)row * DM + col0 + bj * 128;
                    float bv[8]; unpack8(*(const u32x4*)(base + off), bv);
                    const f32x4 v0 = (f32x4){bv[0], bv[1], bv[2], bv[3]} + 0.5f * acc[ai][bj][m][0], v1 = (f32x4){bv[4], bv[5], bv[6], bv[7]} + 0.5f * acc[ai][bj][m][1];
                    acc[ai][bj][m][0] = v0; acc[ai][bj][m][1] = v1;
                    sq += (v0[0] * v0[0] + v0[1] * v0[1]) + (v0[2] * v0[2] + v0[3] * v0[3]) + (v1[0] * v1[0] + v1[1] * v1[1]) + (v1[2] * v1[2] + v1[3] * v1[3]);
                }
                sq += __shfl_xor(sq, 16); sq += __shfl_xor(sq, 32);
                if (fq == 0) unsafeAtomicAdd(ss + row, sq);
            }
        xcd_barrier(xb);
#pragma unroll
        for (int ai = 0; ai < 2; ++ai)
#pragma unroll
            for (int m = 0; m < 4; ++m) {
                const int row = row0 + ai * 128 + m * 16; const float rs = rs_of(ss[row]);
#pragma unroll
                for (int bj = 0; bj < 2; ++bj) {
                    const size_t off = (size_t)row * DM + col0 + bj * 128; const int col = col0 + bj * 128;
                    const f32x4 g0 = *(const f32x4*)(gfin + col), g1 = *(const f32x4*)(gfin + col + 4);
                    *(f32x4*)(X + off) = acc[ai][bj][m][0] * rs * g0; *(f32x4*)(X + off + 4) = acc[ai][bj][m][1] * rs * g1;
                }
            }
    }
};
struct RowSrc { const float* p; int ld; };
template <class F>
__device__ __forceinline__ void wprep(LAS unsigned char* lds, bf16_t* dst, int nrows, int K, const float* gain, F rowsrc, int b0 = (int)blockIdx.x, int nb = (int)gridDim.x) {
    LAS float* tile = (LAS float*)lds;
    const int tid = threadIdx.x, kk = tid >> 4, r4 = (tid & 15) * 4;
    const int ntk = K / 128, ntiles = (nrows / 64) * ntk;
    f32x4 cur[4], nxt[4];
    auto fetch = [&](int t, f32x4 (&v)[4]) {
        const int r0 = (t / ntk) * 64, k0 = (t % ntk) * 128; const RowSrc rs = rowsrc(r0 + r4);
#pragma unroll
        for (int it = 0; it < 4; ++it) { const int k = k0 + kk + 32 * it; f32x4 x = *(const f32x4*)(rs.p + (size_t)k * rs.ld); if (gain) x *= gain[k]; v[it] = x; }
    };
    int t = b0;
    if (t < ntiles) fetch(t, cur);
    for (; t < ntiles; t += nb) {
        const int tn = t + nb;
        if (tn < ntiles) fetch(tn, nxt);
        const int r0 = (t / ntk) * 64, k0 = (t % ntk) * 128;
        __syncthreads();
#pragma unroll
        for (int it = 0; it < 4; ++it)
#pragma unroll
            for (int j = 0; j < 4; ++j) tile[(r4 + j) * 129 + kk + 32 * it] = cur[it][j];
        __syncthreads();
        const int row = tid >> 3, ch = tid & 7;
#pragma unroll
        for (int hf = 0; hf < 2; ++hf) { float o[8];
#pragma unroll
            for (int j = 0; j < 8; ++j) o[j] = tile[row * 129 + hf * 64 + ch * 8 + j];
            *(u32x4*)(dst + (size_t)(r0 + row) * K + k0 + hf * 64 + ch * 8) = pack8(o); }
#pragma unroll
        for (int it = 0; it < 4; ++it) cur[it] = nxt[it];
    }
    __syncthreads();
}

__device__ __forceinline__ void rows_prep(const float* src, bf16_t* dst, float* ss, int nrows) {
    const int lane = threadIdx.x & 63, gw = blockIdx.x * 8 + (threadIdx.x >> 6), nw = gridDim.x * 8;
    for (int r = gw; r < nrows; r += nw) {
        const float* sp = src + (size_t)r * DM; float sq = 0.f;
#pragma unroll
        for (int i = 0; i < 2; ++i) {
            const int c = (i * 64 + lane) * 8;
            const f32x4 a = *(const f32x4*)(sp + c), b = *(const f32x4*)(sp + c + 4);
            sq += (a[0] * a[0] + a[1] * a[1]) + (a[2] * a[2] + a[3] * a[3]) + (b[0] * b[0] + b[1] * b[1]) + (b[2] * b[2] + b[3] * b[3]);
            u32x4 w; w.x = cvt_pk_bf16(a[0], a[1]); w.y = cvt_pk_bf16(a[2], a[3]); w.z = cvt_pk_bf16(b[0], b[1]); w.w = cvt_pk_bf16(b[2], b[3]);
            *(u32x4*)(dst + (size_t)r * DM + c) = w;
        }
#pragma unroll
        for (int o = 32; o >= 1; o >>= 1) sq += __shfl_xor(sq, o);
        if (lane == 0) ss[r] = sq;
    }
}

__device__ __forceinline__ bf16x8 tr_frag(LAS unsigned char* tile, int stride, int k0, int x0, int lane) {
    const int g = lane >> 4, ii = lane & 15, q = ii >> 2, p = ii & 3;
    LAS unsigned char* a = tile + (k0 + 8 * g + q) * stride + (x0 + 4 * p) * 2;
    const s16x4 lo = __builtin_amdgcn_ds_read_tr16_b64_v4i16((LAS s16x4*)a);
    const s16x4 hi = __builtin_amdgcn_ds_read_tr16_b64_v4i16((LAS s16x4*)(a + 4 * stride));
    bf16x8 r; r[0] = lo[0]; r[1] = lo[1]; r[2] = lo[2]; r[3] = lo[3]; r[4] = hi[0]; r[5] = hi[1]; r[6] = hi[2]; r[7] = hi[3]; return r;
}
__device__ __forceinline__ bf16x8 scale_frag(bf16x8 f, const float* s) {
    u32x4 w = __builtin_bit_cast(u32x4, f); float o[8]; unpack8(w, o);
#pragma unroll
    for (int j = 0; j < 8; ++j) o[j] *= s[j];
    return __builtin_bit_cast(bf16x8, pack8(o));
}

constexpr int R_KT = 0, R_KS = 272;
constexpr int R_VT = 128 * 272, R_VS = 144;
constexpr int R_SB = R_VT + 128 * 144;
constexpr int R_PW = R_SB + 128 * 144;
static_assert(R_PW + 8 * 16 * 272 <= LDS_BYTES, "ret lds");
__device__ __forceinline__ void retention_item(LAS unsigned char* lds, int item, const bf16_t* qb, const bf16_t* kb, bf16_t* vb  , float* stats) {
    int tid = threadIdx.x; asm volatile("" : "+v"(tid));
    const int wid = tid >> 6, lane = tid & 63, fr = lane & 15, fg = lane >> 4;
    const int widu = __builtin_amdgcn_readfirstlane(tid >> 6);
    const int b = item >> 4, h = (item >> 2) & 3, es = item & 3;
    const float l2g = __log2f(1.0f - exp2f(-5.0f - (float)h));
    const float cd = exp2f(128.0f * l2g);
    const size_t tok0 = (size_t)b * SEQ;
    LAS unsigned char* Pw = lds + R_PW + wid * (16 * 272);
    f32x4 st[4];
#pragma unroll
    for (int e = 0; e < 4; ++e) st[e] = (f32x4){0.f, 0.f, 0.f, 0.f};
    u32x4 kreg[4], vreg[2], qnext[4], qf[4];
    auto issue = [&](int n) {
        const size_t t0 = tok0 + (size_t)n * 128;
#pragma unroll
        for (int i = 0; i < 4; ++i) { const int c = tid + 512 * i, row = c >> 4, c16 = c & 15; kreg[i] = *(const u32x4*)(kb + (t0 + row) * 512 + h * 128 + c16 * 8); }
#pragma unroll
        for (int i = 0; i < 2; ++i) { const int c = tid + 512 * i, row = c >> 3, c8 = c & 7; vreg[i] = *(const u32x4*)(vb + (t0 + row) * DM + h * 256 + es * 64 + c8 * 8); }
#pragma unroll
        for (int s = 0; s < 4; ++s) qnext[s] = *(const u32x4*)(qb + (t0 + wid * 16 + fr) * 512 + h * 128 + s * 32 + fg * 8);
    };
    issue(0);
    const float qdec = exp2f((float)(wid * 16 + fr + 1) * l2g);
    for (int n = 0; n < 16; ++n) {
        float l2 = l2g; asm volatile("" : "+v"(l2));
        int irow = wid * 16 + fr, fgl = fg; asm volatile("" : "+v"(irow), "+v"(fgl));
        lds_barrier();
#pragma unroll
        for (int i = 0; i < 4; ++i) { const int c = tid + 512 * i, row = c >> 4, c16 = c & 15; *(LAS u32x4*)(lds + R_KT + row * R_KS + c16 * 16) = kreg[i]; }
#pragma unroll
        for (int i = 0; i < 2; ++i) { const int c = tid + 512 * i, row = c >> 3, c8 = c & 7; *(LAS u32x4*)(lds + R_VT + row * R_VS + c8 * 16) = vreg[i]; }
#pragma unroll
        for (int e = 0; e < 4; ++e) { u32x2 w; w.x = cvt_pk_bf16(st[e][0], st[e][1]); w.y = cvt_pk_bf16(st[e][2], st[e][3]);
            *(LAS u32x2*)(lds + R_SB + (wid * 16 + fr) * R_VS + (e * 16 + fg * 4) * 2) = w; }
#pragma unroll
        for (int s = 0; s < 4; ++s) qf[s] = qnext[s];
        if (n + 1 < 16) issue(n + 1);
        lds_barrier();
        {
#pragma unroll
            for (int jf = 0; jf < 8; ++jf) {
                if (jf > (widu | 1)) break;
                f32x4 sc = (f32x4){0.f, 0.f, 0.f, 0.f};
#pragma unroll
                for (int s = 0; s < 4; ++s) {
                    const bf16x8 a = *(const LAS bf16x8*)(lds + R_KT + (jf * 16 + fr) * R_KS + (s * 32 + fg * 8) * 2);
                    sc = __builtin_amdgcn_mfma_f32_16x16x32_bf16(a, __builtin_bit_cast(bf16x8, qf[s]), sc, 0, 0, 0);
                }
                float pv[4];
#pragma unroll
                for (int r = 0; r < 4; ++r) { const int j = jf * 16 + fgl * 4 + r; const int dlt = irow - j; pv[r] = dlt >= 0 ? sc[r] * __builtin_amdgcn_exp2f((float)dlt * l2) : 0.f; }
                u32x2 w; w.x = cvt_pk_bf16(pv[0], pv[1]); w.y = cvt_pk_bf16(pv[2], pv[3]);
                *(LAS u32x2*)(Pw + fr * 272 + (jf * 16 + fg * 4) * 2) = w;
                __builtin_amdgcn_sched_barrier(0);
            }
        }
        asm volatile("s_waitcnt lgkmcnt(0)" ::: "memory");
        {
            f32x4 o[4];
#pragma unroll
            for (int e = 0; e < 4; ++e) { o[e] = (f32x4){0.f, 0.f, 0.f, 0.f}; st[e] *= cd; }
#pragma unroll
            for (int s = 0; s < 4; ++s) {
                const bf16x8 pf = *(const LAS bf16x8*)(Pw + fr * 272 + (s * 32 + fg * 8) * 2);
                float kd[8];
#pragma unroll
                for (int j = 0; j < 8; ++j) kd[j] = __builtin_amdgcn_exp2f((float)(127 - (s * 32 + fgl * 8 + j)) * l2);
                const bf16x8 kf = scale_frag(tr_frag(lds + R_KT, R_KS, s * 32, wid * 16, lane), kd);
                float qs[8];
#pragma unroll
                for (int j = 0; j < 8; ++j) qs[j] = qdec;
                const bf16x8 qsf = scale_frag(__builtin_bit_cast(bf16x8, qf[s]), qs);
#pragma unroll
                for (int e = 0; e < 4; ++e) {
                    const bf16x8 vf = tr_frag(lds + R_VT, R_VS, s * 32, e * 16, lane);
                    if (s <= (widu >> 1)) o[e] = __builtin_amdgcn_mfma_f32_16x16x32_bf16(vf, pf, o[e], 0, 0, 0);
                    st[e] = __builtin_amdgcn_mfma_f32_16x16x32_bf16(vf, kf, st[e], 0, 0, 0);
                    const bf16x8 sf = tr_frag(lds + R_SB, R_VS, s * 32, e * 16, lane);
                    o[e] = __builtin_amdgcn_mfma_f32_16x16x32_bf16(sf, qsf, o[e], 0, 0, 0);
                }
                __builtin_amdgcn_sched_barrier(0);
            }
            const size_t tok = tok0 + (size_t)n * 128 + wid * 16 + fr;
            float s1 = 0.f, s2 = 0.f;
#pragma unroll
            for (int e = 0; e < 4; ++e) {
                u32x2 w; w.x = cvt_pk_bf16(o[e][0], o[e][1]); w.y = cvt_pk_bf16(o[e][2], o[e][3]);
                *(u32x2*)(vb + tok * DM + h * 256 + es * 64 + e * 16 + fg * 4) = w;
                s1 += (o[e][0] + o[e][1]) + (o[e][2] + o[e][3]);
                s2 += (o[e][0] * o[e][0] + o[e][1] * o[e][1]) + (o[e][2] * o[e][2] + o[e][3] * o[e][3]);
            }
            s1 += __shfl_xor(s1, 16); s1 += __shfl_xor(s1, 32); s2 += __shfl_xor(s2, 16); s2 += __shfl_xor(s2, 32);
            if (fg == 0) { unsafeAtomicAdd(stats + (tok * 4 + h) * 2, s1); unsafeAtomicAdd(stats + (tok * 4 + h) * 2 + 1, s2); }
        }
    }
    lds_barrier();
}

constexpr int L_XC = 0;
constexpr int L_WL = 128 * 272;
constexpr int L_SA = L_WL + 128 * 272;
constexpr int L_SBX = L_SA + 32768;
constexpr int L_SEGA = L_SBX + 32768;
constexpr int L_SEGB = L_SEGA + 2048;
constexpr int L_CARRY = L_SEGB + 2048;
constexpr int L_CW = L_CARRY + 512;
static_assert(L_CW + 5 * 512 <= LDS_BYTES - 16, "lru lds");
__device__ __forceinline__ void lru_item(LAS unsigned char* lds, int item, const bf16_t* xl, bf16_t* gg  , const bf16_t* wlru,
                                         const float* conv_w, const float* conv_b, const float* b_r, const float* b_i, const float* lam) {
    int tid = threadIdx.x; asm volatile("" : "+v"(tid));
    const int wid = tid >> 6, lane = tid & 63, fr = lane & 15, fg = lane >> 4;
    const int b = item >> 4, g = (item >> 1) & 7, hf2 = item & 1;
    const int chg = g * 128, c0 = chg + hf2 * 64;
    const size_t tok0 = (size_t)b * SEQ;
    for (int c = tid; c < 128 * 16; c += 512) { const int n = c >> 4, c16 = c & 15; const bf16_t* src = wlru + ((size_t)(n >> 6) * 1024 + c0 + (n & 63)) * 128 + c16 * 8;
        *(LAS u32x4*)(lds + L_WL + n * 272 + c16 * 16) = *(const u32x4*)src; }
    if (tid < 64) ((LAS float*)(lds + L_CARRY))[tid] = 0.f;
    const int ch8 = tid & 15;
    for (int c = tid; c < 5 * 128; c += 512) ((LAS float*)(lds + L_CW))[c] = c < 512 ? conv_w[(c >> 7) * DM + chg + (c & 127)] : conv_b[chg + (c & 127)];
    float br_[4], bi_[4], sp_[4];
#pragma unroll
    for (int hf = 0; hf < 4; ++hf) { const int ch = c0 + hf * 16 + fr; br_[hf] = b_r[ch]; bi_[hf] = b_i[ch]; sp_[hf] = log1pf(__expf(-lam[ch])); }
    u32x4 rwn[7];
    auto load_rows = [&](int T0n) {
        const int tk0 = (tid >> 4) * 4;
#pragma unroll
        for (int q = 0; q < 7; ++q) { const int ts = T0n + tk0 - 3 + q; rwn[q] = ts >= 0 ? *(const u32x4*)(xl + (tok0 + ts) * DM + chg + ch8 * 8) : (u32x4){0u, 0u, 0u, 0u}; }
    };
    load_rows(0);
    for (int tile = 0; tile < 16; ++tile) {
        const int T0 = tile * 128;
        bf16_t gpre[16];
#pragma unroll
        for (int t = 0; t < 16; ++t) gpre[t] = gg[(tok0 + T0 + wid * 16 + t) * DM + c0 + lane];
        {
            const int tk0 = (tid >> 4) * 4;
            float acc8[4][8], cw[4][8];
            { const f32x4 b0 = *(const LAS f32x4*)(lds + L_CW + 2048 + ch8 * 32), b1 = *(const LAS f32x4*)(lds + L_CW + 2048 + ch8 * 32 + 16);
#pragma unroll
              for (int i = 0; i < 4; ++i)
#pragma unroll
                for (int j = 0; j < 4; ++j) { acc8[i][j] = b0[j]; acc8[i][4 + j] = b1[j]; } }
#pragma unroll
            for (int t = 0; t < 4; ++t) { const f32x4 w0 = *(const LAS f32x4*)(lds + L_CW + t * 512 + ch8 * 32), w1 = *(const LAS f32x4*)(lds + L_CW + t * 512 + ch8 * 32 + 16);
#pragma unroll
                for (int j = 0; j < 4; ++j) { cw[t][j] = w0[j]; cw[t][4 + j] = w1[j]; } }
#pragma unroll
            for (int q = 0; q < 7; ++q) { float x[8]; unpack8(rwn[q], x);
#pragma unroll
                for (int i = 0; i < 4; ++i) { const int tap = q - i;
                    if (tap >= 0 && tap < 4) {
#pragma unroll
                        for (int j = 0; j < 8; ++j) acc8[i][j] += cw[tap][j] * x[j]; } } }
#pragma unroll
            for (int i = 0; i < 4; ++i) *(LAS u32x4*)(lds + L_XC + (tk0 + i) * 272 + ch8 * 16) = pack8(acc8[i]);
            if (tile + 1 < 16) load_rows(T0 + 128);
        }
        lds_barrier();
        {
            f32x4 ga[8];
#pragma unroll
            for (int nf = 0; nf < 8; ++nf) ga[nf] = (f32x4){0.f, 0.f, 0.f, 0.f};
#pragma unroll
            for (int s = 0; s < 4; ++s) {
                const bf16x8 af = *(const LAS bf16x8*)(lds + L_XC + (wid * 16 + fr) * 272 + (s * 32 + fg * 8) * 2);
#pragma unroll
                for (int nf = 0; nf < 8; ++nf) {
                    const bf16x8 bfr = *(const LAS bf16x8*)(lds + L_WL + (nf * 16 + fr) * 272 + (s * 32 + fg * 8) * 2);
                    ga[nf] = __builtin_amdgcn_mfma_f32_16x16x32_bf16(af, bfr, ga[nf], 0, 0, 0);
                }
            }
#pragma unroll
            for (int hf = 0; hf < 4; ++hf)
#pragma unroll
                for (int r = 0; r < 4; ++r) {
                    const int tk = wid * 16 + fg * 4 + r, cl = hf * 16 + fr;
                    float rg, ig; sigmoid2(ga[hf][r] + br_[hf], ga[4 + hf][r] + bi_[hf], rg, ig);
                    const float la = -8.0f * rg * sp_[hf]; const float a = __expf(la); const float mult = __builtin_amdgcn_sqrtf(fmaxf(fmaf(-a, a, 1.0f), 0.f));
                    const float x = bf2f(*(const LAS bf16_t*)(lds + L_XC + tk * 272 + (hf2 * 64 + cl) * 2));
                    ((LAS float*)(lds + L_SA))[tk * 64 + cl] = a; ((LAS float*)(lds + L_SBX))[tk * 64 + cl] = mult * ig * x;
                }
        }
        asm volatile("s_waitcnt lgkmcnt(0)" ::: "memory");
        {
            const int c = lane, sg = wid;
            float A = 1.f, B = 0.f;
#pragma unroll
            for (int t = 0; t < 16; ++t) { const float a_ = ((LAS float*)(lds + L_SA))[(sg * 16 + t) * 64 + c], b_ = ((LAS float*)(lds + L_SBX))[(sg * 16 + t) * 64 + c]; A *= a_; B = a_ * B + b_; }
            ((LAS float*)(lds + L_SEGA))[sg * 64 + c] = A; ((LAS float*)(lds + L_SEGB))[sg * 64 + c] = B;
            lds_barrier();
            float hst = ((LAS float*)(lds + L_CARRY))[(tile & 1) * 64 + c];
            { float sa_[7], sb_[7];
#pragma unroll
              for (int s2 = 0; s2 < 7; ++s2) { sa_[s2] = ((LAS float*)(lds + L_SEGA))[s2 * 64 + c]; sb_[s2] = ((LAS float*)(lds + L_SEGB))[s2 * 64 + c]; }
#pragma unroll
              for (int s2 = 0; s2 < 7; ++s2) hst = s2 < sg ? sa_[s2] * hst + sb_[s2] : hst; }
#pragma unroll
            for (int t = 0; t < 16; ++t) {
                hst = ((LAS float*)(lds + L_SA))[(sg * 16 + t) * 64 + c] * hst + ((LAS float*)(lds + L_SBX))[(sg * 16 + t) * 64 + c];
                gg[(tok0 + T0 + sg * 16 + t) * DM + c0 + c] = (bf16_t)(cvt_pk_bf16(hst * bf2f(gpre[t]), 0.f) & 0xffffu);
            }
            if (sg == 7) ((LAS float*)(lds + L_CARRY))[((tile + 1) & 1) * 64 + c] = hst;
        }
    }
    lds_barrier();
}

constexpr int X_T = 0, X_TS = 528;
constexpr int X_VS = 272;
constexpr int X_PW = 256 * 272;
constexpr int X_SCR = X_PW + 8 * 16 * 272;
static_assert(128 * 528 <= X_PW && X_SCR + 8 * 256 <= 128 * 1024, "xattn lds");
__device__ __forceinline__ void xattn_items(LAS unsigned char* lds, const int* items, int nitems, const bf16_t* xq, const bf16_t* xkv, bf16_t* xo) {
    int tid = threadIdx.x; asm volatile("" : "+v"(tid));
    const int wid = tid >> 6, lane = tid & 63, fr = lane & 15, fg = lane >> 4;
    LAS unsigned char* Pw = lds + X_PW + wid * (16 * 272);
    u32x4 pre[8];
    auto loadK = [&](int b, int h, int mt) {
#pragma unroll
        for (int i = 0; i < 8; ++i) { const int c = tid + 512 * i, row = c >> 5, c16 = c & 31; pre[i] = *(const u32x4*)(xkv + ((size_t)b * 256 + mt * 128 + row) * 2048 + h * 256 + c16 * 8); } };
    auto loadV = [&](int b, int h, int mt) {
#pragma unroll
        for (int i = 0; i < 8; ++i) { const int c = tid + 512 * i, m = c & 127, c16 = c >> 7; pre[i] = *(const u32x4*)(xkv + ((size_t)b * 256 + mt * 128 + m) * 2048 + 1024 + h * 256 + c16 * 8); } };
    auto putK = [&]() {
#pragma unroll
        for (int i = 0; i < 8; ++i) { const int c = tid + 512 * i, row = c >> 5, c16 = c & 31; *(LAS u32x4*)(lds + X_T + row * X_TS + c16 * 16) = pre[i]; } };
    auto putV = [&]() {
#pragma unroll
        for (int i = 0; i < 8; ++i) { const int c = tid + 512 * i, m = c & 127, c16 = c >> 7; const u32x4 w = pre[i];
            LAS unsigned char* dp = lds + X_T + (c16 * 8) * X_VS + m * 2;
            *(LAS bf16_t*)(dp + 0 * X_VS) = (bf16_t)(w.x & 0xffffu); *(LAS bf16_t*)(dp + 1 * X_VS) = (bf16_t)(w.x >> 16);
            *(LAS bf16_t*)(dp + 2 * X_VS) = (bf16_t)(w.y & 0xffffu); *(LAS bf16_t*)(dp + 3 * X_VS) = (bf16_t)(w.y >> 16);
            *(LAS bf16_t*)(dp + 4 * X_VS) = (bf16_t)(w.z & 0xffffu); *(LAS bf16_t*)(dp + 5 * X_VS) = (bf16_t)(w.z >> 16);
            *(LAS bf16_t*)(dp + 6 * X_VS) = (bf16_t)(w.w & 0xffffu); *(LAS bf16_t*)(dp + 7 * X_VS) = (bf16_t)(w.w >> 16); } };
    { const int it0 = items[0]; loadK(it0 >> 6, (it0 >> 4) & 3, 0); }
    for (int ii = 0; ii < nitems; ++ii) {
        const int item = items[ii];
        const int b = item >> 6, h = (item >> 4) & 3, qt = item & 15;
        const size_t tok = (size_t)b * SEQ + qt * 128 + wid * 16 + fr;
        bf16x8 qf[8];
#pragma unroll
        for (int s = 0; s < 8; ++s) qf[s] = __builtin_bit_cast(bf16x8, *(const u32x4*)(xq + tok * DM + h * 256 + s * 32 + fg * 8));
        f32x4 sc[16];
#pragma unroll
        for (int mt = 0; mt < 2; ++mt) {
            lds_barrier();
            putK();
            if (mt == 0) loadK(b, h, 1); else loadV(b, h, 0);
            lds_barrier();
#pragma unroll
            for (int mf = 0; mf < 8; ++mf) {
                f32x4 a4 = (f32x4){0.f, 0.f, 0.f, 0.f};
#pragma unroll
                for (int s = 0; s < 8; ++s) {
                    const bf16x8 kf = *(const LAS bf16x8*)(lds + X_T + (mf * 16 + fr) * X_TS + (s * 32 + fg * 8) * 2);
                    a4 = __builtin_amdgcn_mfma_f32_16x16x32_bf16(kf, qf[s], a4, 0, 0, 0);
                }
                sc[mt * 8 + mf] = a4;
            }
        }
        float mx = -3.0e38f;
#pragma unroll
        for (int f = 0; f < 16; ++f) mx = fmaxf(mx, fmaxf(fmaxf(sc[f][0], sc[f][1]), fmaxf(sc[f][2], sc[f][3])));
        volatile LAS float* scr = (volatile LAS float*)(lds + X_SCR) + wid * 64;
        scr[lane] = mx;
        { const float m0 = scr[fr], m1 = scr[fr + 16], m2 = scr[fr + 32], m3 = scr[fr + 48]; mx = fmaxf(fmaxf(m0, m1), fmaxf(m2, m3)); }
        float sum = 0.f;
#pragma unroll
        for (int f = 0; f < 16; ++f)
#pragma unroll
            for (int r = 0; r < 4; ++r) { const float pe = __expf(sc[f][r] - mx); sc[f][r] = pe; sum += pe; }
        scr[lane] = sum;
        { const float m0 = scr[fr], m1 = scr[fr + 16], m2 = scr[fr + 32], m3 = scr[fr + 48]; sum = (m0 + m1) + (m2 + m3); }
        const float inv = 1.0f / sum;
        f32x4 o[16];
#pragma unroll
        for (int f = 0; f < 16; ++f) o[f] = (f32x4){0.f, 0.f, 0.f, 0.f};
#pragma unroll
        for (int mt = 0; mt < 2; ++mt) {
            lds_barrier();
            putV();
            if (mt == 0) loadV(b, h, 1);
            else if (ii + 1 < nitems) { const int itn = items[ii + 1]; loadK(itn >> 6, (itn >> 4) & 3, 0); }
#pragma unroll
            for (int f = 0; f < 8; ++f) { const f32x4 pv = sc[mt * 8 + f] * inv; u32x2 w; w.x = cvt_pk_bf16(pv[0], pv[1]); w.y = cvt_pk_bf16(pv[2], pv[3]);
                *(LAS u32x2*)(Pw + fr * 272 + (f * 16 + fg * 4) * 2) = w; }
            lds_barrier();
#pragma unroll
            for (int s = 0; s < 4; ++s) {
                const bf16x8 pf = *(const LAS bf16x8*)(Pw + fr * 272 + (s * 32 + fg * 8) * 2);
#pragma unroll
                for (int df = 0; df < 16; ++df) {
                    const bf16x8 vf = *(const LAS bf16x8*)(lds + X_T + (df * 16 + fr) * X_VS + (s * 32 + fg * 8) * 2);
                    o[df] = __builtin_amdgcn_mfma_f32_16x16x32_bf16(vf, pf, o[df], 0, 0, 0);
                }
            }
        }
#pragma unroll
        for (int df = 0; df < 16; ++df) { u32x2 w; w.x = cvt_pk_bf16(o[df][0], o[df][1]); w.y = cvt_pk_bf16(o[df][2], o[df][3]);
            *(u32x2*)(xo + tok * DM + h * 256 + df * 16 + fg * 4) = w; }
    }
    lds_barrier();
}
__device__ __forceinline__ void xattn_pair(LAS unsigned char* lds, int i0, const bf16_t* xq, const bf16_t* xkv, bf16_t* xo) { const int it[2] = {i0, i0 + 1}; xattn_items(lds, it, 2, xq, xkv, xo); }
__device__ __forceinline__ void xattn_item(LAS unsigned char* lds, int item, const bf16_t* xq, const bf16_t* xkv, bf16_t* xo) { const int it[1] = {item}; xattn_items(lds, it, 1, xq, xkv, xo); }

struct Ptrs {
    unsigned char* ws; float *ss1, *ss2, *ss3, *ss4, *ss5, *ssm, *stats, *rcos, *rsin; bf16_t *mb, *xkv, *B0, *B1, *B2, *B3, *B4, *qbuf, *kbuf;
    __device__ __forceinline__ explicit Ptrs(unsigned char* w) {
        size_t z = 0; asm volatile("" : "+s"(z));
        ws = w + z; ss1 = (float*)(ws + S_SS); ss2 = ss1 + T_TOK; ss3 = ss2 + T_TOK; ss4 = ss3 + T_TOK; ss5 = ss4 + T_TOK;
        ssm = (float*)(ws + S_SSM); stats = (float*)(ws + S_STATS); rcos = (float*)(ws + S_COS); rsin = (float*)(ws + S_SIN);
        mb = (bf16_t*)(ws + A_MB); xkv = (bf16_t*)(ws + A_XKV);
        B0 = (bf16_t*)(ws + A_B0); B1 = (bf16_t*)(ws + A_B1); B2 = (bf16_t*)(ws + A_B2); B3 = (bf16_t*)(ws + A_B3); B4 = (bf16_t*)(ws + A_B4);
        qbuf = B1; kbuf = B1 + (size_t)T_TOK * 512;
    }
    __device__ __forceinline__ const bf16_t* w(size_t off) const { return (const bf16_t*)(ws + off); }
};
template <class Epi>
__device__ __forceinline__ void run_gemm(LAS unsigned char* lds, const bf16_t* A, int lda, const bf16_t* Bt, int M, int N, int K, int c, const Epi& E) {
    pg8::StaticOrder S; S.init(M, N, (int)gridDim.x, c);
    pg8::gemm_phase(lds, pg8::Gemm{A, Bt, M, N, K, lda, K}, S, E);
}
__device__ __forceinline__ void phase_prep(const Params& p, LAS unsigned char* lds) {
    const Ptrs P(p.ws); unsigned char* ws = P.ws;
    const int G = (int)gridDim.x, bid = (int)blockIdx.x, tid = threadIdx.x;
    for (int i = bid * 512 + tid; i < 4 * T_TOK; i += G * 512) P.ss2[i] = 0.f;
    for (int i = bid * 512 + tid; i < T_TOK * 8; i += G * 512) P.stats[i] = 0.f;
    for (int i = bid * 512 + tid; i < SEQ * 64; i += G * 512) {
        const int pos = i >> 6, d = i & 63;
        const float invf = exp2f(-(float)d * (13.287712379549449f / 64.0f));
        const float ang = (float)pos * invf;
        const float nrev = rintf(ang * 0.15915494309189535f);
        float r = fmaf(-nrev, 6.2831854820251465f, ang); r = fmaf(-nrev, -1.7484555314695172e-07f, r);
        P.rcos[i] = __builtin_amdgcn_cosf(r * 0.15915494309189535f); P.rsin[i] = __builtin_amdgcn_sinf(r * 0.15915494309189535f);
    }
    rows_prep(p.in[0], P.B0, P.ss1, T_TOK);
    rows_prep(p.in[1], P.mb, P.ssm, MEMT);
    const float* w1a = p.in[3]; const float* w3a = p.in[4];
    wprep(lds, (bf16_t*)(ws + W_13A), 5632, 1024, p.in[2], [=](int r) { const int pn = r >> 8, bj = (r >> 7) & 1, pp = r & 127; return RowSrc{(bj ? w3a : w1a) + pn * 128 + pp, DFF}; });
    const float* w2a = p.in[5];
    wprep(lds, (bf16_t*)(ws + W_2A), 1024, 2816, nullptr, [=](int r) { return RowSrc{w2a + r, 1024}; });
    const float* win = p.in[7];
    wprep(lds, (bf16_t*)(ws + W_IN), 4096, 1024, p.in[6], [=](int r) {
        int col;
        if (r < 1024) { const int seg = r >> 9, rr = r & 511, pnl = rr >> 8, bj = (rr >> 7) & 1, pp = rr & 127; const int head = 2 * pnl + (pp >> 6), d = pp & 63; col = seg * 512 + head * 128 + 64 * bj + d; }
        else if (r < 2048) col = 3072 + (r - 1024);
        else if (r < 3072) col = 1024 + (r - 2048);
        else col = 4096 + (r - 3072);
        return RowSrc{win + col, 5120}; });
    const float* wxk = p.in[24]; const float* wxv = p.in[25];
    wprep(lds, (bf16_t*)(ws + W_XKV), 2048, 1024, p.in[22], [=](int r) { return r < 1024 ? RowSrc{wxk + r, 1024} : RowSrc{wxv + (r - 1024), 1024}; });
    const float* wrg = p.in[12]; const float* wig = p.in[14];
    wprep(lds, (bf16_t*)(ws + W_LRU), 2048, 128, nullptr, [=](int r) { const int gi = (r >> 7) & 7, c = r & 127; return RowSrc{(r < 1024 ? wrg : wig) + gi * 16384 + c, 128}; });
}
__device__ __forceinline__ void phase1_late(const Params& p, LAS unsigned char* lds, unsigned char* ws) {
    const int G = (int)gridDim.x, bid = (int)blockIdx.x;
    const int nlate = G / 4, l0 = G - nlate;
    if (bid >= l0) {
        const float* w1b = p.in[28]; const float* w3b = p.in[29];
        wprep(lds, (bf16_t*)(ws + W_13B), 5632, 1024, p.in[27], [=](int r) { const int pn = r >> 8, bj = (r >> 7) & 1, pp = r & 127; return RowSrc{(bj ? w3b : w1b) + pn * 128 + pp, DFF}; }, bid - l0, nlate);
        const float* w2b = p.in[30];
        wprep(lds, (bf16_t*)(ws + W_2B), 1024, 2816, nullptr, [=](int r) { return RowSrc{w2b + r, 1024}; }, bid - l0, nlate);
    } else if (bid >= G / 2) {
        const int m0 = G / 2, nm = l0 - m0;
        const float* wout = p.in[20]; wprep(lds, (bf16_t*)(ws + W_OUT), 1024, 1024, nullptr, [=](int r) { return RowSrc{wout + r, 1024}; }, bid - m0, nm);
        const float* wxq = p.in[23]; wprep(lds, (bf16_t*)(ws + W_XQ), 1024, 1024, p.in[21], [=](int r) { return RowSrc{wxq + r, 1024}; }, bid - m0, nm);
        const float* wxo = p.in[26]; wprep(lds, (bf16_t*)(ws + W_XO), 1024, 1024, nullptr, [=](int r) { return RowSrc{wxo + r, 1024}; }, bid - m0, nm);
    }
}
__device__ __forceinline__ void phase_mix(const Params& p, LAS unsigned char* lds, int mode = 0) {
    const Ptrs P(p.ws); const int G = (int)gridDim.x, bid = (int)blockIdx.x;
    if (G == 256) {
        if (bid < 128) { retention_item(lds, bid, P.qbuf, P.kbuf, P.B3, P.stats);
            unsigned char* ws = P.ws; const float* win = p.in[7]; const float* wbg = p.in[18];
            wprep(lds, (bf16_t*)(ws + W_GG), 3072, 1024, p.in[6], [=](int r) { return r < 1024 ? RowSrc{win + 2048 + r, 5120} : RowSrc{wbg + (r - 1024), 2048}; }, bid, 128);
            const float* wro = p.in[9]; wprep(lds, (bf16_t*)(ws + W_RO), 1024, 1024, nullptr, [=](int r) { return RowSrc{wro + r, 1024}; }, bid, 128);
            const float* wlo = p.in[17]; wprep(lds, (bf16_t*)(ws + W_LO), 1024, 1024, nullptr, [=](int r) { return RowSrc{wlo + r, 1024}; }, bid, 128); }
        else lru_item(lds, bid - 128, P.B2, P.B4, P.w(W_LRU), p.in[10], p.in[11], p.in[13], p.in[15], p.in[16]);
    } else {
        { unsigned char* ws = P.ws; const float* win = p.in[7]; const float* wbg = p.in[18];
          wprep(lds, (bf16_t*)(ws + W_GG), 3072, 1024, p.in[6], [=](int r) { return r < 1024 ? RowSrc{win + 2048 + r, 5120} : RowSrc{wbg + (r - 1024), 2048}; });
          const float* wro = p.in[9]; wprep(lds, (bf16_t*)(ws + W_RO), 1024, 1024, nullptr, [=](int r) { return RowSrc{wro + r, 1024}; });
          const float* wlo = p.in[17]; wprep(lds, (bf16_t*)(ws + W_LO), 1024, 1024, nullptr, [=](int r) { return RowSrc{wlo + r, 1024}; }); }
        for (int it = bid; it < 256; it += G) {
            if (it < 128) retention_item(lds, it, P.qbuf, P.kbuf, P.B3, P.stats);
            else lru_item(lds, it - 128, P.B2, P.B4, P.w(W_LRU), p.in[10], p.in[11], p.in[13], p.in[15], p.in[16]);
        }
    }
}
__device__ __forceinline__ void phase_final(const Params& p) {
    const Ptrs P(p.ws); const int G = (int)gridDim.x, bid = (int)blockIdx.x, tid = threadIdx.x;
    const float* gf = p.in[31]; float* X = p.out;
    for (int i = bid * 512 + tid; i < T_TOK * 256; i += G * 512) {
        const int row = i >> 8, c = (i & 255) * 4; const float rs = rs_of(P.ss5[row]);
        const u32x2 w = *(const u32x2*)(P.B0 + (size_t)row * DM + c); const f32x4 gv = *(const f32x4*)(gf + c);
        f32x4 v = (f32x4){bflo(w.x), bfhi(w.x), bflo(w.y), bfhi(w.y)};
        v = v * rs * gv; *(f32x4*)(X + (size_t)row * DM + c) = v;
    }
}

__global__ __launch_bounds__(512, 2) void fwd_mega(Params p) {
    extern __shared__ __attribute__((aligned(16))) unsigned char shm[];
    LAS unsigned char* lds = (LAS unsigned char*)shm;
    cg::grid_group grid = cg::this_grid();
    const int bid = (int)blockIdx.x, G = (int)gridDim.x;
    unsigned* bar = (unsigned*)(p.ws + S_BAR);
    volatile LAS unsigned* xst = (volatile LAS unsigned*)(lds + LDS_BYTES - 16);
    if (threadIdx.x == 0) { xst[0] = 0u; xst[1] = 0u; }
    __syncthreads();
    const XcdBarrier xb = xcd_barrier_post(bar, xst);
    if (p.ph_lo > 1000) grid.sync();
#ifndef PHMASK
#define PHMASK 0x7fff
#endif
#ifndef REPMASK
#define REPMASK 0
#endif
#define PHASE(k, body) if (((PHMASK >> (k)) & 1) && p.ph_lo <= (k) && (k) < p.ph_hi) { if ((k) > p.ph_lo) xcd_barrier(xb); { body } if ((REPMASK >> (k)) & 1) { xcd_barrier(xb); { body } } }
    PHASE(0, phase_prep(p, lds);)
    PHASE(1, { const Ptrs P(p.ws);
        run_gemm(lds, P.B0, 1024, P.w(W_13A), T_TOK, 5632, 1024, bid, EpiSwiglu{P.B1, P.ss1});
        run_gemm(lds, P.mb, 1024, P.w(W_XKV), MEMT, 2048, 1024, (bid + G / 2) % G, EpiScale{P.xkv, 2048, P.ssm, 1.0f});
        phase1_late(p, lds, P.ws); })
    PHASE(2, { const Ptrs P(p.ws);
        run_gemm(lds, P.B1, DFF, P.w(W_2A), T_TOK, 1024, DFF, bid, EpiResidB<true>{p.in[0], P.B0, P.ss2, 0.5f}); })
    PHASE(3, { const Ptrs P(p.ws);
        run_gemm(lds, P.B0, 1024, P.w(W_IN), T_TOK, 4096, 1024, bid, EpiInproj{P.qbuf, P.B2, P.ss2, P.rcos, P.rsin}); })
    PHASE(4, phase_mix(p, lds);)
    PHASE(5, { const Ptrs P(p.ws);
        run_gemm(lds, P.B0, 1024, P.w(W_GG), T_TOK, 3072, 1024, bid, EpiGG{P.B3, P.B1, P.ss2, P.stats, p.in[8], p.in[19]}); })
    PHASE(6, { const Ptrs P(p.ws);
        run_gemm(lds, P.B3, 1024, P.w(W_RO), T_TOK, 1024, 1024, bid, EpiMerge<false>{(bf16_t*)p.out, P.B1}); })
    if (((PHMASK >> 7) & 1) && p.ph_lo <= 7 && 7 < p.ph_hi) { const Ptrs P(p.ws);
        run_gemm(lds, P.B4, 1024, P.w(W_LO), T_TOK, 1024, 1024, bid, EpiMerge<true>{(bf16_t*)p.out, P.B1}); }
    PHASE(8, { const Ptrs P(p.ws);
        run_gemm(lds, (const bf16_t*)p.out, 1024, P.w(W_OUT), T_TOK, 1024, 1024, bid, EpiResidB<false>{P.B0, P.B3, P.ss3, 1.0f}); })
    PHASE(9, { const Ptrs P(p.ws);
        run_gemm(lds, P.B3, 1024, P.w(W_XQ), T_TOK, 1024, 1024, bid, EpiScale{P.B4, 1024, P.ss3, 0.0625f});
        if (G == 256) {
            pg8::StaticOrder S; S.init(T_TOK, 1024, G, bid); Unit u; S.next(0, u);
            asm volatile("s_waitcnt vmcnt(0)" ::: "memory"); __syncthreads();
            xattn_pair(lds, ((u.pm >> 3) << 6) | (u.pn << 4) | ((u.pm & 7) * 2), P.B4, P.xkv, P.B0);
        } })
    if (G != 256) { PHASE(10, { const Ptrs P(p.ws);
        for (int it = bid; it < 512; it += G) xattn_item(lds, it, P.B4, P.xkv, P.B0); }) }
    PHASE(11, { const Ptrs P(p.ws);
        run_gemm(lds, P.B0, 1024, P.w(W_XO), T_TOK, 1024, 1024, bid, EpiResidB<false>{P.B3, P.B4, P.ss4, 1.0f}); })
    PHASE(12, { const Ptrs P(p.ws);
        run_gemm(lds, P.B4, 1024, P.w(W_13B), T_TOK, 5632, 1024, bid, EpiSwiglu{P.B1, P.ss4}); })
    if (G == 256) {
        PHASE(13, { const Ptrs P(p.ws);
            run_gemm(lds, P.B1, DFF, P.w(W_2B), T_TOK, 1024, DFF, bid, EpiFinal{P.B4, p.out, P.ss5, p.in[31], xb}); })
    } else {
        PHASE(13, { const Ptrs P(p.ws);
            run_gemm(lds, P.B1, DFF, P.w(W_2B), T_TOK, 1024, DFF, bid, EpiResidB<false>{P.B4, P.B0, P.ss5, 0.5f}); })
        PHASE(14, phase_final(p);)
    }
#undef PHASE
}

constexpr int N_PHASES = 15;
#ifndef DBG_HI
#define DBG_HI N_PHASES
#endif
extern "C" void kernel_launch(void* const* d_in, const int* in_sizes, int n_in, void* d_out, int out_size, void* d_ws, size_t ws_size, hipStream_t stream) {
    static int grid = 0;
    if (grid == 0) {
        if (n_in != 32 || out_size != T_TOK * DM || ws_size < WS_NEED) { fprintf(stderr, "kernel_launch: unexpected shapes (n_in %d out %d ws %zu)\n", n_in, out_size, ws_size); grid = -1; return; }
        int dev = 0, cus = 0, per_cu = 0;
        hipGetDevice(&dev); hipDeviceGetAttribute(&cus, hipDeviceAttributeMultiprocessorCount, dev);
        hipFuncSetAttribute((const void*)fwd_mega, hipFuncAttributeMaxDynamicSharedMemorySize, LDS_BYTES);
        hipOccupancyMaxActiveBlocksPerMultiprocessor(&per_cu, (const void*)fwd_mega, 512, LDS_BYTES);
        if (per_cu < 1) { fprintf(stderr, "kernel_launch: occupancy query says %d blocks/CU\n", per_cu); per_cu = 1; }
        (void)hipGetLastError();
        grid = cus;
    }
    if (grid < 0) return;
    Params p{};
    for (int i = 0; i < 32; ++i) p.in[i] = (const float*)d_in[i];
    p.out = (float*)d_out; p.ws = (unsigned char*)d_ws;
#ifndef N_CUTS
#define N_CUTS 1
#endif
    if (hipMemsetAsync((unsigned char*)d_ws + S_BAR, 0, 16384, stream) != hipSuccess) { fprintf(stderr, "kernel_launch: memset of the barrier word failed\n"); return; }
    for (int li = 0; li < N_CUTS; ++li) {
        p.ph_lo = li * DBG_HI / N_CUTS; p.ph_hi = (li + 1) * DBG_HI / N_CUTS;
        void* args[] = {&p};
        hipError_t e = hipLaunchCooperativeKernel((const void*)fwd_mega, dim3(grid), dim3(512), args, LDS_BYTES, stream);
        if (e != hipSuccess) fprintf(stderr, "cooperative launch failed: %s (grid %d)\n", hipGetErrorString(e), grid);
    }
}
```

```cpp
#include <hip/hip_runtime.h>
#include <hip/hip_cooperative_groups.h>
#include <cstdio>
namespace cg = cooperative_groups;

#define LAS __attribute__((address_space(3)))
typedef unsigned short bf16_t;
typedef short bf16x8 __attribute__((ext_vector_type(8)));
typedef short s16x4 __attribute__((ext_vector_type(4)));
typedef float f32x4 __attribute__((ext_vector_type(4)));
typedef unsigned u32x4 __attribute__((ext_vector_type(4)));
typedef unsigned u32x2 __attribute__((ext_vector_type(2)));

constexpr int T_TOK = 16384, DM = 1024, SEQ = 2048, NB = 8, DFF = 2816, MEMT = 2048;
constexpr float EPS = 1e-6f;
constexpr int LDS_BYTES = 140 * 1024;

constexpr size_t MiB = 1024 * 1024;
constexpr size_t W_13A = 0;
constexpr size_t W_2A = W_13A + (size_t)5632 * 1024 * 2;
constexpr size_t W_IN = W_2A + (size_t)1024 * 2816 * 2;
constexpr size_t W_GG = W_IN + (size_t)4096 * 1024 * 2;
constexpr size_t W_RO = W_GG + (size_t)3072 * 1024 * 2;
constexpr size_t W_LO = W_RO + (size_t)1024 * 1024 * 2;
constexpr size_t W_OUT = W_LO + (size_t)1024 * 1024 * 2;
constexpr size_t W_XQ = W_OUT + (size_t)1024 * 1024 * 2;
constexpr size_t W_XKV = W_XQ + (size_t)1024 * 1024 * 2;
constexpr size_t W_XO = W_XKV + (size_t)2048 * 1024 * 2;
constexpr size_t W_13B = W_XO + (size_t)1024 * 1024 * 2;
constexpr size_t W_2B = W_13B + (size_t)5632 * 1024 * 2;
constexpr size_t W_LRU = W_2B + (size_t)1024 * 2816 * 2;
constexpr size_t W_END = W_LRU + (size_t)2 * 1024 * 128 * 2;
static_assert(W_END <= 62 * MiB, "weights");
constexpr size_t S_SS = 62 * MiB;
constexpr size_t S_SSM = S_SS + 5 * 65536;
constexpr size_t S_STATS = S_SSM + 8192;
constexpr size_t S_COS = S_STATS + 524288;
constexpr size_t S_SIN = S_COS + 524288;
constexpr size_t S_BAR = S_SIN + 524288;
static_assert(S_BAR + 16384 <= 64 * MiB && S_BAR % 256 == 0, "small");
constexpr size_t A_MB = 64 * MiB;
constexpr size_t A_XKV = 68 * MiB;
constexpr size_t A_B0 = 76 * MiB, A_B1 = 108 * MiB, A_B2 = 140 * MiB, A_B3 = 172 * MiB, A_B4 = 204 * MiB;
constexpr size_t WS_NEED = 236 * MiB;

struct Params { const float* in[32]; float* out; unsigned char* ws; int ph_lo, ph_hi; };

typedef float f32x2v __attribute__((ext_vector_type(2)));
typedef __bf16 bf16x2v __attribute__((ext_vector_type(2)));
__device__ __forceinline__ unsigned cvt_pk_bf16(float lo, float hi) { const f32x2v v = {lo, hi}; return __builtin_bit_cast(unsigned, __builtin_convertvector(v, bf16x2v)); }
__device__ __forceinline__ float bflo(unsigned w) { return __uint_as_float(w << 16); }
__device__ __forceinline__ float bfhi(unsigned w) { return __uint_as_float(w & 0xffff0000u); }
__device__ __forceinline__ float bf2f(bf16_t b) { return __uint_as_float((unsigned)b << 16); }
__device__ __forceinline__ u32x4 pack8(const float* o) { u32x4 w; w.x = cvt_pk_bf16(o[0], o[1]); w.y = cvt_pk_bf16(o[2], o[3]); w.z = cvt_pk_bf16(o[4], o[5]); w.w = cvt_pk_bf16(o[6], o[7]); return w; }
__device__ __forceinline__ void unpack8(u32x4 w, float* o) { o[0] = bflo(w.x); o[1] = bfhi(w.x); o[2] = bflo(w.y); o[3] = bfhi(w.y); o[4] = bflo(w.z); o[5] = bfhi(w.z); o[6] = bflo(w.w); o[7] = bfhi(w.w); }
__device__ __forceinline__ float sigmoidf_(float x) { return __builtin_amdgcn_rcpf(1.0f + __expf(-x)); }
__device__ __forceinline__ void sigmoid2(float x0, float x1, float& s0, float& s1) {
    const float d0 = 1.0f + __expf(-fmaxf(x0, -40.f)), d1 = 1.0f + __expf(-fmaxf(x1, -40.f)); const float r = __builtin_amdgcn_rcpf(d0 * d1); s0 = r * d1; s1 = r * d0; }
__device__ __forceinline__ float rs_of(float ss) { return rsqrtf(ss * (1.0f / 1024.0f) + EPS); }
__device__ __forceinline__ void lds_barrier() { asm volatile("s_waitcnt lgkmcnt(0)" ::: "memory"); __builtin_amdgcn_s_barrier(); asm volatile("" ::: "memory"); }

namespace pg8 {
constexpr int BM = 256, BK = 64, HALF = 128, HTB = HALF * BK * 2, STAGE_BYTES = 8 * HTB, NXCD = 8, WGM = 8;
__host__ __device__ __forceinline__ int lds_byte(int r, int c) { const int st = (r >> 4) * 2 + (c >> 5), rr = r & 15, cc = c & 31, ob = rr * 64 + cc * 2; return st * 1024 + (ob ^ (((ob >> 9) & 1) << 5)); }
__host__ __device__ __forceinline__ void stage_rc(int b, int& R, int& C) { const int st = b / 1024, sb = b % 1024, swz = sb ^ (((sb >> 9) & 1) << 5); R = (st >> 1) * 16 + swz / 64; C = (st & 1) * 32 + (swz % 64) / 2; }
__host__ __device__ __forceinline__ int perm32(int rho) { const int n = rho >> 4, i = rho & 15; return 8 * (i >> 2) + 4 * n + (i & 3); }
struct Unit { int pm, pn; };
struct Gemm { const bf16_t* A; const bf16_t* Bt; int M, N, K, lda, ldb; };
struct StaticOrder {
    int nM, nN, nwg, G, c;
    __device__ __forceinline__ void init(int M, int N, int G_, int c_) { nM = M / BM; nN = N / BM; nwg = nM * nN; G = G_; c = c_; }
    __device__ __forceinline__ bool next(int i, Unit& u) const {
        const long L = (long)i * G + c; if (L >= nwg) return false;
        int wgid = (int)L; { const int q = nwg / NXCD, r = nwg % NXCD, xcd = wgid % NXCD, off = wgid / NXCD; wgid = (xcd < r ? xcd * (q + 1) : r * (q + 1) + (xcd - r) * q) + off; }
        const int nig = WGM * nN, gid = wgid / nig, fm = gid * WGM, gsz = (nM - fm) < WGM ? (nM - fm) : WGM;
        u.pm = fm + ((wgid % nig) % gsz); u.pn = (wgid % nig) / gsz; return true;
    }
};
template <class Epi>
__device__ __forceinline__ void gemm_phase(LAS unsigned char* lds, const Gemm g, const StaticOrder& S, const Epi& E) {
    const int tid = threadIdx.x, wid = __builtin_amdgcn_readfirstlane(tid >> 6), lane = tid & 63, wr = wid >> 2, wc = wid & 3, fr = lane & 15, fq = lane >> 4;
    const int K = g.K, nt = K / BK;
    unsigned voffA[2], voffB[2];
#pragma unroll
    for (int i = 0; i < 2; ++i) { int R, C; stage_rc(tid * 16 + i * 8192, R, C); const int Rb = Epi::PERM ? ((R & ~31) + perm32(R & 31)) : R;
        voffA[i] = (unsigned)(R * g.lda + C) * 2u; voffB[i] = (unsigned)(Rb * g.ldb + C) * 2u; }
    const size_t kstep = (size_t)(BK * 2);
    const size_t hstepA = (size_t)HALF * g.lda * 2, hstepB = (size_t)HALF * g.ldb * 2;
    const size_t tstepA = 2 * hstepA, tstepB = 2 * hstepB;
    const unsigned ldsw = (unsigned)wid * 1024u;
    const int aoff = lds_byte(wr * 64 + fr, fq * 8), boff = lds_byte(wc * 32 + fr, fq * 8);
#define PG8_SA(b, h) (((b) * 2 + (h)) * HTB)
#define PG8_SB(b, h) ((4 + (b) * 2 + (h)) * HTB)
#define PG8_STAGE(bufoff, gbase, voff) do { _Pragma("unroll") for (int _i = 0; _i < 2; ++_i) \
        __builtin_amdgcn_global_load_lds((const unsigned*)((const char*)(gbase) + (voff)[_i]), (LAS unsigned*)(lds + (bufoff) + ldsw + _i * 8192), 16, 0, 0); } while (0)
#define PG8_LDA(dst, b, h) do { _Pragma("unroll") for (int m = 0; m < 4; ++m) _Pragma("unroll") for (int k = 0; k < 2; ++k) dst[m][k] = *(const LAS bf16x8*)(lds + PG8_SA(b, h) + aoff + m * 2048 + k * 1024); } while (0)
#define PG8_LDB(dst, b, h) do { _Pragma("unroll") for (int n = 0; n < 2; ++n) _Pragma("unroll") for (int k = 0; k < 2; ++k) dst[n][k] = *(const LAS bf16x8*)(lds + PG8_SB(b, h) + boff + n * 2048 + k * 1024); } while (0)
#define PG8_MMA(ai, bj, At, Bt) do { __builtin_amdgcn_s_setprio(1); _Pragma("unroll") for (int m = 0; m < 4; ++m) _Pragma("unroll") for (int n = 0; n < 2; ++n) _Pragma("unroll") for (int k = 0; k < 2; ++k) \
        acc[ai][bj][m][n] = __builtin_amdgcn_mfma_f32_16x16x32_bf16(Bt[n][k], At[m][k], acc[ai][bj][m][n], 0, 0, 0); __builtin_amdgcn_s_setprio(0); } while (0)
#define PG8_WAIT_V(n) asm volatile("s_waitcnt vmcnt(" #n ")" ::: "memory")
#define PG8_WAIT_L(n) asm volatile("s_waitcnt lgkmcnt(" #n ")" ::: "memory")
#define PG8_BAR __builtin_amdgcn_s_barrier()
#define PG8_SCHED __builtin_amdgcn_sched_barrier(0)
    Unit cur, nxt; int ui = 0;
    if (!S.next(0, cur)) return;
    f32x4 acc[2][2][4][2];
#pragma unroll
    for (int a = 0; a < 2; ++a)
#pragma unroll
        for (int b = 0; b < 2; ++b)
#pragma unroll
            for (int m = 0; m < 4; ++m)
#pragma unroll
                for (int n = 0; n < 2; ++n) acc[a][b][m][n] = (f32x4){0.f, 0.f, 0.f, 0.f};
    bf16x8 At[4][2], B0[2][2], B1[2][2];
    const char* cA = (const char*)g.A + (size_t)cur.pm * tstepA; const char* cB = (const char*)g.Bt + (size_t)cur.pn * tstepB;
    PG8_STAGE(PG8_SB(0, 0), cB, voffB); PG8_STAGE(PG8_SA(0, 0), cA, voffA); PG8_STAGE(PG8_SB(0, 1), cB + hstepB, voffB); PG8_STAGE(PG8_SA(0, 1), cA + hstepA, voffA);
    if (wr == 1) PG8_BAR;
    PG8_WAIT_V(4); PG8_BAR;
    PG8_STAGE(PG8_SB(1, 0), cB + kstep, voffB); PG8_STAGE(PG8_SA(1, 0), cA + kstep, voffA); PG8_STAGE(PG8_SB(1, 1), cB + hstepB + kstep, voffB);
    PG8_WAIT_V(6); PG8_BAR;
    for (;;) {
        const bool has_next = S.next(ui + 1, nxt);
        const char* nA = has_next ? (const char*)g.A + (size_t)nxt.pm * tstepA : cA; const char* nB = has_next ? (const char*)g.Bt + (size_t)nxt.pn * tstepB : cB;
        for (int t = 0; t < nt; t += 2) {
            const bool last = (t == nt - 2);
            const char* a1 = cA + (size_t)(t + 1) * kstep;
            const char* a2 = last ? nA : cA + (size_t)(t + 2) * kstep; const char* b2 = last ? nB : cB + (size_t)(t + 2) * kstep;
            const char* a3 = a2 + kstep; const char* b3 = b2 + kstep;
            PG8_LDB(B0, 0, 0); PG8_SCHED; PG8_LDA(At, 0, 0); PG8_STAGE(PG8_SA(1, 1), a1 + hstepA, voffA);
            PG8_WAIT_L(8); PG8_BAR; PG8_WAIT_L(0); PG8_MMA(0, 0, At, B0); PG8_BAR; PG8_SCHED;
            PG8_LDB(B1, 0, 1); PG8_STAGE(PG8_SB(0, 0), b2, voffB);
            PG8_BAR; PG8_WAIT_L(0); PG8_MMA(0, 1, At, B1); PG8_BAR;
            PG8_LDA(At, 0, 1); PG8_STAGE(PG8_SA(0, 0), a2, voffA);
            PG8_BAR; PG8_WAIT_L(0); PG8_MMA(1, 0, At, B0); PG8_BAR; PG8_SCHED;
            PG8_STAGE(PG8_SB(0, 1), b2 + hstepB, voffB);
            PG8_WAIT_V(6); PG8_BAR; PG8_MMA(1, 1, At, B1); PG8_BAR;
            PG8_LDB(B0, 1, 0); PG8_SCHED; PG8_LDA(At, 1, 0); PG8_STAGE(PG8_SA(0, 1), a2 + hstepA, voffA);
            PG8_WAIT_L(8); PG8_BAR; PG8_WAIT_L(0); PG8_MMA(0, 0, At, B0); PG8_BAR; PG8_SCHED;
            PG8_LDB(B1, 1, 1); PG8_STAGE(PG8_SB(1, 0), b3, voffB);
            PG8_BAR; PG8_WAIT_L(0); PG8_MMA(0, 1, At, B1); PG8_BAR;
            PG8_LDA(At, 1, 1); PG8_STAGE(PG8_SA(1, 0), a3, voffA);
            PG8_BAR; PG8_WAIT_L(0); PG8_MMA(1, 0, At, B0); PG8_BAR; PG8_SCHED;
            PG8_STAGE(PG8_SB(1, 1), b3 + hstepB, voffB);
            PG8_WAIT_V(6); PG8_BAR; PG8_MMA(1, 1, At, B1); PG8_BAR;
        }
        if constexpr (!Epi::AFTER_DRAIN) E(acc, cur, wr, wc, fr, fq);
        if (!has_next) break;
#pragma unroll
        for (int a = 0; a < 2; ++a)
#pragma unroll
            for (int b = 0; b < 2; ++b)
#pragma unroll
                for (int m = 0; m < 4; ++m)
#pragma unroll
                    for (int n = 0; n < 2; ++n) acc[a][b][m][n] = (f32x4){0.f, 0.f, 0.f, 0.f};
        cur = nxt; cA = nA; cB = nB; ++ui;
    }
    PG8_WAIT_V(0);
    if (wr == 0) PG8_BAR;
    PG8_BAR;
    if constexpr (Epi::AFTER_DRAIN) E.fused(acc, cur, wr, wc, fr, fq);
#undef PG8_SA
#undef PG8_SB
#undef PG8_STAGE
#undef PG8_LDA
#undef PG8_LDB
#undef PG8_MMA
#undef PG8_WAIT_V
#undef PG8_WAIT_L
#undef PG8_BAR
#undef PG8_SCHED
}
}
using pg8::Unit;
typedef f32x4 AccT[2][2][4][2];

#define XB_TMO      128
#define XB_XCNT(j)  (256  + 64 * (j))
#define XB_XSUB(j)  (1280 + 64 * (j))
#define XB_XGEN(j)  (2304 + 64 * (j))
#define XB_TOP      3328
#define XB_TOPGEN   3392
#define XCD_BAR_WORDS 3456
#define XB_SPIN_CAP (1u << 18)

__device__ __forceinline__ unsigned xb_ld(unsigned* p)              { return __hip_atomic_load(p, __ATOMIC_RELAXED, __HIP_MEMORY_SCOPE_AGENT); }
__device__ __forceinline__ unsigned xb_add(unsigned* p, unsigned v) { return __hip_atomic_fetch_add(p, v, __ATOMIC_RELAXED, __HIP_MEMORY_SCOPE_AGENT); }
__device__ __forceinline__ unsigned xb_xcc_id() { return (unsigned)__builtin_amdgcn_s_getreg((3 << 11) | 20) & 0xFu; }
#define XB_SPIN(cond, bar) do { unsigned _sp = 0; while (cond) { __builtin_amdgcn_s_sleep(1); \
    if ((++_sp & 255u) == 0u) { if (xb_ld(&(bar)[XB_TMO])) break; if (_sp > XB_SPIN_CAP) { atomicAdd(&(bar)[XB_TMO], 1u); break; } } } } while (0)

struct XcdBarrier {
    unsigned* bar; unsigned x;
    volatile LAS unsigned* st;
};

__device__ __forceinline__ XcdBarrier xcd_barrier_post(unsigned* bar, volatile LAS unsigned* st) {
    XcdBarrier b; b.bar = bar; b.x = xb_xcc_id(); b.st = st;
    if (threadIdx.x == 0) (void)xb_add(&bar[XB_XCNT(b.x)], 1u);
    return b;
}
__device__ __forceinline__ void xcd_barrier_complete(unsigned* bar, unsigned x, unsigned& nloc, unsigned& nx) {
    const unsigned G = gridDim.x * gridDim.y * gridDim.z;
    unsigned sum, cnt, mine, sp = 0u;
    for (;;) {
        sum = 0u; cnt = 0u; mine = 0u;
#pragma unroll
        for (unsigned j = 0; j < 16; ++j) { const unsigned c = xb_ld(&bar[XB_XCNT(j)]); sum += c; cnt += (c > 0u) ? 1u : 0u; mine = (j == x) ? c : mine; }
        if (sum == G) break;
        __builtin_amdgcn_s_sleep(1);
        if ((++sp & 255u) == 0u) { if (xb_ld(&bar[XB_TMO])) break; if (sp > XB_SPIN_CAP) { atomicAdd(&bar[XB_TMO], 1u); break; } }
    }
    nloc = mine > 0u ? mine : 1u; nx = cnt > 0u ? cnt : 1u;
}

__device__ __forceinline__ void xcd_barrier(const XcdBarrier& b) {
    asm volatile("s_waitcnt vmcnt(0)" ::: "memory");
    __syncthreads();
    if (threadIdx.x == 0) {
        unsigned* bar = b.bar;
        __builtin_amdgcn_s_waitcnt(0);
        unsigned nloc = b.st[0], nx = b.st[1];
        if (nloc == 0u) { xcd_barrier_complete(bar, b.x, nloc, nx); b.st[0] = nloc; b.st[1] = nx; }
        const unsigned old = xb_add(&bar[XB_XSUB(b.x)], 1u);
        const unsigned gen = old / nloc;
        if (old + 1u == (gen + 1u) * nloc) {
            __builtin_amdgcn_fence(__ATOMIC_RELEASE, "agent");
            asm volatile("s_waitcnt vmcnt(0)" ::: "memory");
            const unsigned og = xb_add(&bar[XB_TOP], 1u);
            const unsigned tg = og / nx;
            if (og + 1u == (tg + 1u) * nx) xb_add(&bar[XB_TOPGEN], 1u);
            else XB_SPIN(xb_ld(&bar[XB_TOPGEN]) == tg, bar);
            __builtin_amdgcn_fence(__ATOMIC_ACQUIRE, "agent");
            xb_add(&bar[XB_XGEN(b.x)], 1u);
            asm volatile("s_waitcnt vmcnt(0)" ::: "memory");
        } else {
            XB_SPIN(xb_ld(&bar[XB_XGEN(b.x)]) == gen, bar);
            __builtin_amdgcn_fence(__ATOMIC_ACQUIRE, "agent");
            asm volatile("s_waitcnt vmcnt(0)" ::: "memory");
        }
    }
    __syncthreads();
}


struct EpiSwiglu {
    static constexpr bool PERM = true, AFTER_DRAIN = false;
    bf16_t* G; const float* ss;
    __device__ __forceinline__ void operator()(const AccT& acc, const Unit& u, int wr, int wc, int fr, int fq) const {
        const int row0 = u.pm * 256 + wr * 64 + fr, col0 = u.pn * 128 + wc * 32 + 8 * fq;
#pragma unroll
        for (int ai = 0; ai < 2; ++ai)
#pragma unroll
            for (int m = 0; m < 4; ++m) {
                const int row = row0 + ai * 128 + m * 16; const float rs = rs_of(ss[row]); float o[8];
#pragma unroll
                for (int n = 0; n < 2; ++n)
#pragma unroll
                    for (int j = 0; j < 4; j += 2) {
                        const float a1 = acc[ai][0][m][n][j] * rs, b1 = acc[ai][0][m][n][j + 1] * rs;
                        const float d0 = 1.0f + __expf(-fmaxf(a1, -40.f)), d1 = 1.0f + __expf(-fmaxf(b1, -40.f));
                        const float r = __builtin_amdgcn_rcpf(d0 * d1);
                        o[4 * n + j] = a1 * (r * d1) * (acc[ai][1][m][n][j] * rs); o[4 * n + j + 1] = b1 * (r * d0) * (acc[ai][1][m][n][j + 1] * rs); }
                *(u32x4*)(G + (size_t)row * DFF + col0) = pack8(o);
            }
    }
};
template <bool WB> struct EpiResid {
    static constexpr bool PERM = true, AFTER_DRAIN = false;
    const float* base; float* X; bf16_t* Xb; float* ss; float scale;
    __device__ __forceinline__ void operator()(const AccT& acc, const Unit& u, int wr, int wc, int fr, int fq) const {
        const int row0 = u.pm * 256 + wr * 64 + fr, col0 = u.pn * 256 + wc * 32 + 8 * fq;
#pragma unroll
        for (int ai = 0; ai < 2; ++ai)
#pragma unroll
            for (int m = 0; m < 4; ++m) {
                const int row = row0 + ai * 128 + m * 16; float sq = 0.f;
#pragma unroll
                for (int bj = 0; bj < 2; ++bj) {
                    const size_t off = (size_t)row * DM + col0 + bj * 128;
                    const f32x4 b0 = *(const f32x4*)(base + off), b1 = *(const f32x4*)(base + off + 4);
                    const f32x4 v0 = b0 + scale * acc[ai][bj][m][0], v1 = b1 + scale * acc[ai][bj][m][1];
                    *(f32x4*)(X + off) = v0; *(f32x4*)(X + off + 4) = v1;
                    sq += (v0[0] * v0[0] + v0[1] * v0[1]) + (v0[2] * v0[2] + v0[3] * v0[3]) + (v1[0] * v1[0] + v1[1] * v1[1]) + (v1[2] * v1[2] + v1[3] * v1[3]);
                    if (WB) { u32x4 w; w.x = cvt_pk_bf16(v0[0], v0[1]); w.y = cvt_pk_bf16(v0[2], v0[3]); w.z = cvt_pk_bf16(v1[0], v1[1]); w.w = cvt_pk_bf16(v1[2], v1[3]); *(u32x4*)(Xb + off) = w; }
                }
                sq += __shfl_xor(sq, 16); sq += __shfl_xor(sq, 32);
                if (fq == 0) unsafeAtomicAdd(ss + row, sq);
            }
    }
};
template <bool BASE_F32> struct EpiResidB {
    static constexpr bool PERM = true, AFTER_DRAIN = false;
    const void* base; bf16_t* Xb; float* ss; float scale;
    __device__ __forceinline__ void operator()(const AccT& acc, const Unit& u, int wr, int wc, int fr, int fq) const {
        const int row0 = u.pm * 256 + wr * 64 + fr, col0 = u.pn * 256 + wc * 32 + 8 * fq;
#pragma unroll
        for (int ai = 0; ai < 2; ++ai)
#pragma unroll
            for (int m = 0; m < 4; ++m) {
                const int row = row0 + ai * 128 + m * 16; float sq = 0.f;
#pragma unroll
                for (int bj = 0; bj < 2; ++bj) {
                    const size_t off = (size_t)row * DM + col0 + bj * 128; float bv[8];
                    if (BASE_F32) { const f32x4 b0 = *(const f32x4*)((const float*)base + off), b1 = *(const f32x4*)((const float*)base + off + 4);
#pragma unroll
                        for (int j = 0; j < 4; ++j) { bv[j] = b0[j]; bv[4 + j] = b1[j]; } }
                    else unpack8(*(const u32x4*)((const bf16_t*)base + off), bv);
                    float o[8];
#pragma unroll
                    for (int n = 0; n < 2; ++n)
#pragma unroll
                        for (int j = 0; j < 4; ++j) { const float v = bv[4 * n + j] + scale * acc[ai][bj][m][n][j]; o[4 * n + j] = v; sq += v * v; }
                    *(u32x4*)(Xb + off) = pack8(o);
                }
                sq += __shfl_xor(sq, 16); sq += __shfl_xor(sq, 32);
                if (fq == 0) unsafeAtomicAdd(ss + row, sq);
            }
    }
};
struct EpiInproj {
    static constexpr bool PERM = true, AFTER_DRAIN = false;
    bf16_t *q, *xl; const float *ss, *cs, *sn;
    __device__ __forceinline__ void operator()(const AccT& acc, const Unit& u, int wr, int wc, int fr, int fq) const {
        const int row0 = u.pm * 256 + wr * 64 + fr, p0 = wc * 32 + 8 * fq, pn = u.pn;
        if (pn < 4) {
            bf16_t* dst = q + (size_t)(pn >> 1) * ((size_t)T_TOK * 512); const float sc = pn < 2 ? 1.0f : 0.08838834764831845f;
            const int head = 2 * (pn & 1) + (p0 >> 6), d0 = p0 & 63;
#pragma unroll
            for (int ai = 0; ai < 2; ++ai)
#pragma unroll
                for (int m = 0; m < 4; ++m) {
                    const int row = row0 + ai * 128 + m * 16; const float rs = rs_of(ss[row]) * sc; const int pos = row & (SEQ - 1);
                    const float* cp = cs + pos * 64 + d0; const float* sp = sn + pos * 64 + d0;
                    bf16_t* dp = dst + (size_t)row * 512 + head * 128 + d0;
#pragma unroll
                    for (int n = 0; n < 2; ++n) {
                        const f32x4 c = *(const f32x4*)(cp + 4 * n), s = *(const f32x4*)(sp + 4 * n);
                        const f32x4 t1 = acc[ai][0][m][n] * rs, t2 = acc[ai][1][m][n] * rs;
                        const f32x4 o1 = t1 * c - t2 * s, o2 = t2 * c + t1 * s;
                        u32x2 w1, w2; w1.x = cvt_pk_bf16(o1[0], o1[1]); w1.y = cvt_pk_bf16(o1[2], o1[3]); w2.x = cvt_pk_bf16(o2[0], o2[1]); w2.y = cvt_pk_bf16(o2[2], o2[3]);
                        *(u32x2*)(dp + 4 * n) = w1; *(u32x2*)(dp + 64 + 4 * n) = w2;
                    }
                }
        } else {
            const int seg = (pn - 4) >> 2; bf16_t* dst = xl + (size_t)seg * ((size_t)T_TOK * DM); const int colb = ((pn - 4) & 3) * 256 + p0;
#pragma unroll
            for (int ai = 0; ai < 2; ++ai)
#pragma unroll
                for (int m = 0; m < 4; ++m) {
                    const int row = row0 + ai * 128 + m * 16; const float rs = rs_of(ss[row]);
#pragma unroll
                    for (int bj = 0; bj < 2; ++bj) {
                        float o[8];
#pragma unroll
                        for (int n = 0; n < 2; ++n)
#pragma unroll
                            for (int j = 0; j < 4; j += 2) { float a = acc[ai][bj][m][n][j] * rs, b = acc[ai][bj][m][n][j + 1] * rs;
                                if (seg == 2) { const float ua = 1.5957691216057308f * (a + 0.044715f * a * a * a), ub = 1.5957691216057308f * (b + 0.044715f * b * b * b);
                                    float sa, sb; sigmoid2(ua, ub, sa, sb); a *= sa; b *= sb; }
                                o[4 * n + j] = a; o[4 * n + j + 1] = b; }
                        *(u32x4*)(dst + (size_t)row * DM + colb + bj * 128) = pack8(o);
                    }
                }
        }
    }
};
struct EpiGG {
    static constexpr bool PERM = true, AFTER_DRAIN = false;
    bf16_t* aret; bf16_t* gates; const float *ss, *stats, *gn, *bg;
    __device__ __forceinline__ void operator()(const AccT& acc, const Unit& u, int wr, int wc, int fr, int fq) const {
        const int row0 = u.pm * 256 + wr * 64 + fr, p0 = wc * 32 + 8 * fq, pn = u.pn;
        if (pn < 4) {
#pragma unroll
            for (int ai = 0; ai < 2; ++ai)
#pragma unroll
                for (int m = 0; m < 4; ++m) {
                    const int row = row0 + ai * 128 + m * 16; const float rs = rs_of(ss[row]);
                    const float s1 = stats[((size_t)row * 4 + pn) * 2], s2 = stats[((size_t)row * 4 + pn) * 2 + 1];
                    const float mu = s1 * (1.0f / 256.0f); const float var = fmaxf(s2 * (1.0f / 256.0f) - mu * mu, 0.f); const float rstd = rsqrtf(var + EPS);
#pragma unroll
                    for (int bj = 0; bj < 2; ++bj) {
                        const int col = pn * 256 + bj * 128 + p0; bf16_t* rp = aret + (size_t)row * DM + col;
                        float r[8], o[8]; unpack8(*(const u32x4*)rp, r);
                        const f32x4 g0 = *(const f32x4*)(gn + col), g1 = *(const f32x4*)(gn + col + 4);
#pragma unroll
                        for (int n = 0; n < 2; ++n)
#pragma unroll
                            for (int j = 0; j < 4; j += 2) { const float a = acc[ai][bj][m][n][j] * rs, b = acc[ai][bj][m][n][j + 1] * rs; float sa, sb; sigmoid2(a, b, sa, sb);
                                o[4 * n + j] = a * sa * (n ? g1[j] : g0[j]) * (r[4 * n + j] - mu) * rstd; o[4 * n + j + 1] = b * sb * (n ? g1[j + 1] : g0[j + 1]) * (r[4 * n + j + 1] - mu) * rstd; }
                        *(u32x4*)rp = pack8(o);
                    }
                }
        } else {
#pragma unroll
            for (int ai = 0; ai < 2; ++ai)
#pragma unroll
                for (int m = 0; m < 4; ++m) {
                    const int row = row0 + ai * 128 + m * 16; const float rs = rs_of(ss[row]);
#pragma unroll
                    for (int bj = 0; bj < 2; ++bj) {
                        const int col = (pn - 4) * 256 + bj * 128 + p0; float o[8];
                        const f32x4 b0 = *(const f32x4*)(bg + col), b1 = *(const f32x4*)(bg + col + 4);
#pragma unroll
                        for (int n = 0; n < 2; ++n)
#pragma unroll
                            for (int j = 0; j < 4; j += 2) sigmoid2(acc[ai][bj][m][n][j] * rs + (n ? b1[j] : b0[j]), acc[ai][bj][m][n][j + 1] * rs + (n ? b1[j + 1] : b0[j + 1]), o[4 * n + j], o[4 * n + j + 1]);
                        *(u32x4*)(gates + (size_t)row * 2048 + col) = pack8(o);
                    }
                }
        }
    }
};
template <bool SECOND> struct EpiMerge {
    static constexpr bool PERM = true, AFTER_DRAIN = false;
    bf16_t* merged; const bf16_t* gates;
    __device__ __forceinline__ void operator()(const AccT& acc, const Unit& u, int wr, int wc, int fr, int fq) const {
        const int row0 = u.pm * 256 + wr * 64 + fr, col0 = u.pn * 256 + wc * 32 + 8 * fq;
#pragma unroll
        for (int ai = 0; ai < 2; ++ai)
#pragma unroll
            for (int m = 0; m < 4; ++m) {
                const int row = row0 + ai * 128 + m * 16;
#pragma unroll
                for (int bj = 0; bj < 2; ++bj) {
                    const int col = col0 + bj * 128; float g[8], o[8];
                    unpack8(*(const u32x4*)(gates + (size_t)row * 2048 + (SECOND ? 1024 : 0) + col), g);
                    bf16_t* mp = merged + (size_t)row * DM + col;
                    if (SECOND) unpack8(*(const u32x4*)mp, o);
#pragma unroll
                    for (int n = 0; n < 2; ++n)
#pragma unroll
                        for (int j = 0; j < 4; ++j) { const float t = g[4 * n + j] * acc[ai][bj][m][n][j]; o[4 * n + j] = SECOND ? o[4 * n + j] + t : t; }
                    *(u32x4*)mp = pack8(o);
                }
            }
    }
};
struct EpiScale {
    static constexpr bool PERM = true, AFTER_DRAIN = false;
    bf16_t* O; int ldc; const float* ss; float sc;
    __device__ __forceinline__ void operator()(const AccT& acc, const Unit& u, int wr, int wc, int fr, int fq) const {
        const int row0 = u.pm * 256 + wr * 64 + fr, col0 = u.pn * 256 + wc * 32 + 8 * fq;
#pragma unroll
        for (int ai = 0; ai < 2; ++ai)
#pragma unroll
            for (int m = 0; m < 4; ++m) {
                const int row = row0 + ai * 128 + m * 16; const float rs = rs_of(ss[row]) * sc;
#pragma unroll
                for (int bj = 0; bj < 2; ++bj) { float o[8];
#pragma unroll
                    for (int n = 0; n < 2; ++n)
#pragma unroll
                        for (int j = 0; j < 4; ++j) o[4 * n + j] = acc[ai][bj][m][n][j] * rs;
                    *(u32x4*)(O + (size_t)row * ldc + col0 + bj * 128) = pack8(o); }
            }
    }
};

struct EpiFinal {
    static constexpr bool PERM = true, AFTER_DRAIN = true;
    const bf16_t* base; float* X; float* ss; const float* gfin; XcdBarrier xb;
    __device__ __forceinline__ void fused(AccT& acc, const Unit& u, int wr, int wc, int fr, int fq) const {
        const int row0 = u.pm * 256 + wr * 64 + fr, col0 = u.pn * 256 + wc * 32 + 8 * fq;
#pragma unroll
        for (int ai = 0; ai < 2; ++ai)
#pragma unroll
            for (int m = 0; m < 4; ++m) {
                const int row = row0 + ai * 128 + m * 16; float sq = 0.f;
#pragma unroll
                for (int bj = 0; bj < 2; ++bj) {
                    const size_t off = (size_t)row * DM + col0 + bj * 128;
                    float bv[8]; unpack8(*(const u32x4*)(base + off), bv);
                    const f32x4 v0 = (f32x4){bv[0], bv[1], bv[2], bv[3]} + 0.5f * acc[ai][bj][m][0], v1 = (f32x4){bv[4], bv[5], bv[6], bv[7]} + 0.5f * acc[ai][bj][m][1];
                    acc[ai][bj][m][0] = v0; acc[ai][bj][m][1] = v1;
                    sq += (v0[0] * v0[0] + v0[1] * v0[1]) + (v0[2] * v0[2] + v0[3] * v0[3]) + (v1[0] * v1[0] + v1[1] * v1[1]) + (v1[2] * v1[2] + v1[3] * v1[3]);
                }
                sq += __shfl_xor(sq, 16); sq += __shfl_xor(sq, 32);
                if (fq == 0) unsafeAtomicAdd(ss + row, sq);
            }
        xcd_barrier(xb);
#pragma unroll
        for (int ai = 0; ai < 2; ++ai)
#pragma unroll
            for (int m = 0; m < 4; ++m) {
                const int row = row0 + ai * 128 + m * 16; const float rs = rs_of(ss[row]);
#pragma unroll
                for (int bj = 0; bj < 2; ++bj) {
                    const size_t off = (size_t)row * DM + col0 + bj * 128; const int col = col0 + bj * 128;
                    const f32x4 g0 = *(const f32x4*)(gfin + col), g1 = *(const f32x4*)(gfin + col + 4);
                    *(f32x4*)(X + off) = acc[ai][bj][m][0] * rs * g0; *(f32x4*)(X + off + 4) = acc[ai][bj][m][1] * rs * g1;
                }
            }
    }
};
struct RowSrc { const float* p; int ld; };
template <class F>
__device__ __forceinline__ void wprep(LAS unsigned char* lds, bf16_t* dst, int nrows, int K, const float* gain, F rowsrc, int b0 = (int)blockIdx.x, int nb = (int)gridDim.x) {
    LAS float* tile = (LAS float*)lds;
    const int tid = threadIdx.x, kk = tid >> 4, r4 = (tid & 15) * 4;
    const int ntk = K / 128, ntiles = (nrows / 64) * ntk;
    f32x4 cur[4], nxt[4];
    auto fetch = [&](int t, f32x4 (&v)[4]) {
        const int r0 = (t / ntk) * 64, k0 = (t % ntk) * 128; const RowSrc rs = rowsrc(r0 + r4);
#pragma unroll
        for (int it = 0; it < 4; ++it) { const int k = k0 + kk + 32 * it; f32x4 x = *(const f32x4*)(rs.p + (size_t)k * rs.ld); if (gain) x *= gain[k]; v[it] = x; }
    };
    int t = b0;
    if (t < ntiles) fetch(t, cur);
    for (; t < ntiles; t += nb) {
        const int tn = t + nb;
        if (tn < ntiles) fetch(tn, nxt);
        const int r0 = (t / ntk) * 64, k0 = (t % ntk) * 128;
        __syncthreads();
#pragma unroll
        for (int it = 0; it < 4; ++it)
#pragma unroll
            for (int j = 0; j < 4; ++j) tile[(r4 + j) * 129 + kk + 32 * it] = cur[it][j];
        __syncthreads();
        const int row = tid >> 3, ch = tid & 7;
#pragma unroll
        for (int hf = 0; hf < 2; ++hf) { float o[8];
#pragma unroll
            for (int j = 0; j < 8; ++j) o[j] = tile[row * 129 + hf * 64 + ch * 8 + j];
            *(u32x4*)(dst + (size_t)(r0 + row) * K + k0 + hf * 64 + ch * 8) = pack8(o); }
#pragma unroll
        for (int it = 0; it < 4; ++it) cur[it] = nxt[it];
    }
    __syncthreads();
}

__device__ __forceinline__ void rows_prep(const float* src, bf16_t* dst, float* ss, int nrows) {
    const int lane = threadIdx.x & 63, gw = blockIdx.x * 8 + (threadIdx.x >> 6), nw = gridDim.x * 8;
    for (int r = gw; r < nrows; r += nw) {
        const float* sp = src + (size_t)r * DM; float sq = 0.f;
#pragma unroll
        for (int i = 0; i < 2; ++i) {
            const int c = (i * 64 + lane) * 8;
            const f32x4 a = *(const f32x4*)(sp + c), b = *(const f32x4*)(sp + c + 4);
            sq += (a[0] * a[0] + a[1] * a[1]) + (a[2] * a[2] + a[3] * a[3]) + (b[0] * b[0] + b[1] * b[1]) + (b[2] * b[2] + b[3] * b[3]);
            u32x4 w; w.x = cvt_pk_bf16(a[0], a[1]); w.y = cvt_pk_bf16(a[2], a[3]); w.z = cvt_pk_bf16(b[0], b[1]); w.w = cvt_pk_bf16(b[2], b[3]);
            *(u32x4*)(dst + (size_t)r * DM + c) = w;
        }
#pragma unroll
        for (int o = 32; o >= 1; o >>= 1) sq += __shfl_xor(sq, o);
        if (lane == 0) ss[r] = sq;
    }
}

__device__ __forceinline__ bf16x8 tr_frag(LAS unsigned char* tile, int stride, int k0, int x0, int lane) {
    const int g = lane >> 4, ii = lane & 15, q = ii >> 2, p = ii & 3;
    LAS unsigned char* a = tile + (k0 + 8 * g + q) * stride + (x0 + 4 * p) * 2;
    const s16x4 lo = __builtin_amdgcn_ds_read_tr16_b64_v4i16((LAS s16x4*)a);
    const s16x4 hi = __builtin_amdgcn_ds_read_tr16_b64_v4i16((LAS s16x4*)(a + 4 * stride));
    bf16x8 r; r[0] = lo[0]; r[1] = lo[1]; r[2] = lo[2]; r[3] = lo[3]; r[4] = hi[0]; r[5] = hi[1]; r[6] = hi[2]; r[7] = hi[3]; return r;
}
__device__ __forceinline__ bf16x8 scale_frag(bf16x8 f, const float* s) {
    u32x4 w = __builtin_bit_cast(u32x4, f); float o[8]; unpack8(w, o);
#pragma unroll
    for (int j = 0; j < 8; ++j) o[j] *= s[j];
    return __builtin_bit_cast(bf16x8, pack8(o));
}

constexpr int R_KT = 0, R_KS = 272;
constexpr int R_VT = 128 * 272, R_VS = 144;
constexpr int R_SB = R_VT + 128 * 144;
constexpr int R_PW = R_SB + 128 * 144;
static_assert(R_PW + 8 * 16 * 272 <= LDS_BYTES, "ret lds");
__device__ __forceinline__ void retention_item(LAS unsigned char* lds, int item, const bf16_t* qb, const bf16_t* kb, bf16_t* vb  , float* stats) {
    int tid = threadIdx.x; asm volatile("" : "+v"(tid));
    const int wid = tid >> 6, lane = tid & 63, fr = lane & 15, fg = lane >> 4;
    const int widu = __builtin_amdgcn_readfirstlane(tid >> 6);
    const int b = item >> 4, h = (item >> 2) & 3, es = item & 3;
    const float l2g = __log2f(1.0f - exp2f(-5.0f - (float)h));
    const float cd = exp2f(128.0f * l2g);
    const size_t tok0 = (size_t)b * SEQ;
    LAS unsigned char* Pw = lds + R_PW + wid * (16 * 272);
    f32x4 st[4];
#pragma unroll
    for (int e = 0; e < 4; ++e) st[e] = (f32x4){0.f, 0.f, 0.f, 0.f};
    u32x4 kreg[4], vreg[2], qnext[4], qf[4];
    auto issue = [&](int n) {
        const size_t t0 = tok0 + (size_t)n * 128;
#pragma unroll
        for (int i = 0; i < 4; ++i) { const int c = tid + 512 * i, row = c >> 4, c16 = c & 15; kreg[i] = *(const u32x4*)(kb + (t0 + row) * 512 + h * 128 + c16 * 8); }
#pragma unroll
        for (int i = 0; i < 2; ++i) { const int c = tid + 512 * i, row = c >> 3, c8 = c & 7; vreg[i] = *(const u32x4*)(vb + (t0 + row) * DM + h * 256 + es * 64 + c8 * 8); }
#pragma unroll
        for (int s = 0; s < 4; ++s) qnext[s] = *(const u32x4*)(qb + (t0 + wid * 16 + fr) * 512 + h * 128 + s * 32 + fg * 8);
    };
    issue(0);
    const float qdec = exp2f((float)(wid * 16 + fr + 1) * l2g);
    for (int n = 0; n < 16; ++n) {
        float l2 = l2g; asm volatile("" : "+v"(l2));
        int irow = wid * 16 + fr, fgl = fg; asm volatile("" : "+v"(irow), "+v"(fgl));
        lds_barrier();
#pragma unroll
        for (int i = 0; i < 4; ++i) { const int c = tid + 512 * i, row = c >> 4, c16 = c & 15; *(LAS u32x4*)(lds + R_KT + row * R_KS + c16 * 16) = kreg[i]; }
#pragma unroll
        for (int i = 0; i < 2; ++i) { const int c = tid + 512 * i, row = c >> 3, c8 = c & 7; *(LAS u32x4*)(lds + R_VT + row * R_VS + c8 * 16) = vreg[i]; }
#pragma unroll
        for (int e = 0; e < 4; ++e) { u32x2 w; w.x = cvt_pk_bf16(st[e][0], st[e][1]); w.y = cvt_pk_bf16(st[e][2], st[e][3]);
            *(LAS u32x2*)(lds + R_SB + (wid * 16 + fr) * R_VS + (e * 16 + fg * 4) * 2) = w; }
#pragma unroll
        for (int s = 0; s < 4; ++s) qf[s] = qnext[s];
        if (n + 1 < 16) issue(n + 1);
        lds_barrier();
        {
#pragma unroll
            for (int jf = 0; jf < 8; ++jf) {
                if (jf > (widu | 1)) break;
                f32x4 sc = (f32x4){0.f, 0.f, 0.f, 0.f};
#pragma unroll
                for (int s = 0; s < 4; ++s) {
                    const bf16x8 a = *(const LAS bf16x8*)(lds + R_KT + (jf * 16 + fr) * R_KS + (s * 32 + fg * 8) * 2);
                    sc = __builtin_amdgcn_mfma_f32_16x16x32_bf16(a, __builtin_bit_cast(bf16x8, qf[s]), sc, 0, 0, 0);
                }
                float pv[4];
#pragma unroll
                for (int r = 0; r < 4; ++r) { const int j = jf * 16 + fgl * 4 + r; const int dlt = irow - j; pv[r] = dlt >= 0 ? sc[r] * __builtin_amdgcn_exp2f((float)dlt * l2) : 0.f; }
                u32x2 w; w.x = cvt_pk_bf16(pv[0], pv[1]); w.y = cvt_pk_bf16(pv[2], pv[3]);
                *(LAS u32x2*)(Pw + fr * 272 + (jf * 16 + fg * 4) * 2) = w;
                __builtin_amdgcn_sched_barrier(0);
            }
        }
        asm volatile("s_waitcnt lgkmcnt(0)" ::: "memory");
        {
            f32x4 o[4];
#pragma unroll
            for (int e = 0; e < 4; ++e) { o[e] = (f32x4){0.f, 0.f, 0.f, 0.f}; st[e] *= cd; }
#pragma unroll
            for (int s = 0; s < 4; ++s) {
                const bf16x8 pf = *(const LAS bf16x8*)(Pw + fr * 272 + (s * 32 + fg * 8) * 2);
                float kd[8];
#pragma unroll
                for (int j = 0; j < 8; ++j) kd[j] = __builtin_amdgcn_exp2f((float)(127 - (s * 32 + fgl * 8 + j)) * l2);
                const bf16x8 kf = scale_frag(tr_frag(lds + R_KT, R_KS, s * 32, wid * 16, lane), kd);
                float qs[8];
#pragma unroll
                for (int j = 0; j < 8; ++j) qs[j] = qdec;
                const bf16x8 qsf = scale_frag(__builtin_bit_cast(bf16x8, qf[s]), qs);
#pragma unroll
                for (int e = 0; e < 4; ++e) {
                    const bf16x8 vf = tr_frag(lds + R_VT, R_VS, s * 32, e * 16, lane);
                    if (s <= (widu >> 1)) o[e] = __builtin_amdgcn_mfma_f32_16x16x32_bf16(vf, pf, o[e], 0, 0, 0);
                    st[e] = __builtin_amdgcn_mfma_f32_16x16x32_bf16(vf, kf, st[e], 0, 0, 0);
                    const bf16x8 sf = tr_frag(lds + R_SB, R_VS, s * 32, e * 16, lane);
                    o[e] = __builtin_amdgcn_mfma_f32_16x16x32_bf16(sf, qsf, o[e], 0, 0, 0);
                }
                __builtin_amdgcn_sched_barrier(0);
            }
            const size_t tok = tok0 + (size_t)n * 128 + wid * 16 + fr;
            float s1 = 0.f, s2 = 0.f;
#pragma unroll
            for (int e = 0; e < 4; ++e) {
                u32x2 w; w.x = cvt_pk_bf16(o[e][0], o[e][1]); w.y = cvt_pk_bf16(o[e][2], o[e][3]);
                *(u32x2*)(vb + tok * DM + h * 256 + es * 64 + e * 16 + fg * 4) = w;
                s1 += (o[e][0] + o[e][1]) + (o[e][2] + o[e][3]);
                s2 += (o[e][0] * o[e][0] + o[e][1] * o[e][1]) + (o[e][2] * o[e][2] + o[e][3] * o[e][3]);
            }
            s1 += __shfl_xor(s1, 16); s1 += __shfl_xor(s1, 32); s2 += __shfl_xor(s2, 16); s2 += __shfl_xor(s2, 32);
            if (fg == 0) { unsafeAtomicAdd(stats + (tok * 4 + h) * 2, s1); unsafeAtomicAdd(stats + (tok * 4 + h) * 2 + 1, s2); }
        }
    }
    lds_barrier();
}

constexpr int L_XC = 0;
constexpr int L_WL = 128 * 272;
constexpr int L_SA = L_WL + 128 * 272;
constexpr int L_SBX = L_SA + 32768;
constexpr int L_SEGA = L_SBX + 32768;
constexpr int L_SEGB = L_SEGA + 2048;
constexpr int L_CARRY = L_SEGB + 2048;
constexpr int L_CW = L_CARRY + 512;
static_assert(L_CW + 5 * 512 <= LDS_BYTES - 16, "lru lds");
__device__ __forceinline__ void lru_item(LAS unsigned char* lds, int item, const bf16_t* xl, bf16_t* gg  , const bf16_t* wlru,
                                         const float* conv_w, const float* conv_b, const float* b_r, const float* b_i, const float* lam) {
    int tid = threadIdx.x; asm volatile("" : "+v"(tid));
    const int wid = tid >> 6, lane = tid & 63, fr = lane & 15, fg = lane >> 4;
    const int b = item >> 4, g = (item >> 1) & 7, hf2 = item & 1;
    const int chg = g * 128, c0 = chg + hf2 * 64;
    const size_t tok0 = (size_t)b * SEQ;
    for (int c = tid; c < 128 * 16; c += 512) { const int n = c >> 4, c16 = c & 15; const bf16_t* src = wlru + ((size_t)(n >> 6) * 1024 + c0 + (n & 63)) * 128 + c16 * 8;
        *(LAS u32x4*)(lds + L_WL + n * 272 + c16 * 16) = *(const u32x4*)src; }
    if (tid < 64) ((LAS float*)(lds + L_CARRY))[tid] = 0.f;
    const int ch8 = tid & 15;
    for (int c = tid; c < 5 * 128; c += 512) ((LAS float*)(lds + L_CW))[c] = c < 512 ? conv_w[(c >> 7) * DM + chg + (c & 127)] : conv_b[chg + (c & 127)];
    float br_[4], bi_[4], sp_[4];
#pragma unroll
    for (int hf = 0; hf < 4; ++hf) { const int ch = c0 + hf * 16 + fr; br_[hf] = b_r[ch]; bi_[hf] = b_i[ch]; sp_[hf] = log1pf(__expf(-lam[ch])); }
    u32x4 rwn[7];
    auto load_rows = [&](int T0n) {
        const int tk0 = (tid >> 4) * 4;
#pragma unroll
        for (int q = 0; q < 7; ++q) { const int ts = T0n + tk0 - 3 + q; rwn[q] = ts >= 0 ? *(const u32x4*)(xl + (tok0 + ts) * DM + chg + ch8 * 8) : (u32x4){0u, 0u, 0u, 0u}; }
    };
    load_rows(0);
    for (int tile = 0; tile < 16; ++tile) {
        const int T0 = tile * 128;
        bf16_t gpre[16];
#pragma unroll
        for (int t = 0; t < 16; ++t) gpre[t] = gg[(tok0 + T0 + wid * 16 + t) * DM + c0 + lane];
        {
            const int tk0 = (tid >> 4) * 4;
            float acc8[4][8], cw[4][8];
            { const f32x4 b0 = *(const LAS f32x4*)(lds + L_CW + 2048 + ch8 * 32), b1 = *(const LAS f32x4*)(lds + L_CW + 2048 + ch8 * 32 + 16);
#pragma unroll
              for (int i = 0; i < 4; ++i)
#pragma unroll
                for (int j = 0; j < 4; ++j) { acc8[i][j] = b0[j]; acc8[i][4 + j] = b1[j]; } }
#pragma unroll
            for (int t = 0; t < 4; ++t) { const f32x4 w0 = *(const LAS f32x4*)(lds + L_CW + t * 512 + ch8 * 32), w1 = *(const LAS f32x4*)(lds + L_CW + t * 512 + ch8 * 32 + 16);
#pragma unroll
                for (int j = 0; j < 4; ++j) { cw[t][j] = w0[j]; cw[t][4 + j] = w1[j]; } }
#pragma unroll
            for (int q = 0; q < 7; ++q) { float x[8]; unpack8(rwn[q], x);
#pragma unroll
                for (int i = 0; i < 4; ++i) { const int tap = q - i;
                    if (tap >= 0 && tap < 4) {
#pragma unroll
                        for (int j = 0; j < 8; ++j) acc8[i][j] += cw[tap][j] * x[j]; } } }
#pragma unroll
            for (int i = 0; i < 4; ++i) *(LAS u32x4*)(lds + L_XC + (tk0 + i) * 272 + ch8 * 16) = pack8(acc8[i]);
            if (tile + 1 < 16) load_rows(T0 + 128);
        }
        lds_barrier();
        {
            f32x4 ga[8];
#pragma unroll
            for (int nf = 0; nf < 8; ++nf) ga[nf] = (f32x4){0.f, 0.f, 0.f, 0.f};
#pragma unroll
            for (int s = 0; s < 4; ++s) {
                const bf16x8 af = *(const LAS bf16x8*)(lds + L_XC + (wid * 16 + fr) * 272 + (s * 32 + fg * 8) * 2);
#pragma unroll
                for (int nf = 0; nf < 8; ++nf) {
                    const bf16x8 bfr = *(const LAS bf16x8*)(lds + L_WL + (nf * 16 + fr) * 272 + (s * 32 + fg * 8) * 2);
                    ga[nf] = __builtin_amdgcn_mfma_f32_16x16x32_bf16(af, bfr, ga[nf], 0, 0, 0);
                }
            }
#pragma unroll
            for (int hf = 0; hf < 4; ++hf)
#pragma unroll
                for (int r = 0; r < 4; ++r) {
                    const int tk = wid * 16 + fg * 4 + r, cl = hf * 16 + fr;
                    float rg, ig; sigmoid2(ga[hf][r] + br_[hf], ga[4 + hf][r] + bi_[hf], rg, ig);
                    const float la = -8.0f * rg * sp_[hf]; const float a = __expf(la); const float mult = __builtin_amdgcn_sqrtf(fmaxf(fmaf(-a, a, 1.0f), 0.f));
                    const float x = bf2f(*(const LAS bf16_t*)(lds + L_XC + tk * 272 + (hf2 * 64 + cl) * 2));
                    ((LAS float*)(lds + L_SA))[tk * 64 + cl] = a; ((LAS float*)(lds + L_SBX))[tk * 64 + cl] = mult * ig * x;
                }
        }
        asm volatile("s_waitcnt lgkmcnt(0)" ::: "memory");
        {
            const int c = lane, sg = wid;
            float A = 1.f, B = 0.f;
#pragma unroll
            for (int t = 0; t < 16; ++t) { const float a_ = ((LAS float*)(lds + L_SA))[(sg * 16 + t) * 64 + c], b_ = ((LAS float*)(lds + L_SBX))[(sg * 16 + t) * 64 + c]; A *= a_; B = a_ * B + b_; }
            ((LAS float*)(lds + L_SEGA))[sg * 64 + c] = A; ((LAS float*)(lds + L_SEGB))[sg * 64 + c] = B;
            lds_barrier();
            float hst = ((LAS float*)(lds + L_CARRY))[(tile & 1) * 64 + c];
            { float sa_[7], sb_[7];
#pragma unroll
              for (int s2 = 0; s2 < 7; ++s2) { sa_[s2] = ((LAS float*)(lds + L_SEGA))[s2 * 64 + c]; sb_[s2] = ((LAS float*)(lds + L_SEGB))[s2 * 64 + c]; }
#pragma unroll
              for (int s2 = 0; s2 < 7; ++s2) hst = s2 < sg ? sa_[s2] * hst + sb_[s2] : hst; }
#pragma unroll
            for (int t = 0; t < 16; ++t) {
                hst = ((LAS float*)(lds + L_SA))[(sg * 16 + t) * 64 + c] * hst + ((LAS float*)(lds + L_SBX))[(sg * 16 + t) * 64 + c];
                gg[(tok0 + T0 + sg * 16 + t) * DM + c0 + c] = (bf16_t)(cvt_pk_bf16(hst * bf2f(gpre[t]), 0.f) & 0xffffu);
            }
            if (sg == 7) ((LAS float*)(lds + L_CARRY))[((tile + 1) & 1) * 64 + c] = hst;
        }
    }
    lds_barrier();
}

constexpr int X_T = 0, X_TS = 528;
constexpr int X_VS = 272;
constexpr int X_PW = 256 * 272;
constexpr int X_SCR = X_PW + 8 * 16 * 272;
static_assert(128 * 528 <= X_PW && X_SCR + 8 * 256 <= 128 * 1024, "xattn lds");
__device__ __forceinline__ void xattn_items(LAS unsigned char* lds, const int* items, int nitems, const bf16_t* xq, const bf16_t* xkv, bf16_t* xo) {
    int tid = threadIdx.x; asm volatile("" : "+v"(tid));
    const int wid = tid >> 6, lane = tid & 63, fr = lane & 15, fg = lane >> 4;
    LAS unsigned char* Pw = lds + X_PW + wid * (16 * 272);
    u32x4 pre[8];
    auto loadK = [&](int b, int h, int mt) {
#pragma unroll
        for (int i = 0; i < 8; ++i) { const int c = tid + 512 * i, row = c >> 5, c16 = c & 31; pre[i] = *(const u32x4*)(xkv + ((size_t)b * 256 + mt * 128 + row) * 2048 + h * 256 + c16 * 8); } };
    auto loadV = [&](int b, int h, int mt) {
#pragma unroll
        for (int i = 0; i < 8; ++i) { const int c = tid + 512 * i, m = c & 127, c16 = c >> 7; pre[i] = *(const u32x4*)(xkv + ((size_t)b * 256 + mt * 128 + m) * 2048 + 1024 + h * 256 + c16 * 8); } };
    auto putK = [&]() {
#pragma unroll
        for (int i = 0; i < 8; ++i) { const int c = tid + 512 * i, row = c >> 5, c16 = c & 31; *(LAS u32x4*)(lds + X_T + row * X_TS + c16 * 16) = pre[i]; } };
    auto putV = [&]() {
#pragma unroll
        for (int i = 0; i < 8; ++i) { const int c = tid + 512 * i, m = c & 127, c16 = c >> 7; const u32x4 w = pre[i];
            LAS unsigned char* dp = lds + X_T + (c16 * 8) * X_VS + m * 2;
            *(LAS bf16_t*)(dp + 0 * X_VS) = (bf16_t)(w.x & 0xffffu); *(LAS bf16_t*)(dp + 1 * X_VS) = (bf16_t)(w.x >> 16);
            *(LAS bf16_t*)(dp + 2 * X_VS) = (bf16_t)(w.y & 0xffffu); *(LAS bf16_t*)(dp + 3 * X_VS) = (bf16_t)(w.y >> 16);
            *(LAS bf16_t*)(dp + 4 * X_VS) = (bf16_t)(w.z & 0xffffu); *(LAS bf16_t*)(dp + 5 * X_VS) = (bf16_t)(w.z >> 16);
            *(LAS bf16_t*)(dp + 6 * X_VS) = (bf16_t)(w.w & 0xffffu); *(LAS bf16_t*)(dp + 7 * X_VS) = (bf16_t)(w.w >> 16); } };
    { const int it0 = items[0]; loadK(it0 >> 6, (it0 >> 4) & 3, 0); }
    for (int ii = 0; ii < nitems; ++ii) {
        const int item = items[ii];
        const int b = item >> 6, h = (item >> 4) & 3, qt = item & 15;
        const size_t tok = (size_t)b * SEQ + qt * 128 + wid * 16 + fr;
        bf16x8 qf[8];
#pragma unroll
        for (int s = 0; s < 8; ++s) qf[s] = __builtin_bit_cast(bf16x8, *(const u32x4*)(xq + tok * DM + h * 256 + s * 32 + fg * 8));
        f32x4 sc[16];
#pragma unroll
        for (int mt = 0; mt < 2; ++mt) {
            lds_barrier();
            putK();
            if (mt == 0) loadK(b, h, 1); else loadV(b, h, 0);
            lds_barrier();
#pragma unroll
            for (int mf = 0; mf < 8; ++mf) {
                f32x4 a4 = (f32x4){0.f, 0.f, 0.f, 0.f};
#pragma unroll
                for (int s = 0; s < 8; ++s) {
                    const bf16x8 kf = *(const LAS bf16x8*)(lds + X_T + (mf * 16 + fr) * X_TS + (s * 32 + fg * 8) * 2);
                    a4 = __builtin_amdgcn_mfma_f32_16x16x32_bf16(kf, qf[s], a4, 0, 0, 0);
                }
                sc[mt * 8 + mf] = a4;
            }
        }
        float mx = -3.0e38f;
#pragma unroll
        for (int f = 0; f < 16; ++f) mx = fmaxf(mx, fmaxf(fmaxf(sc[f][0], sc[f][1]), fmaxf(sc[f][2], sc[f][3])));
        volatile LAS float* scr = (volatile LAS float*)(lds + X_SCR) + wid * 64;
        scr[lane] = mx;
        { const float m0 = scr[fr], m1 = scr[fr + 16], m2 = scr[fr + 32], m3 = scr[fr + 48]; mx = fmaxf(fmaxf(m0, m1), fmaxf(m2, m3)); }
        float sum = 0.f;
#pragma unroll
        for (int f = 0; f < 16; ++f)
#pragma unroll
            for (int r = 0; r < 4; ++r) { const float pe = __expf(sc[f][r] - mx); sc[f][r] = pe; sum += pe; }
        scr[lane] = sum;
        { const float m0 = scr[fr], m1 = scr[fr + 16], m2 = scr[fr + 32], m3 = scr[fr + 48]; sum = (m0 + m1) + (m2 + m3); }
        const float inv = 1.0f / sum;
        f32x4 o[16];
#pragma unroll
        for (int f = 0; f < 16; ++f) o[f] = (f32x4){0.f, 0.f, 0.f, 0.f};
#pragma unroll
        for (int mt = 0; mt < 2; ++mt) {
            lds_barrier();
            putV();
            if (mt == 0) loadV(b, h, 1);
            else if (ii + 1 < nitems) { const int itn = items[ii + 1]; loadK(itn >> 6, (itn >> 4) & 3, 0); }
#pragma unroll
            for (int f = 0; f < 8; ++f) { const f32x4 pv = sc[mt * 8 + f] * inv; u32x2 w; w.x = cvt_pk_bf16(pv[0], pv[1]); w.y = cvt_pk_bf16(pv[2], pv[3]);
                *(LAS u32x2*)(Pw + fr * 272 + (f * 16 + fg * 4) * 2) = w; }
            lds_barrier();
#pragma unroll
            for (int s = 0; s < 4; ++s) {
                const bf16x8 pf = *(const LAS bf16x8*)(Pw + fr * 272 + (s * 32 + fg * 8) * 2);
#pragma unroll
                for (int df = 0; df < 16; ++df) {
                    const bf16x8 vf = *(const LAS bf16x8*)(lds + X_T + (df * 16 + fr) * X_VS + (s * 32 + fg * 8) * 2);
                    o[df] = __builtin_amdgcn_mfma_f32_16x16x32_bf16(vf, pf, o[df], 0, 0, 0);
                }
            }
        }
#pragma unroll
        for (int df = 0; df < 16; ++df) { u32x2 w; w.x = cvt_pk_bf16(o[df][0], o[df][1]); w.y = cvt_pk_bf16(o[df][2], o[df][3]);
            *(u32x2*)(xo + tok * DM + h * 256 + df * 16 + fg * 4) = w; }
    }
    lds_barrier();
}
__device__ __forceinline__ void xattn_pair(LAS unsigned char* lds, int i0, const bf16_t* xq, const bf16_t* xkv, bf16_t* xo) { const int it[2] = {i0, i0 + 1}; xattn_items(lds, it, 2, xq, xkv, xo); }
__device__ __forceinline__ void xattn_item(LAS unsigned char* lds, int item, const bf16_t* xq, const bf16_t* xkv, bf16_t* xo) { const int it[1] = {item}; xattn_items(lds, it, 1, xq, xkv, xo); }

struct Ptrs {
    unsigned char* ws; float *ss1, *ss2, *ss3, *ss4, *ss5, *ssm, *stats, *rcos, *rsin; bf16_t *mb, *xkv, *B0, *B1, *B2, *B3, *B4, *qbuf, *kbuf;
    __device__ __forceinline__ explicit Ptrs(unsigned char* w) {
        size_t z = 0; asm volatile("" : "+s"(z));
        ws = w + z; ss1 = (float*)(ws + S_SS); ss2 = ss1 + T_TOK; ss3 = ss2 + T_TOK; ss4 = ss3 + T_TOK; ss5 = ss4 + T_TOK;
        ssm = (float*)(ws + S_SSM); stats = (float*)(ws + S_STATS); rcos = (float*)(ws + S_COS); rsin = (float*)(ws + S_SIN);
        mb = (bf16_t*)(ws + A_MB); xkv = (bf16_t*)(ws + A_XKV);
        B0 = (bf16_t*)(ws + A_B0); B1 = (bf16_t*)(ws + A_B1); B2 = (bf16_t*)(ws + A_B2); B3 = (bf16_t*)(ws + A_B3); B4 = (bf16_t*)(ws + A_B4);
        qbuf = B1; kbuf = B1 + (size_t)T_TOK * 512;
    }
    __device__ __forceinline__ const bf16_t* w(size_t off) const { return (const bf16_t*)(ws + off); }
};
template <class Epi>
__device__ __forceinline__ void run_gemm(LAS unsigned char* lds, const bf16_t* A, int lda, const bf16_t* Bt, int M, int N, int K, int c, const Epi& E) {
    pg8::StaticOrder S; S.init(M, N, (int)gridDim.x, c);
    pg8::gemm_phase(lds, pg8::Gemm{A, Bt, M, N, K, lda, K}, S, E);
}
__device__ __forceinline__ void phase_prep(const Params& p, LAS unsigned char* lds) {
    const Ptrs P(p.ws); unsigned char* ws = P.ws;
    const int G = (int)gridDim.x, bid = (int)blockIdx.x, tid = threadIdx.x;
    for (int i = bid * 512 + tid; i < 4 * T_TOK; i += G * 512) P.ss2[i] = 0.f;
    for (int i = bid * 512 + tid; i < T_TOK * 8; i += G * 512) P.stats[i] = 0.f;
    for (int i = bid * 512 + tid; i < SEQ * 64; i += G * 512) {
        const int pos = i >> 6, d = i & 63;
        const float invf = exp2f(-(float)d * (13.287712379549449f / 64.0f));
        const float ang = (float)pos * invf;
        const float nrev = rintf(ang * 0.15915494309189535f);
        float r = fmaf(-nrev, 6.2831854820251465f, ang); r = fmaf(-nrev, -1.7484555314695172e-07f, r);
        P.rcos[i] = __builtin_amdgcn_cosf(r * 0.15915494309189535f); P.rsin[i] = __builtin_amdgcn_sinf(r * 0.15915494309189535f);
    }
    rows_prep(p.in[0], P.B0, P.ss1, T_TOK);
    rows_prep(p.in[1], P.mb, P.ssm, MEMT);
    const float* w1a = p.in[3]; const float* w3a = p.in[4];
    wprep(lds, (bf16_t*)(ws + W_13A), 5632, 1024, p.in[2], [=](int r) { const int pn = r >> 8, bj = (r >> 7) & 1, pp = r & 127; return RowSrc{(bj ? w3a : w1a) + pn * 128 + pp, DFF}; });
    const float* w2a = p.in[5];
    wprep(lds, (bf16_t*)(ws + W_2A), 1024, 2816, nullptr, [=](int r) { return RowSrc{w2a + r, 1024}; });
    const float* win = p.in[7];
    wprep(lds, (bf16_t*)(ws + W_IN), 4096, 1024, p.in[6], [=](int r) {
        int col;
        if (r < 1024) { const int seg = r >> 9, rr = r & 511, pnl = rr >> 8, bj = (rr >> 7) & 1, pp = rr & 127; const int head = 2 * pnl + (pp >> 6), d = pp & 63; col = seg * 512 + head * 128 + 64 * bj + d; }
        else if (r < 2048) col = 3072 + (r - 1024);
        else if (r < 3072) col = 1024 + (r - 2048);
        else col = 4096 + (r - 3072);
        return RowSrc{win + col, 5120}; });
    const float* wxk = p.in[24]; const float* wxv = p.in[25];
    wprep(lds, (bf16_t*)(ws + W_XKV), 2048, 1024, p.in[22], [=](int r) { return r < 1024 ? RowSrc{wxk + r, 1024} : RowSrc{wxv + (r - 1024), 1024}; });
    const float* wrg = p.in[12]; const float* wig = p.in[14];
    wprep(lds, (bf16_t*)(ws + W_LRU), 2048, 128, nullptr, [=](int r) { const int gi = (r >> 7) & 7, c = r & 127; return RowSrc{(r < 1024 ? wrg : wig) + gi * 16384 + c, 128}; });
}
__device__ __forceinline__ void phase1_late(const Params& p, LAS unsigned char* lds, unsigned char* ws) {
    const int G = (int)gridDim.x, bid = (int)blockIdx.x;
    const int nlate = G / 4, l0 = G - nlate;
    if (bid >= l0) {
        const float* w1b = p.in[28]; const float* w3b = p.in[29];
        wprep(lds, (bf16_t*)(ws + W_13B), 5632, 1024, p.in[27], [=](int r) { const int pn = r >> 8, bj = (r >> 7) & 1, pp = r & 127; return RowSrc{(bj ? w3b : w1b) + pn * 128 + pp, DFF}; }, bid - l0, nlate);
        const float* w2b = p.in[30];
        wprep(lds, (bf16_t*)(ws + W_2B), 1024, 2816, nullptr, [=](int r) { return RowSrc{w2b + r, 1024}; }, bid - l0, nlate);
    } else if (bid >= G / 2) {
        const int m0 = G / 2, nm = l0 - m0;
        const float* wout = p.in[20]; wprep(lds, (bf16_t*)(ws + W_OUT), 1024, 1024, nullptr, [=](int r) { return RowSrc{wout + r, 1024}; }, bid - m0, nm);
        const float* wxq = p.in[23]; wprep(lds, (bf16_t*)(ws + W_XQ), 1024, 1024, p.in[21], [=](int r) { return RowSrc{wxq + r, 1024}; }, bid - m0, nm);
        const float* wxo = p.in[26]; wprep(lds, (bf16_t*)(ws + W_XO), 1024, 1024, nullptr, [=](int r) { return RowSrc{wxo + r, 1024}; }, bid - m0, nm);
    }
}
__device__ __forceinline__ void phase_mix(const Params& p, LAS unsigned char* lds, int mode = 0) {
    const Ptrs P(p.ws); const int G = (int)gridDim.x, bid = (int)blockIdx.x;
    if (G == 256) {
        if (bid < 128) { retention_item(lds, bid, P.qbuf, P.kbuf, P.B3, P.stats);
            unsigned char* ws = P.ws; const float* win = p.in[7]; const float* wbg = p.in[18];
            wprep(lds, (bf16_t*)(ws + W_GG), 3072, 1024, p.in[6], [=](int r) { return r < 1024 ? RowSrc{win + 2048 + r, 5120} : RowSrc{wbg + (r - 1024), 2048}; }, bid, 128);
            const float* wro = p.in[9]; wprep(lds, (bf16_t*)(ws + W_RO), 1024, 1024, nullptr, [=](int r) { return RowSrc{wro + r, 1024}; }, bid, 128);
            const float* wlo = p.in[17]; wprep(lds, (bf16_t*)(ws + W_LO), 1024, 1024, nullptr, [=](int r) { return RowSrc{wlo + r, 1024}; }, bid, 128); }
        else lru_item(lds, bid - 128, P.B2, P.B4, P.w(W_LRU), p.in[10], p.in[11], p.in[13], p.in[15], p.in[16]);
    } else {
        { unsigned char* ws = P.ws; const float* win = p.in[7]; const float* wbg = p.in[18];
          wprep(lds, (bf16_t*)(ws + W_GG), 3072, 1024, p.in[6], [=](int r) { return r < 1024 ? RowSrc{win + 2048 + r, 5120} : RowSrc{wbg + (r - 1024), 2048}; });
          const float* wro = p.in[9]; wprep(lds, (bf16_t*)(ws + W_RO), 1024, 1024, nullptr, [=](int r) { return RowSrc{wro + r, 1024}; });
          const float* wlo = p.in[17]; wprep(lds, (bf16_t*)(ws + W_LO), 1024, 1024, nullptr, [=](int r) { return RowSrc{wlo + r, 1024}; }); }
        for (int it = bid; it < 256; it += G) {
            if (it < 128) retention_item(lds, it, P.qbuf, P.kbuf, P.B3, P.stats);
            else lru_item(lds, it - 128, P.B2, P.B4, P.w(W_LRU), p.in[10], p.in[11], p.in[13], p.in[15], p.in[16]);
        }
    }
}
__device__ __forceinline__ void phase_final(const Params& p) {
    const Ptrs P(p.ws); const int G = (int)gridDim.x, bid = (int)blockIdx.x, tid = threadIdx.x;
    const float* gf = p.in[31]; float* X = p.out;
    for (int i = bid * 512 + tid; i < T_TOK * 256; i += G * 512) {
        const int row = i >> 8, c = (i & 255) * 4; const float rs = rs_of(P.ss5[row]);
        const u32x2 w = *(const u32x2*)(P.B0 + (size_t)row * DM + c); const f32x4 gv = *(const f32x4*)(gf + c);
        f32x4 v = (f32x4){bflo(w.x), bfhi(w.x), bflo(w.y), bfhi(w.y)};
        v = v * rs * gv; *(f32x4*)(X + (size_t)row * DM + c) = v;
    }
}

__global__ __launch_bounds__(512, 2) void fwd_mega(Params p) {
    extern __shared__ __attribute__((aligned(16))) unsigned char shm[];
    LAS unsigned char* lds = (LAS unsigned char*)shm;
    cg::grid_group grid = cg::this_grid();
    const int bid = (int)blockIdx.x, G = (int)gridDim.x;
    unsigned* bar = (unsigned*)(p.ws + S_BAR);
    volatile LAS unsigned* xst = (volatile LAS unsigned*)(lds + LDS_BYTES - 16);
    if (threadIdx.x == 0) { xst[0] = 0u; xst[1] = 0u; }
    __syncthreads();
    const XcdBarrier xb = xcd_barrier_post(bar, xst);
    if (p.ph_lo > 1000) grid.sync();
#ifndef PHMASK
#define PHMASK 0x7fff
#endif
#ifndef REPMASK
#define REPMASK 0
#endif
#define PHASE(k, body) if (((PHMASK >> (k)) & 1) && p.ph_lo <= (k) && (k) < p.ph_hi) { if ((k) > p.ph_lo) xcd_barrier(xb); { body } if ((REPMASK >> (k)) & 1) { xcd_barrier(xb); { body } } }
    PHASE(0, phase_prep(p, lds);)
    PHASE(1, { const Ptrs P(p.ws);
        run_gemm(lds, P.B0, 1024, P.w(W_13A), T_TOK, 5632, 1024, bid, EpiSwiglu{P.B1, P.ss1});
        run_gemm(lds, P.mb, 1024, P.w(W_XKV), MEMT, 2048, 1024, (bid + G / 2) % G, EpiScale{P.xkv, 2048, P.ssm, 1.0f});
        phase1_late(p, lds, P.ws); })
    PHASE(2, { const Ptrs P(p.ws);
        run_gemm(lds, P.B1, DFF, P.w(W_2A), T_TOK, 1024, DFF, bid, EpiResidB<false>{P.B0, P.B0, P.ss2, 0.5f}); })
    PHASE(3, { const Ptrs P(p.ws);
        run_gemm(lds, P.B0, 1024, P.w(W_IN), T_TOK, 4096, 1024, bid, EpiInproj{P.qbuf, P.B2, P.ss2, P.rcos, P.rsin}); })
    PHASE(4, phase_mix(p, lds);)
    PHASE(5, { const Ptrs P(p.ws);
        run_gemm(lds, P.B0, 1024, P.w(W_GG), T_TOK, 3072, 1024, bid, EpiGG{P.B3, P.B1, P.ss2, P.stats, p.in[8], p.in[19]}); })
    PHASE(6, { const Ptrs P(p.ws);
        run_gemm(lds, P.B3, 1024, P.w(W_RO), T_TOK, 1024, 1024, bid, EpiMerge<false>{(bf16_t*)p.out, P.B1}); })
    if (((PHMASK >> 7) & 1) && p.ph_lo <= 7 && 7 < p.ph_hi) { const Ptrs P(p.ws);
        run_gemm(lds, P.B4, 1024, P.w(W_LO), T_TOK, 1024, 1024, bid, EpiMerge<true>{(bf16_t*)p.out, P.B1}); }
    PHASE(8, { const Ptrs P(p.ws);
        run_gemm(lds, (const bf16_t*)p.out, 1024, P.w(W_OUT), T_TOK, 1024, 1024, bid, EpiResidB<false>{P.B0, P.B3, P.ss3, 1.0f}); })
    PHASE(9, { const Ptrs P(p.ws);
        run_gemm(lds, P.B3, 1024, P.w(W_XQ), T_TOK, 1024, 1024, bid, EpiScale{P.B4, 1024, P.ss3, 0.0625f});
        if (G == 256) {
            pg8::StaticOrder S; S.init(T_TOK, 1024, G, bid); Unit u; S.next(0, u);
            asm volatile("s_waitcnt vmcnt(0)" ::: "memory"); __syncthreads();
            xattn_pair(lds, ((u.pm >> 3) << 6) | (u.pn << 4) | ((u.pm & 7) * 2), P.B4, P.xkv, P.B0);
        } })
    if (G != 256) { PHASE(10, { const Ptrs P(p.ws);
        for (int it = bid; it < 512; it += G) xattn_item(lds, it, P.B4, P.xkv, P.B0); }) }
    PHASE(11, { const Ptrs P(p.ws);
        run_gemm(lds, P.B0, 1024, P.w(W_XO), T_TOK, 1024, 1024, bid, EpiResidB<false>{P.B3, P.B4, P.ss4, 1.0f}); })
    PHASE(12, { const Ptrs P(p.ws);
        run_gemm(lds, P.B4, 1024, P.w(W_13B), T_TOK, 5632, 1024, bid, EpiSwiglu{P.B1, P.ss4}); })
    if (G == 256) {
        PHASE(13, { const Ptrs P(p.ws);
            run_gemm(lds, P.B1, DFF, P.w(W_2B), T_TOK, 1024, DFF, bid, EpiFinal{P.B4, p.out, P.ss5, p.in[31], xb}); })
    } else {
        PHASE(13, { const Ptrs P(p.ws);
            run_gemm(lds, P.B1, DFF, P.w(W_2B), T_TOK, 1024, DFF, bid, EpiResidB<false>{P.B4, P.B0, P.ss5, 0.5f}); })
        PHASE(14, phase_final(p);)
    }
#undef PHASE
}

constexpr int N_PHASES = 15;
#ifndef DBG_HI
#define DBG_HI N_PHASES
#endif
extern "C" void kernel_launch(void* const* d_in, const int* in_sizes, int n_in, void* d_out, int out_size, void* d_ws, size_t ws_size, hipStream_t stream) {
    static int grid = 0;
    if (grid == 0) {
        if (n_in != 32 || out_size != T_TOK * DM || ws_size < WS_NEED) { fprintf(stderr, "kernel_launch: unexpected shapes (n_in %d out %d ws %zu)\n", n_in, out_size, ws_size); grid = -1; return; }
        int dev = 0, cus = 0, per_cu = 0;
        hipGetDevice(&dev); hipDeviceGetAttribute(&cus, hipDeviceAttributeMultiprocessorCount, dev);
        hipFuncSetAttribute((const void*)fwd_mega, hipFuncAttributeMaxDynamicSharedMemorySize, LDS_BYTES);
        hipOccupancyMaxActiveBlocksPerMultiprocessor(&per_cu, (const void*)fwd_mega, 512, LDS_BYTES);
        if (per_cu < 1) { fprintf(stderr, "kernel_launch: occupancy query says %d blocks/CU\n", per_cu); per_cu = 1; }
        (void)hipGetLastError();
        grid = cus;
    }
    if (grid < 0) return;
    Params p{};
    for (int i = 0; i < 32; ++i) p.in[i] = (const float*)d_in[i];
    p.out = (float*)d_out; p.ws = (unsigned char*)d_ws;
#ifndef N_CUTS
#define N_CUTS 1
#endif
    if (hipMemsetAsync((unsigned char*)d_ws + S_BAR, 0, 16384, stream) != hipSuccess) { fprintf(stderr, "kernel_launch: memset of the barrier word failed\n"); return; }
    for (int li = 0; li < N_CUTS; ++li) {
        p.ph_lo = li * DBG_HI / N_CUTS; p.ph_hi = (li + 1) * DBG_HI / N_CUTS;
        void* args[] = {&p};
        hipError_t e = hipLaunchCooperativeKernel((const void*)fwd_mega, dim3(grid), dim3(512), args, LDS_BYTES, stream);
        if (e != hipSuccess) fprintf(stderr, "cooperative launch failed: %s (grid %d)\n", hipGetErrorString(e), grid);
    }
}
```

```cpp
#include <hip/hip_runtime.h>
#include <hip/hip_cooperative_groups.h>
#include <cstdio>
namespace cg = cooperative_groups;

#define LAS __attribute__((address_space(3)))
typedef unsigned short bf16_t;
typedef short bf16x8 __attribute__((ext_vector_type(8)));
typedef short s16x4 __attribute__((ext_vector_type(4)));
typedef float f32x4 __attribute__((ext_vector_type(4)));
typedef unsigned u32x4 __attribute__((ext_vector_type(4)));
typedef unsigned u32x2 __attribute__((ext_vector_type(2)));

constexpr int T_TOK = 16384, DM = 1024, SEQ = 2048, NB = 8, DFF = 2816, MEMT = 2048;
constexpr float EPS = 1e-6f;
constexpr int LDS_BYTES = 140 * 1024;

constexpr size_t MiB = 1024 * 1024;
constexpr size_t W_13A = 0;
constexpr size_t W_2A = W_13A + (size_t)5632 * 1024 * 2;
constexpr size_t W_IN = W_2A + (size_t)1024 * 2816 * 2;
constexpr size_t W_GG = W_IN + (size_t)4096 * 1024 * 2;
constexpr size_t W_RO = W_GG + (size_t)3072 * 1024 * 2;
constexpr size_t W_LO = W_RO + (size_t)1024 * 1024 * 2;
constexpr size_t W_OUT = W_LO + (size_t)1024 * 1024 * 2;
constexpr size_t W_XQ = W_OUT + (size_t)1024 * 1024 * 2;
constexpr size_t W_XKV = W_XQ + (size_t)1024 * 1024 * 2;
constexpr size_t W_XO = W_XKV + (size_t)2048 * 1024 * 2;
constexpr size_t W_13B = W_XO + (size_t)1024 * 1024 * 2;
constexpr size_t W_2B = W_13B + (size_t)5632 * 1024 * 2;
constexpr size_t W_LRU = W_2B + (size_t)1024 * 2816 * 2;
constexpr size_t W_END = W_LRU + (size_t)2 * 1024 * 128 * 2;
static_assert(W_END <= 62 * MiB, "weights");
constexpr size_t S_SS = 62 * MiB;
constexpr size_t S_SSM = S_SS + 5 * 65536;
constexpr size_t S_STATS = S_SSM + 8192;
constexpr size_t S_COS = S_STATS + 524288;
constexpr size_t S_SIN = S_COS + 524288;
constexpr size_t S_BAR = S_SIN + 524288;
static_assert(S_BAR + 16384 <= 64 * MiB && S_BAR % 256 == 0, "small");
constexpr size_t A_MB = 64 * MiB;
constexpr size_t A_XKV = 68 * MiB;
constexpr size_t A_B0 = 76 * MiB, A_B1 = 108 * MiB, A_B2 = 140 * MiB, A_B3 = 172 * MiB, A_B4 = 204 * MiB;
constexpr size_t WS_NEED = 236 * MiB;

struct Params { const float* in[32]; float* out; unsigned char* ws; int ph_lo, ph_hi; };

typedef float f32x2v __attribute__((ext_vector_type(2)));
typedef __bf16 bf16x2v __attribute__((ext_vector_type(2)));
__device__ __forceinline__ unsigned cvt_pk_bf16(float lo, float hi) { const f32x2v v = {lo, hi}; return __builtin_bit_cast(unsigned, __builtin_convertvector(v, bf16x2v)); }
__device__ __forceinline__ float bflo(unsigned w) { return __uint_as_float(w << 16); }
__device__ __forceinline__ float bfhi(unsigned w) { return __uint_as_float(w & 0xffff0000u); }
__device__ __forceinline__ float bf2f(bf16_t b) { return __uint_as_float((unsigned)b << 16); }
__device__ __forceinline__ u32x4 pack8(const float* o) { u32x4 w; w.x = cvt_pk_bf16(o[0], o[1]); w.y = cvt_pk_bf16(o[2], o[3]); w.z = cvt_pk_bf16(o[4], o[5]); w.w = cvt_pk_bf16(o[6], o[7]); return w; }
__device__ __forceinline__ void unpack8(u32x4 w, float* o) { o[0] = bflo(w.x); o[1] = bfhi(w.x); o[2] = bflo(w.y); o[3] = bfhi(w.y); o[4] = bflo(w.z); o[5] = bfhi(w.z); o[6] = bflo(w.w); o[7] = bfhi(w.w); }
__device__ __forceinline__ float sigmoidf_(float x) { return __builtin_amdgcn_rcpf(1.0f + __expf(-x)); }
__device__ __forceinline__ void sigmoid2(float x0, float x1, float& s0, float& s1) {
    const float d0 = 1.0f + __expf(-fmaxf(x0, -40.f)), d1 = 1.0f + __expf(-fmaxf(x1, -40.f)); const float r = __builtin_amdgcn_rcpf(d0 * d1); s0 = r * d1; s1 = r * d0; }
__device__ __forceinline__ float rs_of(float ss) { return rsqrtf(ss * (1.0f / 1024.0f) + EPS); }
__device__ __forceinline__ void lds_barrier() { asm volatile("s_waitcnt lgkmcnt(0)" ::: "memory"); __builtin_amdgcn_s_barrier(); asm volatile("" ::: "memory"); }

namespace pg8 {
constexpr int BM = 256, BK = 64, HALF = 128, HTB = HALF * BK * 2, STAGE_BYTES = 8 * HTB, NXCD = 8, WGM = 8;
__host__ __device__ __forceinline__ int lds_byte(int r, int c) { const int st = (r >> 4) * 2 + (c >> 5), rr = r & 15, cc = c & 31, ob = rr * 64 + cc * 2; return st * 1024 + (ob ^ (((ob >> 9) & 1) << 5)); }
__host__ __device__ __forceinline__ void stage_rc(int b, int& R, int& C) { const int st = b / 1024, sb = b % 1024, swz = sb ^ (((sb >> 9) & 1) << 5); R = (st >> 1) * 16 + swz / 64; C = (st & 1) * 32 + (swz % 64) / 2; }
__host__ __device__ __forceinline__ int perm32(int rho) { const int n = rho >> 4, i = rho & 15; return 8 * (i >> 2) + 4 * n + (i & 3); }
struct Unit { int pm, pn; };
struct Gemm { const bf16_t* A; const bf16_t* Bt; int M, N, K, lda, ldb; };
struct StaticOrder {
    int nM, nN, nwg, G, c;
    __device__ __forceinline__ void init(int M, int N, int G_, int c_) { nM = M / BM; nN = N / BM; nwg = nM * nN; G = G_; c = c_; }
    __device__ __forceinline__ bool next(int i, Unit& u) const {
        const long L = (long)i * G + c; if (L >= nwg) return false;
        int wgid = (int)L; { const int q = nwg / NXCD, r = nwg % NXCD, xcd = wgid % NXCD, off = wgid / NXCD; wgid = (xcd < r ? xcd * (q + 1) : r * (q + 1) + (xcd - r) * q) + off; }
        const int nig = WGM * nN, gid = wgid / nig, fm = gid * WGM, gsz = (nM - fm) < WGM ? (nM - fm) : WGM;
        u.pm = fm + ((wgid % nig) % gsz); u.pn = (wgid % nig) / gsz; return true;
    }
};
template <class Epi>
__device__ __forceinline__ void gemm_phase(LAS unsigned char* lds, const Gemm g, const StaticOrder& S, const Epi& E) {
    const int tid = threadIdx.x, wid = __builtin_amdgcn_readfirstlane(tid >> 6), lane = tid & 63, wr = wid >> 2, wc = wid & 3, fr = lane & 15, fq = lane >> 4;
    const int K = g.K, nt = K / BK;
    unsigned voffA[2], voffB[2];
#pragma unroll
    for (int i = 0; i < 2; ++i) { int R, C; stage_rc(tid * 16 + i * 8192, R, C); const int Rb = Epi::PERM ? ((R & ~31) + perm32(R & 31)) : R;
        voffA[i] = (unsigned)(R * g.lda + C) * 2u; voffB[i] = (unsigned)(Rb * g.ldb + C) * 2u; }
    const size_t kstep = (size_t)(BK * 2);
    const size_t hstepA = (size_t)HALF * g.lda * 2, hstepB = (size_t)HALF * g.ldb * 2;
    const size_t tstepA = 2 * hstepA, tstepB = 2 * hstepB;
    const unsigned ldsw = (unsigned)wid * 1024u;
    const int aoff = lds_byte(wr * 64 + fr, fq * 8), boff = lds_byte(wc * 32 + fr, fq * 8);
#define PG8_SA(b, h) (((b) * 2 + (h)) * HTB)
#define PG8_SB(b, h) ((4 + (b) * 2 + (h)) * HTB)
#define PG8_STAGE(bufoff, gbase, voff) do { _Pragma("unroll") for (int _i = 0; _i < 2; ++_i) \
        __builtin_amdgcn_global_load_lds((const unsigned*)((const char*)(gbase) + (voff)[_i]), (LAS unsigned*)(lds + (bufoff) + ldsw + _i * 8192), 16, 0, 0); } while (0)
#define PG8_LDA(dst, b, h) do { _Pragma("unroll") for (int m = 0; m < 4; ++m) _Pragma("unroll") for (int k = 0; k < 2; ++k) dst[m][k] = *(const LAS bf16x8*)(lds + PG8_SA(b, h) + aoff + m * 2048 + k * 1024); } while (0)
#define PG8_LDB(dst, b, h) do { _Pragma("unroll") for (int n = 0; n < 2; ++n) _Pragma("unroll") for (int k = 0; k < 2; ++k) dst[n][k] = *(const LAS bf16x8*)(lds + PG8_SB(b, h) + boff + n * 2048 + k * 1024); } while (0)
#define PG8_MMA(ai, bj, At, Bt) do { __builtin_amdgcn_s_setprio(1); _Pragma("unroll") for (int m = 0; m < 4; ++m) _Pragma("unroll") for (int n = 0; n < 2; ++n) _Pragma("unroll") for (int k = 0; k < 2; ++k) \
        acc[ai][bj][m][n] = __builtin_amdgcn_mfma_f32_16x16x32_bf16(Bt[n][k], At[m][k], acc[ai][bj][m][n], 0, 0, 0); __builtin_amdgcn_s_setprio(0); } while (0)
#define PG8_WAIT_V(n) asm volatile("s_waitcnt vmcnt(" #n ")" ::: "memory")
#define PG8_WAIT_L(n) asm volatile("s_waitcnt lgkmcnt(" #n ")" ::: "memory")
#define PG8_BAR __builtin_amdgcn_s_barrier()
#define PG8_SCHED __builtin_amdgcn_sched_barrier(0)
    Unit cur, nxt; int ui = 0;
    if (!S.next(0, cur)) return;
    f32x4 acc[2][2][4][2];
#pragma unroll
    for (int a = 0; a < 2; ++a)
#pragma unroll
        for (int b = 0; b < 2; ++b)
#pragma unroll
            for (int m = 0; m < 4; ++m)
#pragma unroll
                for (int n = 0; n < 2; ++n) acc[a][b][m][n] = (f32x4){0.f, 0.f, 0.f, 0.f};
    bf16x8 At[4][2], B0[2][2], B1[2][2];
    const char* cA = (const char*)g.A + (size_t)cur.pm * tstepA; const char* cB = (const char*)g.Bt + (size_t)cur.pn * tstepB;
    PG8_STAGE(PG8_SB(0, 0), cB, voffB); PG8_STAGE(PG8_SA(0, 0), cA, voffA); PG8_STAGE(PG8_SB(0, 1), cB + hstepB, voffB); PG8_STAGE(PG8_SA(0, 1), cA + hstepA, voffA);
    if (wr == 1) PG8_BAR;
    PG8_WAIT_V(4); PG8_BAR;
    PG8_STAGE(PG8_SB(1, 0), cB + kstep, voffB); PG8_STAGE(PG8_SA(1, 0), cA + kstep, voffA); PG8_STAGE(PG8_SB(1, 1), cB + hstepB + kstep, voffB);
    PG8_WAIT_V(6); PG8_BAR;
    for (;;) {
        const bool has_next = S.next(ui + 1, nxt);
        const char* nA = has_next ? (const char*)g.A + (size_t)nxt.pm * tstepA : cA; const char* nB = has_next ? (const char*)g.Bt + (size_t)nxt.pn * tstepB : cB;
        for (int t = 0; t < nt; t += 2) {
            const bool last = (t == nt - 2);
            const char* a1 = cA + (size_t)(t + 1) * kstep;
            const char* a2 = last ? nA : cA + (size_t)(t + 2) * kstep; const char* b2 = last ? nB : cB + (size_t)(t + 2) * kstep;
            const char* a3 = a2 + kstep; const char* b3 = b2 + kstep;
            PG8_LDB(B0, 0, 0); PG8_SCHED; PG8_LDA(At, 0, 0); PG8_STAGE(PG8_SA(1, 1), a1 + hstepA, voffA);
            PG8_WAIT_L(8); PG8_BAR; PG8_WAIT_L(0); PG8_MMA(0, 0, At, B0); PG8_BAR; PG8_SCHED;
            PG8_LDB(B1, 0, 1); PG8_STAGE(PG8_SB(0, 0), b2, voffB);
            PG8_BAR; PG8_WAIT_L(0); PG8_MMA(0, 1, At, B1); PG8_BAR;
            PG8_LDA(At, 0, 1); PG8_STAGE(PG8_SA(0, 0), a2, voffA);
            PG8_BAR; PG8_WAIT_L(0); PG8_MMA(1, 0, At, B0); PG8_BAR; PG8_SCHED;
            PG8_STAGE(PG8_SB(0, 1), b2 + hstepB, voffB);
            PG8_WAIT_V(6); PG8_BAR; PG8_MMA(1, 1, At, B1); PG8_BAR;
            PG8_LDB(B0, 1, 0); PG8_SCHED; PG8_LDA(At, 1, 0); PG8_STAGE(PG8_SA(0, 1), a2 + hstepA, voffA);
            PG8_WAIT_L(8); PG8_BAR; PG8_WAIT_L(0); PG8_MMA(0, 0, At, B0); PG8_BAR; PG8_SCHED;
            PG8_LDB(B1, 1, 1); PG8_STAGE(PG8_SB(1, 0), b3, voffB);
            PG8_BAR; PG8_WAIT_L(0); PG8_MMA(0, 1, At, B1); PG8_BAR;
            PG8_LDA(At, 1, 1); PG8_STAGE(PG8_SA(1, 0), a3, voffA);
            PG8_BAR; PG8_WAIT_L(0); PG8_MMA(1, 0, At, B0); PG8_BAR; PG8_SCHED;
            PG8_STAGE(PG8_SB(1, 1), b3 + hstepB, voffB);
            PG8_WAIT_V(6); PG8_BAR; PG8_MMA(1, 1, At, B1); PG8_BAR;
        }
        if constexpr (!Epi::AFTER_DRAIN) E(acc, cur, wr, wc, fr, fq);
        if (!has_next) break;
#pragma unroll
        for (int a = 0; a < 2; ++a)
#pragma unroll
            for (int b = 0; b < 2; ++b)
#pragma unroll
                for (int m = 0; m < 4; ++m)
#pragma unroll
                    for (int n = 0; n < 2; ++n) acc[a][b][m][n] = (f32x4){0.f, 0.f, 0.f, 0.f};
        cur = nxt; cA = nA; cB = nB; ++ui;
    }
    PG8_WAIT_V(0);
    if (wr == 0) PG8_BAR;
    PG8_BAR;
    if constexpr (Epi::AFTER_DRAIN) E.fused(acc, cur, wr, wc, fr, fq);
#undef PG8_SA
#undef PG8_SB
#undef PG8_STAGE
#undef PG8_LDA
#undef PG8_LDB
#undef PG8_MMA
#undef PG8_WAIT_V
#undef PG8_WAIT_L
#undef PG8_BAR
#undef PG8_SCHED
}
}
using pg8::Unit;
typedef f32x4 AccT[2][2][4][2];

#define XB_TMO      128
#define XB_XCNT(j)  (256  + 64 * (j))
#define XB_XSUB(j)  (1280 + 64 * (j))
#define XB_XGEN(j)  (2304 + 64 * (j))
#define XB_TOP      3328
#define XB_TOPGEN   3392
#define XCD_BAR_WORDS 3456
#define XB_SPIN_CAP (1u << 18)

__device__ __forceinline__ unsigned xb_ld(unsigned* p)              { return __hip_atomic_load(p, __ATOMIC_RELAXED, __HIP_MEMORY_SCOPE_AGENT); }
__device__ __forceinline__ unsigned xb_add(unsigned* p, unsigned v) { return __hip_atomic_fetch_add(p, v, __ATOMIC_RELAXED, __HIP_MEMORY_SCOPE_AGENT); }
__device__ __forceinline__ unsigned xb_xcc_id() { return (unsigned)__builtin_amdgcn_s_getreg((3 << 11) | 20) & 0xFu; }
#define XB_SPIN(cond, bar) do { unsigned _sp = 0; while (cond) { __builtin_amdgcn_s_sleep(1); \
    if ((++_sp & 255u) == 0u) { if (xb_ld(&(bar)[XB_TMO])) break; if (_sp > XB_SPIN_CAP) { atomicAdd(&(bar)[XB_TMO], 1u); break; } } } } while (0)

struct XcdBarrier {
    unsigned* bar; unsigned x;
    volatile LAS unsigned* st;
};

__device__ __forceinline__ XcdBarrier xcd_barrier_post(unsigned* bar, volatile LAS unsigned* st) {
    XcdBarrier b; b.bar = bar; b.x = xb_xcc_id(); b.st = st;
    if (threadIdx.x == 0) (void)xb_add(&bar[XB_XCNT(b.x)], 1u);
    return b;
}
__device__ __forceinline__ void xcd_barrier_complete(unsigned* bar, unsigned x, unsigned& nloc, unsigned& nx) {
    const unsigned G = gridDim.x * gridDim.y * gridDim.z;
    unsigned sum, cnt, mine, sp = 0u;
    for (;;) {
        sum = 0u; cnt = 0u; mine = 0u;
#pragma unroll
        for (unsigned j = 0; j < 16; ++j) { const unsigned c = xb_ld(&bar[XB_XCNT(j)]); sum += c; cnt += (c > 0u) ? 1u : 0u; mine = (j == x) ? c : mine; }
        if (sum == G) break;
        __builtin_amdgcn_s_sleep(1);
        if ((++sp & 255u) == 0u) { if (xb_ld(&bar[XB_TMO])) break; if (sp > XB_SPIN_CAP) { atomicAdd(&bar[XB_TMO], 1u); break; } }
    }
    nloc = mine > 0u ? mine : 1u; nx = cnt > 0u ? cnt : 1u;
}

__device__ __forceinline__ void xcd_barrier(const XcdBarrier& b) {
    asm volatile("s_waitcnt vmcnt(0)" ::: "memory");
    __syncthreads();
    if (threadIdx.x == 0) {
        unsigned* bar = b.bar;
        __builtin_amdgcn_s_waitcnt(0);
        unsigned nloc = b.st[0], nx = b.st[1];
        if (nloc == 0u) { xcd_barrier_complete(bar, b.x, nloc, nx); b.st[0] = nloc; b.st[1] = nx; }
        const unsigned old = xb_add(&bar[XB_XSUB(b.x)], 1u);
        const unsigned gen = old / nloc;
        if (old + 1u == (gen + 1u) * nloc) {
            __builtin_amdgcn_fence(__ATOMIC_RELEASE, "agent");
            asm volatile("s_waitcnt vmcnt(0)" ::: "memory");
            const unsigned og = xb_add(&bar[XB_TOP], 1u);
            const unsigned tg = og / nx;
            if (og + 1u == (tg + 1u) * nx) xb_add(&bar[XB_TOPGEN], 1u);
            else XB_SPIN(xb_ld(&bar[XB_TOPGEN]) == tg, bar);
            __builtin_amdgcn_fence(__ATOMIC_ACQUIRE, "agent");
            xb_add(&bar[XB_XGEN(b.x)], 1u);
            asm volatile("s_waitcnt vmcnt(0)" ::: "memory");
        } else {
            XB_SPIN(xb_ld(&bar[XB_XGEN(b.x)]) == gen, bar);
            __builtin_amdgcn_fence(__ATOMIC_ACQUIRE, "agent");
            asm volatile("s_waitcnt vmcnt(0)" ::: "memory");
        }
    }
    __syncthreads();
}


struct EpiSwiglu {
    static constexpr bool PERM = true, AFTER_DRAIN = false;
    bf16_t* G; const float* ss;
    __device__ __forceinline__ void operator()(const AccT& acc, const Unit& u, int wr, int wc, int fr, int fq) const {
        const int row0 = u.pm * 256 + wr * 64 + fr, col0 = u.pn * 128 + wc * 32 + 8 * fq;
#pragma unroll
        for (int ai = 0; ai < 2; ++ai)
#pragma unroll
            for (int m = 0; m < 4; ++m) {
                const int row = row0 + ai * 128 + m * 16; const float rs = rs_of(ss[row]); float o[8];
#pragma unroll
                for (int n = 0; n < 2; ++n)
#pragma unroll
                    for (int j = 0; j < 4; j += 2) {
                        const float a1 = acc[ai][0][m][n][j] * rs, b1 = acc[ai][0][m][n][j + 1] * rs;
                        const float d0 = 1.0f + __expf(-fmaxf(a1, -40.f)), d1 = 1.0f + __expf(-fmaxf(b1, -40.f));
                        const float r = __builtin_amdgcn_rcpf(d0 * d1);
                        o[4 * n + j] = a1 * (r * d1) * (acc[ai][1][m][n][j] * rs); o[4 * n + j + 1] = b1 * (r * d0) * (acc[ai][1][m][n][j + 1] * rs); }
                *(u32x4*)(G + (size_t)row * DFF + col0) = pack8(o);
            }
    }
};
template <bool WB> struct EpiResid {
    static constexpr bool PERM = true, AFTER_DRAIN = false;
    const float* base; float* X; bf16_t* Xb; float* ss; float scale;
    __device__ __forceinline__ void operator()(const AccT& acc, const Unit& u, int wr, int wc, int fr, int fq) const {
        const int row0 = u.pm * 256 + wr * 64 + fr, col0 = u.pn * 256 + wc * 32 + 8 * fq;
#pragma unroll
        for (int ai = 0; ai < 2; ++ai)
#pragma unroll
            for (int m = 0; m < 4; ++m) {
                const int row = row0 + ai * 128 + m * 16; float sq = 0.f;
#pragma unroll
                for (int bj = 0; bj < 2; ++bj) {
                    const size_t off = (size_t)row * DM + col0 + bj * 128;
                    const f32x4 b0 = *(const f32x4*)(base + off), b1 = *(const f32x4*)(base + off + 4);
                    const f32x4 v0 = b0 + scale * acc[ai][bj][m][0], v1 = b1 + scale * acc[ai][bj][m][1];
                    *(f32x4*)(X + off) = v0; *(f32x4*)(X + off + 4) = v1;
                    sq += (v0[0] * v0[0] + v0[1] * v0[1]) + (v0[2] * v0[2] + v0[3] * v0[3]) + (v1[0] * v1[0] + v1[1] * v1[1]) + (v1[2] * v1[2] + v1[3] * v1[3]);
                    if (WB) { u32x4 w; w.x = cvt_pk_bf16(v0[0], v0[1]); w.y = cvt_pk_bf16(v0[2], v0[3]); w.z = cvt_pk_bf16(v1[0], v1[1]); w.w = cvt_pk_bf16(v1[2], v1[3]); *(u32x4*)(Xb + off) = w; }
                }
                sq += __shfl_xor(sq, 16); sq += __shfl_xor(sq, 32);
                if (fq == 0) unsafeAtomicAdd(ss + row, sq);
            }
    }
};
template <bool BASE_F32> struct EpiResidB {
    static constexpr bool PERM = true, AFTER_DRAIN = false;
    const void* base; bf16_t* Xb; float* ss; float scale;
    __device__ __forceinline__ void operator()(const AccT& acc, const Unit& u, int wr, int wc, int fr, int fq) const {
        const int row0 = u.pm * 256 + wr * 64 + fr, col0 = u.pn * 256 + wc * 32 + 8 * fq;
#pragma unroll
        for (int ai = 0; ai < 2; ++ai)
#pragma unroll
            for (int m = 0; m < 4; ++m) {
                const int row = row0 + ai * 128 + m * 16; float sq = 0.f;
#pragma unroll
                for (int bj = 0; bj < 2; ++bj) {
                    const size_t off = (size_t)row * DM + col0 + bj * 128; float bv[8];
                    if (BASE_F32) { const f32x4 b0 = *(const f32x4*)((const float*)base + off), b1 = *(const f32x4*)((const float*)base + off + 4);
#pragma unroll
                        for (int j = 0; j < 4; ++j) { bv[j] = b0[j]; bv[4 + j] = b1[j]; } }
                    else unpack8(*(const u32x4*)((const bf16_t*)base + off), bv);
                    float o[8];
#pragma unroll
                    for (int n = 0; n < 2; ++n)
#pragma unroll
                        for (int j = 0; j < 4; ++j) { const float v = bv[4 * n + j] + scale * acc[ai][bj][m][n][j]; o[4 * n + j] = v; sq += v * v; }
                    *(u32x4*)(Xb + off) = pack8(o);
                }
                sq += __shfl_xor(sq, 16); sq += __shfl_xor(sq, 32);
                if (fq == 0) unsafeAtomicAdd(ss + row, sq);
            }
    }
};
struct EpiInproj {
    static constexpr bool PERM = true, AFTER_DRAIN = false;
    bf16_t *q, *xl; const float *ss, *cs, *sn;
    __device__ __forceinline__ void operator()(const AccT& acc, const Unit& u, int wr, int wc, int fr, int fq) const {
        const int row0 = u.pm * 256 + wr * 64 + fr, p0 = wc * 32 + 8 * fq, pn = u.pn;
        if (pn < 4) {
            bf16_t* dst = q + (size_t)(pn >> 1) * ((size_t)T_TOK * 512); const float sc = pn < 2 ? 1.0f : 0.08838834764831845f;
            const int head = 2 * (pn & 1) + (p0 >> 6), d0 = p0 & 63;
#pragma unroll
            for (int ai = 0; ai < 2; ++ai)
#pragma unroll
                for (int m = 0; m < 4; ++m) {
                    const int row = row0 + ai * 128 + m * 16; const float rs = rs_of(ss[row]) * sc; const int pos = row & (SEQ - 1);
                    const float* cp = cs + pos * 64 + d0; const float* sp = sn + pos * 64 + d0;
                    bf16_t* dp = dst + (size_t)row * 512 + head * 128 + d0;
#pragma unroll
                    for (int n = 0; n < 2; ++n) {
                        const f32x4 c = *(const f32x4*)(cp + 4 * n), s = *(const f32x4*)(sp + 4 * n);
                        const f32x4 t1 = acc[ai][0][m][n] * rs, t2 = acc[ai][1][m][n] * rs;
                        const f32x4 o1 = t1 * c - t2 * s, o2 = t2 * c + t1 * s;
                        u32x2 w1, w2; w1.x = cvt_pk_bf16(o1[0], o1[1]); w1.y = cvt_pk_bf16(o1[2], o1[3]); w2.x = cvt_pk_bf16(o2[0], o2[1]); w2.y = cvt_pk_bf16(o2[2], o2[3]);
                        *(u32x2*)(dp + 4 * n) = w1; *(u32x2*)(dp + 64 + 4 * n) = w2;
                    }
                }
        } else {
            const int seg = (pn - 4) >> 2; bf16_t* dst = xl + (size_t)seg * ((size_t)T_TOK * DM); const int colb = ((pn - 4) & 3) * 256 + p0;
#pragma unroll
            for (int ai = 0; ai < 2; ++ai)
#pragma unroll
                for (int m = 0; m < 4; ++m) {
                    const int row = row0 + ai * 128 + m * 16; const float rs = rs_of(ss[row]);
#pragma unroll
                    for (int bj = 0; bj < 2; ++bj) {
                        float o[8];
#pragma unroll
                        for (int n = 0; n < 2; ++n)
#pragma unroll
                            for (int j = 0; j < 4; j += 2) { float a = acc[ai][bj][m][n][j] * rs, b = acc[ai][bj][m][n][j + 1] * rs;
                                if (seg == 2) { const float ua = 1.5957691216057308f * (a + 0.044715f * a * a * a), ub = 1.5957691216057308f * (b + 0.044715f * b * b * b);
                                    float sa, sb; sigmoid2(ua, ub, sa, sb); a *= sa; b *= sb; }
                                o[4 * n + j] = a; o[4 * n + j + 1] = b; }
                        *(u32x4*)(dst + (size_t)row * DM + colb + bj * 128) = pack8(o);
                    }
                }
        }
    }
};
struct EpiGG {
    static constexpr bool PERM = true, AFTER_DRAIN = false;
    bf16_t* aret; bf16_t* gates; const float *ss, *stats, *gn, *bg;
    __device__ __forceinline__ void operator()(const AccT& acc, const Unit& u, int wr, int wc, int fr, int fq) const {
        const int row0 = u.pm * 256 + wr * 64 + fr, p0 = wc * 32 + 8 * fq, pn = u.pn;
        if (pn < 4) {
#pragma unroll
            for (int ai = 0; ai < 2; ++ai)
#pragma unroll
                for (int m = 0; m < 4; ++m) {
                    const int row = row0 + ai * 128 + m * 16; const float rs = rs_of(ss[row]);
                    const float s1 = stats[((size_t)row * 4 + pn) * 2], s2 = stats[((size_t)row * 4 + pn) * 2 + 1];
                    const float mu = s1 * (1.0f / 256.0f); const float var = fmaxf(s2 * (1.0f / 256.0f) - mu * mu, 0.f); const float rstd = rsqrtf(var + EPS);
#pragma unroll
                    for (int bj = 0; bj < 2; ++bj) {
                        const int col = pn * 256 + bj * 128 + p0; bf16_t* rp = aret + (size_t)row * DM + col;
                        float r[8], o[8]; unpack8(*(const u32x4*)rp, r);
                        const f32x4 g0 = *(const f32x4*)(gn + col), g1 = *(const f32x4*)(gn + col + 4);
#pragma unroll
                        for (int n = 0; n < 2; ++n)
#pragma unroll
                            for (int j = 0; j < 4; j += 2) { const float a = acc[ai][bj][m][n][j] * rs, b = acc[ai][bj][m][n][j + 1] * rs; float sa, sb; sigmoid2(a, b, sa, sb);
                                o[4 * n + j] = a * sa * (n ? g1[j] : g0[j]) * (r[4 * n + j] - mu) * rstd; o[4 * n + j + 1] = b * sb * (n ? g1[j + 1] : g0[j + 1]) * (r[4 * n + j + 1] - mu) * rstd; }
                        *(u32x4*)rp = pack8(o);
                    }
                }
        } else {
#pragma unroll
            for (int ai = 0; ai < 2; ++ai)
#pragma unroll
                for (int m = 0; m < 4; ++m) {
                    const int row = row0 + ai * 128 + m * 16; const float rs = rs_of(ss[row]);
#pragma unroll
                    for (int bj = 0; bj < 2; ++bj) {
                        const int col = (pn - 4) * 256 + bj * 128 + p0; float o[8];
                        const f32x4 b0 = *(const f32x4*)(bg + col), b1 = *(const f32x4*)(bg + col + 4);
#pragma unroll
                        for (int n = 0; n < 2; ++n)
#pragma unroll
                            for (int j = 0; j < 4; j += 2) sigmoid2(acc[ai][bj][m][n][j] * rs + (n ? b1[j] : b0[j]), acc[ai][bj][m][n][j + 1] * rs + (n ? b1[j + 1] : b0[j + 1]), o[4 * n + j], o[4 * n + j + 1]);
                        *(u32x4*)(gates + (size_t)row * 2048 + col) = pack8(o);
                    }
                }
        }
    }
};
template <bool SECOND> struct EpiMerge {
    static constexpr bool PERM = true, AFTER_DRAIN = false;
    bf16_t* merged; const bf16_t* gates;
    __device__ __forceinline__ void operator()(const AccT& acc, const Unit& u, int wr, int wc, int fr, int fq) const {
        const int row0 = u.pm * 256 + wr * 64 + fr, col0 = u.pn * 256 + wc * 32 + 8 * fq;
#pragma unroll
        for (int ai = 0; ai < 2; ++ai)
#pragma unroll
            for (int m = 0; m < 4; ++m) {
                const int row = row0 + ai * 128 + m * 16;
#pragma unroll
                for (int bj = 0; bj < 2; ++bj) {
                    const int col = col0 + bj * 128; float g[8], o[8];
                    unpack8(*(const u32x4*)(gates + (size_t)row * 2048 + (SECOND ? 1024 : 0) + col), g);
                    bf16_t* mp = merged + (size_t)row * DM + col;
                    if (SECOND) unpack8(*(const u32x4*)mp, o);
#pragma unroll
                    for (int n = 0; n < 2; ++n)
#pragma unroll
                        for (int j = 0; j < 4; ++j) { const float t = g[4 * n + j] * acc[ai][bj][m][n][j]; o[4 * n + j] = SECOND ? o[4 * n + j] + t : t; }
                    *(u32x4*)mp = pack8(o);
                }
            }
    }
};
struct EpiScale {
    static constexpr bool PERM = true, AFTER_DRAIN = false;
    bf16_t* O; int ldc; const float* ss; float sc;
    __device__ __forceinline__ void operator()(const AccT& acc, const Unit& u, int wr, int wc, int fr, int fq) const {
        const int row0 = u.pm * 256 + wr * 64 + fr, col0 = u.pn * 256 + wc * 32 + 8 * fq;
#pragma unroll
        for (int ai = 0; ai < 2; ++ai)
#pragma unroll
            for (int m = 0; m < 4; ++m) {
                const int row = row0 + ai * 128 + m * 16; const float rs = rs_of(ss[row]) * sc;
#pragma unroll
                for (int bj = 0; bj < 2; ++bj) { float o[8];
#pragma unroll
                    for (int n = 0; n < 2; ++n)
#pragma unroll
                        for (int j = 0; j < 4; ++j) o[4 * n + j] = acc[ai][bj][m][n][j] * rs;
                    *(u32x4*)(O + (size_t)row * ldc + col0 + bj * 128) = pack8(o); }
            }
    }
};

struct EpiFinal {
    static constexpr bool PERM = true, AFTER_DRAIN = true;
    const bf16_t* base; float* X; float* ss; const float* gfin; XcdBarrier xb;
    __device__ __forceinline__ void fused(AccT& acc, const Unit& u, int wr, int wc, int fr, int fq) const {
        const int row0 = u.pm * 256 + wr * 64 + fr, col0 = u.pn * 256 + wc * 32 + 8 * fq;
#pragma unroll
        for (int ai = 0; ai < 2; ++ai)
#pragma unroll
            for (int m = 0; m < 4; ++m) {
                const int row = row0 + ai * 128 + m * 16; float sq = 0.f;
#pragma unroll
                for (int bj = 0; bj < 2; ++bj) {
                    const size_t off = (size_t)row * DM + col0 + bj * 128;
                    float bv[8]; unpack8(*(const u32x4*)(base + off), bv);
                    const f32x4 v0 = (f32x4){bv[0], bv[1], bv[2], bv[3]} + 0.5f * acc[ai][bj][m][0], v1 = (f32x4){bv[4], bv[5], bv[6], bv[7]} + 0.5f * acc[ai][bj][m][1];
                    acc[ai][bj][m][0] = v0; acc[ai][bj][m][1] = v1;
                    sq += (v0[0] * v0[0] + v0[1] * v0[1]) + (v0[2] * v0[2] + v0[3] * v0[3]) + (v1[0] * v1[0] + v1[1] * v1[1]) + (v1[2] * v1[2] + v1[3] * v1[3]);
                }
                sq += __shfl_xor(sq, 16); sq += __shfl_xor(sq, 32);
                if (fq == 0) unsafeAtomicAdd(ss + row, sq);
            }
        xcd_barrier(xb);
#pragma unroll
        for (int ai = 0; ai < 2; ++ai)
#pragma unroll
            for (int m = 0; m < 4; ++m) {
                const int row = row0 + ai * 128 + m * 16; const float rs = rs_of(ss[row]);
#pragma unroll
                for (int bj = 0; bj < 2; ++bj) {
                    const size_t off = (size_t)row * DM + col0 + bj * 128; const int col = col0 + bj * 128;
                    const f32x4 g0 = *(const f32x4*)(gfin + col), g1 = *(const f32x4*)(gfin + col + 4);
                    *(f32x4*)(X + off) = acc[ai][bj][m][0] * rs * g0; *(f32x4*)(X + off + 4) = acc[ai][bj][m][1] * rs * g1;
                }
            }
    }
};
struct RowSrc { const float* p; int ld; };
template <class F>
__device__ __forceinline__ void wprep(LAS unsigned char* lds, bf16_t* dst, int nrows, int K, const float* gain, F rowsrc, int b0 = (int)blockIdx.x, int nb = (int)gridDim.x) {
    LAS float* tile = (LAS float*)lds;
    const int tid = threadIdx.x, kk = tid >> 4, r4 = (tid & 15) * 4;
    const int ntk = K / 128, ntiles = (nrows / 64) * ntk;
    f32x4 cur[4], nxt[4];
    auto fetch = [&](int t, f32x4 (&v)[4]) {
        const int r0 = (t / ntk) * 64, k0 = (t % ntk) * 128; const RowSrc rs = rowsrc(r0 + r4);
#pragma unroll
        for (int it = 0; it < 4; ++it) { const int k = k0 + kk + 32 * it; f32x4 x = *(const f32x4*)(rs.p + (size_t)k * rs.ld); if (gain) x *= gain[k]; v[it] = x; }
    };
    int t = b0;
    if (t < ntiles) fetch(t, cur);
    for (; t < ntiles; t += nb) {
        const int tn = t + nb;
        if (tn < ntiles) fetch(tn, nxt);
        const int r0 = (t / ntk) * 64, k0 = (t % ntk) * 128;
        __syncthreads();
#pragma unroll
        for (int it = 0; it < 4; ++it)
#pragma unroll
            for (int j = 0; j < 4; ++j) tile[(r4 + j) * 129 + kk + 32 * it] = cur[it][j];
        __syncthreads();
        const int row = tid >> 3, ch = tid & 7;
#pragma unroll
        for (int hf = 0; hf < 2; ++hf) { float o[8];
#pragma unroll
            for (int j = 0; j < 8; ++j) o[j] = tile[row * 129 + hf * 64 + ch * 8 + j];
            *(u32x4*)(dst + (size_t)(r0 + row) * K + k0 + hf * 64 + ch * 8) = pack8(o); }
#pragma unroll
        for (int it = 0; it < 4; ++it) cur[it] = nxt[it];
    }
    __syncthreads();
}

__device__ __forceinline__ void rows_prep(const float* src, bf16_t* dst, float* ss, int nrows) {
    const int lane = threadIdx.x & 63, gw = blockIdx.x * 8 + (threadIdx.x >> 6), nw = gridDim.x * 8;
    for (int r = gw; r < nrows; r += nw) {
        const float* sp = src + (size_t)r * DM; float sq = 0.f;
#pragma unroll
        for (int i = 0; i < 2; ++i) {
            const int c = (i * 64 + lane) * 8;
            const f32x4 a = *(const f32x4*)(sp + c), b = *(const f32x4*)(sp + c + 4);
            sq += (a[0] * a[0] + a[1] * a[1]) + (a[2] * a[2] + a[3] * a[3]) + (b[0] * b[0] + b[1] * b[1]) + (b[2] * b[2] + b[3] * b[3]);
            u32x4 w; w.x = cvt_pk_bf16(a[0], a[1]); w.y = cvt_pk_bf16(a[2], a[3]); w.z = cvt_pk_bf16(b[0], b[1]); w.w = cvt_pk_bf16(b[2], b[3]);
            *(u32x4*)(dst + (size_t)r * DM + c) = w;
        }
#pragma unroll
        for (int o = 32; o >= 1; o >>= 1) sq += __shfl_xor(sq, o);
        if (lane == 0) ss[r] = sq;
    }
}

__device__ __forceinline__ bf16x8 tr_frag(LAS unsigned char* tile, int stride, int k0, int x0, int lane) {
    const int g = lane >> 4, ii = lane & 15, q = ii >> 2, p = ii & 3;
    LAS unsigned char* a = tile + (k0 + 8 * g + q) * stride + (x0 + 4 * p) * 2;
    const s16x4 lo = __builtin_amdgcn_ds_read_tr16_b64_v4i16((LAS s16x4*)a);
    const s16x4 hi = __builtin_amdgcn_ds_read_tr16_b64_v4i16((LAS s16x4*)(a + 4 * stride));
    bf16x8 r; r[0] = lo[0]; r[1] = lo[1]; r[2] = lo[2]; r[3] = lo[3]; r[4] = hi[0]; r[5] = hi[1]; r[6] = hi[2]; r[7] = hi[3]; return r;
}
__device__ __forceinline__ bf16x8 scale_frag(bf16x8 f, const float* s) {
    u32x4 w = __builtin_bit_cast(u32x4, f); float o[8]; unpack8(w, o);
#pragma unroll
    for (int j = 0; j < 8; ++j) o[j] *= s[j];
    return __builtin_bit_cast(bf16x8, pack8(o));
}

constexpr int R_KT = 0, R_KS = 272;
constexpr int R_VT = 128 * 272, R_VS = 144;
constexpr int R_SB = R_VT + 128 * 144;
constexpr int R_PW = R_SB + 128 * 144;
static_assert(R_PW + 8 * 16 * 272 <= LDS_BYTES, "ret lds");
__device__ __forceinline__ void retention_item(LAS unsigned char* lds, int item, const bf16_t* qb, const bf16_t* kb, bf16_t* vb  , float* stats) {
    int tid = threadIdx.x; asm volatile("" : "+v"(tid));
    const int wid = tid >> 6, lane = tid & 63, fr = lane & 15, fg = lane >> 4;
    const int widu = __builtin_amdgcn_readfirstlane(tid >> 6);
    const int b = item >> 4, h = (item >> 2) & 3, es = item & 3;
    const float l2g = __log2f(1.0f - exp2f(-5.0f - (float)h));
    const float cd = exp2f(128.0f * l2g);
    const size_t tok0 = (size_t)b * SEQ;
    LAS unsigned char* Pw = lds + R_PW + wid * (16 * 272);
    f32x4 st[4];
#pragma unroll
    for (int e = 0; e < 4; ++e) st[e] = (f32x4){0.f, 0.f, 0.f, 0.f};
    u32x4 kreg[4], vreg[2], qnext[4], qf[4];
    auto issue = [&](int n) {
        const size_t t0 = tok0 + (size_t)n * 128;
#pragma unroll
        for (int i = 0; i < 4; ++i) { const int c = tid + 512 * i, row = c >> 4, c16 = c & 15; kreg[i] = *(const u32x4*)(kb + (t0 + row) * 512 + h * 128 + c16 * 8); }
#pragma unroll
        for (int i = 0; i < 2; ++i) { const int c = tid + 512 * i, row = c >> 3, c8 = c & 7; vreg[i] = *(const u32x4*)(vb + (t0 + row) * DM + h * 256 + es * 64 + c8 * 8); }
#pragma unroll
        for (int s = 0; s < 4; ++s) qnext[s] = *(const u32x4*)(qb + (t0 + wid * 16 + fr) * 512 + h * 128 + s * 32 + fg * 8);
    };
    issue(0);
    const float qdec = exp2f((float)(wid * 16 + fr + 1) * l2g);
    for (int n = 0; n < 16; ++n) {
        float l2 = l2g; asm volatile("" : "+v"(l2));
        int irow = wid * 16 + fr, fgl = fg; asm volatile("" : "+v"(irow), "+v"(fgl));
        lds_barrier();
#pragma unroll
        for (int i = 0; i < 4; ++i) { const int c = tid + 512 * i, row = c >> 4, c16 = c & 15; *(LAS u32x4*)(lds + R_KT + row * R_KS + c16 * 16) = kreg[i]; }
#pragma unroll
        for (int i = 0; i < 2; ++i) { const int c = tid + 512 * i, row = c >> 3, c8 = c & 7; *(LAS u32x4*)(lds + R_VT + row * R_VS + c8 * 16) = vreg[i]; }
#pragma unroll
        for (int e = 0; e < 4; ++e) { u32x2 w; w.x = cvt_pk_bf16(st[e][0], st[e][1]); w.y = cvt_pk_bf16(st[e][2], st[e][3]);
            *(LAS u32x2*)(lds + R_SB + (wid * 16 + fr) * R_VS + (e * 16 + fg * 4) * 2) = w; }
#pragma unroll
        for (int s = 0; s < 4; ++s) qf[s] = qnext[s];
        if (n + 1 < 16) issue(n + 1);
        lds_barrier();
        {
#pragma unroll
            for (int jf = 0; jf < 8; ++jf) {
                if (jf > (widu | 1)) break;
                f32x4 sc = (f32x4){0.f, 0.f, 0.f, 0.f};
#pragma unroll
                for (int s = 0; s < 4; ++s) {
                    const bf16x8 a = *(const LAS bf16x8*)(lds + R_KT + (jf * 16 + fr) * R_KS + (s * 32 + fg * 8) * 2);
                    sc = __builtin_amdgcn_mfma_f32_16x16x32_bf16(a, __builtin_bit_cast(bf16x8, qf[s]), sc, 0, 0, 0);
                }
                float pv[4];
#pragma unroll
                for (int r = 0; r < 4; ++r) { const int j = jf * 16 + fgl * 4 + r; const int dlt = irow - j; pv[r] = dlt >= 0 ? sc[r] * __builtin_amdgcn_exp2f((float)dlt * l2) : 0.f; }
                u32x2 w; w.x = cvt_pk_bf16(pv[0], pv[1]); w.y = cvt_pk_bf16(pv[2], pv[3]);
                *(LAS u32x2*)(Pw + fr * 272 + (jf * 16 + fg * 4) * 2) = w;
                __builtin_amdgcn_sched_barrier(0);
            }
        }
        asm volatile("s_waitcnt lgkmcnt(0)" ::: "memory");
        {
            f32x4 o[4];
#pragma unroll
            for (int e = 0; e < 4; ++e) { o[e] = (f32x4){0.f, 0.f, 0.f, 0.f}; st[e] *= cd; }
#pragma unroll
            for (int s = 0; s < 4; ++s) {
                const bf16x8 pf = *(const LAS bf16x8*)(Pw + fr * 272 + (s * 32 + fg * 8) * 2);
                float kd[8];
#pragma unroll
                for (int j = 0; j < 8; ++j) kd[j] = __builtin_amdgcn_exp2f((float)(127 - (s * 32 + fgl * 8 + j)) * l2);
                const bf16x8 kf = scale_frag(tr_frag(lds + R_KT, R_KS, s * 32, wid * 16, lane), kd);
                float qs[8];
#pragma unroll
                for (int j = 0; j < 8; ++j) qs[j] = qdec;
                const bf16x8 qsf = scale_frag(__builtin_bit_cast(bf16x8, qf[s]), qs);
#pragma unroll
                for (int e = 0; e < 4; ++e) {
                    const bf16x8 vf = tr_frag(lds + R_VT, R_VS, s * 32, e * 16, lane);
                    if (s <= (widu >> 1)) o[e] = __builtin_amdgcn_mfma_f32_16x16x32_bf16(vf, pf, o[e], 0, 0, 0);
                    st[e] = __builtin_amdgcn_mfma_f32_16x16x32_bf16(vf, kf, st[e], 0, 0, 0);
                    const bf16x8 sf = tr_frag(lds + R_SB, R_VS, s * 32, e * 16, lane);
                    o[e] = __builtin_amdgcn_mfma_f32_16x16x32_bf16(sf, qsf, o[e], 0, 0, 0);
                }
                __builtin_amdgcn_sched_barrier(0);
            }
            const size_t tok = tok0 + (size_t)n * 128 + wid * 16 + fr;
            float s1 = 0.f, s2 = 0.f;
#pragma unroll
            for (int e = 0; e < 4; ++e) {
                u32x2 w; w.x = cvt_pk_bf16(o[e][0], o[e][1]); w.y = cvt_pk_bf16(o[e][2], o[e][3]);
                *(u32x2*)(vb + tok * DM + h * 256 + es * 64 + e * 16 + fg * 4) = w;
                s1 += (o[e][0] + o[e][1]) + (o[e][2] + o[e][3]);
                s2 += (o[e][0] * o[e][0] + o[e][1] * o[e][1]) + (o[e][2] * o[e][2] + o[e][3] * o[e][3]);
            }
            s1 += __shfl_xor(s1, 16); s1 += __shfl_xor(s1, 32); s2 += __shfl_xor(s2, 16); s2 += __shfl_xor(s2, 32);
            if (fg == 0) { unsafeAtomicAdd(stats + (tok * 4 + h) * 2, s1); unsafeAtomicAdd(stats + (tok * 4 + h) * 2 + 1, s2); }
        }
    }
    lds_barrier();
}

constexpr int L_XC = 0;
constexpr int L_WL = 128 * 272;
constexpr int L_SA = L_WL + 128 * 272;
constexpr int L_SBX = L_SA + 32768;
constexpr int L_SEGA = L_SBX + 32768;
constexpr int L_SEGB = L_SEGA + 2048;
constexpr int L_CARRY = L_SEGB + 2048;
constexpr int L_CW = L_CARRY + 512;
static_assert(L_CW + 5 * 512 <= LDS_BYTES - 16, "lru lds");
__device__ __forceinline__ void lru_item(LAS unsigned char* lds, int item, const bf16_t* xl, bf16_t* gg  , const bf16_t* wlru,
                                         const float* conv_w, const float* conv_b, const float* b_r, const float* b_i, const float* lam) {
    int tid = threadIdx.x; asm volatile("" : "+v"(tid));
    const int wid = tid >> 6, lane = tid & 63, fr = lane & 15, fg = lane >> 4;
    const int b = item >> 4, g = (item >> 1) & 7, hf2 = item & 1;
    const int chg = g * 128, c0 = chg + hf2 * 64;
    const size_t tok0 = (size_t)b * SEQ;
    for (int c = tid; c < 128 * 16; c += 512) { const int n = c >> 4, c16 = c & 15; const bf16_t* src = wlru + ((size_t)(n >> 6) * 1024 + c0 + (n & 63)) * 128 + c16 * 8;
        *(LAS u32x4*)(lds + L_WL + n * 272 + c16 * 16) = *(const u32x4*)src; }
    if (tid < 64) ((LAS float*)(lds + L_CARRY))[tid] = 0.f;
    const int ch8 = tid & 15;
    for (int c = tid; c < 5 * 128; c += 512) ((LAS float*)(lds + L_CW))[c] = c < 512 ? conv_w[(c >> 7) * DM + chg + (c & 127)] : conv_b[chg + (c & 127)];
    float br_[4], bi_[4], sp_[4];
#pragma unroll
    for (int hf = 0; hf < 4; ++hf) { const int ch = c0 + hf * 16 + fr; br_[hf] = b_r[ch]; bi_[hf] = b_i[ch]; sp_[hf] = log1pf(__expf(-lam[ch])); }
    u32x4 rwn[7];
    auto load_rows = [&](int T0n) {
        const int tk0 = (tid >> 4) * 4;
#pragma unroll
        for (int q = 0; q < 7; ++q) { const int ts = T0n + tk0 - 3 + q; rwn[q] = ts >= 0 ? *(const u32x4*)(xl + (tok0 + ts) * DM + chg + ch8 * 8) : (u32x4){0u, 0u, 0u, 0u}; }
    };
    load_rows(0);
    for (int tile = 0; tile < 16; ++tile) {
        const int T0 = tile * 128;
        bf16_t gpre[16];
#pragma unroll
        for (int t = 0; t < 16; ++t) gpre[t] = gg[(tok0 + T0 + wid * 16 + t) * DM + c0 + lane];
        {
            const int tk0 = (tid >> 4) * 4;
            float acc8[4][8], cw[4][8];
            { const f32x4 b0 = *(const LAS f32x4*)(lds + L_CW + 2048 + ch8 * 32), b1 = *(const LAS f32x4*)(lds + L_CW + 2048 + ch8 * 32 + 16);
#pragma unroll
              for (int i = 0; i < 4; ++i)
#pragma unroll
                for (int j = 0; j < 4; ++j) { acc8[i][j] = b0[j]; acc8[i][4 + j] = b1[j]; } }
#pragma unroll
            for (int t = 0; t < 4; ++t) { const f32x4 w0 = *(const LAS f32x4*)(lds + L_CW + t * 512 + ch8 * 32), w1 = *(const LAS f32x4*)(lds + L_CW + t * 512 + ch8 * 32 + 16);
#pragma unroll
                for (int j = 0; j < 4; ++j) { cw[t][j] = w0[j]; cw[t][4 + j] = w1[j]; } }
#pragma unroll
            for (int q = 0; q < 7; ++q) { float x[8]; unpack8(rwn[q], x);
#pragma unroll
                for (int i = 0; i < 4; ++i) { const int tap = q - i;
                    if (tap >= 0 && tap < 4) {
#pragma unroll
                        for (int j = 0; j < 8; ++j) acc8[i][j] += cw[tap][j] * x[j]; } } }
#pragma unroll
            for (int i = 0; i < 4; ++i) *(LAS u32x4*)(lds + L_XC + (tk0 + i) * 272 + ch8 * 16) = pack8(acc8[i]);
            if (tile + 1 < 16) load_rows(T0 + 128);
        }
        lds_barrier();
        {
            f32x4 ga[8];
#pragma unroll
            for (int nf = 0; nf < 8; ++nf) ga[nf] = (f32x4){0.f, 0.f, 0.f, 0.f};
#pragma unroll
            for (int s = 0; s < 4; ++s) {
                const bf16x8 af = *(const LAS bf16x8*)(lds + L_XC + (wid * 16 + fr) * 272 + (s * 32 + fg * 8) * 2);
#pragma unroll
                for (int nf = 0; nf < 8; ++nf) {
                    const bf16x8 bfr = *(const LAS bf16x8*)(lds + L_WL + (nf * 16 + fr) * 272 + (s * 32 + fg * 8) * 2);
                    ga[nf] = __builtin_amdgcn_mfma_f32_16x16x32_bf16(af, bfr, ga[nf], 0, 0, 0);
                }
            }
#pragma unroll
            for (int hf = 0; hf < 4; ++hf)
#pragma unroll
                for (int r = 0; r < 4; ++r) {
                    const int tk = wid * 16 + fg * 4 + r, cl = hf * 16 + fr;
                    float rg, ig; sigmoid2(ga[hf][r] + br_[hf], ga[4 + hf][r] + bi_[hf], rg, ig);
                    const float la = -8.0f * rg * sp_[hf]; const float a = __expf(la); const float mult = __builtin_amdgcn_sqrtf(fmaxf(fmaf(-a, a, 1.0f), 0.f));
                    const float x = bf2f(*(const LAS bf16_t*)(lds + L_XC + tk * 272 + (hf2 * 64 + cl) * 2));
                    ((LAS float*)(lds + L_SA))[tk * 64 + cl] = a; ((LAS float*)(lds + L_SBX))[tk * 64 + cl] = mult * ig * x;
                }
        }
        asm volatile("s_waitcnt lgkmcnt(0)" ::: "memory");
        {
            const int c = lane, sg = wid;
            float A = 1.f, B = 0.f;
#pragma unroll
            for (int t = 0; t < 16; ++t) { const float a_ = ((LAS float*)(lds + L_SA))[(sg * 16 + t) * 64 + c], b_ = ((LAS float*)(lds + L_SBX))[(sg * 16 + t) * 64 + c]; A *= a_; B = a_ * B + b_; }
            ((LAS float*)(lds + L_SEGA))[sg * 64 + c] = A; ((LAS float*)(lds + L_SEGB))[sg * 64 + c] = B;
            lds_barrier();
            float hst = ((LAS float*)(lds + L_CARRY))[(tile & 1) * 64 + c];
            { float sa_[7], sb_[7];
#pragma unroll
              for (int s2 = 0; s2 < 7; ++s2) { sa_[s2] = ((LAS float*)(lds + L_SEGA))[s2 * 64 + c]; sb_[s2] = ((LAS float*)(lds + L_SEGB))[s2 * 64 + c]; }
#pragma unroll
              for (int s2 = 0; s2 < 7; ++s2) hst = s2 < sg ? sa_[s2] * hst + sb_[s2] : hst; }
#pragma unroll
            for (int t = 0; t < 16; ++t) {
                hst = ((LAS float*)(lds + L_SA))[(sg * 16 + t) * 64 + c] * hst + ((LAS float*)(lds + L_SBX))[(sg * 16 + t) * 64 + c];
                gg[(tok0 + T0 + sg * 16 + t) * DM + c0 + c] = (bf16_t)(cvt_pk_bf16(hst * bf2f(gpre[t]), 0.f) & 0xffffu);
            }
            if (sg == 7) ((LAS float*)(lds + L_CARRY))[((tile + 1) & 1) * 64 + c] = hst;
        }
    }
    lds_barrier();
}

constexpr int X_T = 0, X_TS = 528;
constexpr int X_VS = 272;
constexpr int X_PW = 256 * 272;
constexpr int X_SCR = X_PW + 8 * 16 * 272;
static_assert(128 * 528 <= X_PW && X_SCR + 8 * 256 <= 128 * 1024, "xattn lds");
__device__ __forceinline__ void xattn_items(LAS unsigned char* lds, const int* items, int nitems, const bf16_t* xq, const bf16_t* xkv, bf16_t* xo) {
    int tid = threadIdx.x; asm volatile("" : "+v"(tid));
    const int wid = tid >> 6, lane = tid & 63, fr = lane & 15, fg = lane >> 4;
    LAS unsigned char* Pw = lds + X_PW + wid * (16 * 272);
    u32x4 pre[8];
    auto loadK = [&](int b, int h, int mt) {
#pragma unroll
        for (int i = 0; i < 8; ++i) { const int c = tid + 512 * i, row = c >> 5, c16 = c & 31; pre[i] = *(const u32x4*)(xkv + ((size_t)b * 256 + mt * 128 + row) * 2048 + h * 256 + c16 * 8); } };
    auto loadV = [&](int b, int h, int mt) {
#pragma unroll
        for (int i = 0; i < 8; ++i) { const int c = tid + 512 * i, row = c >> 5, c16 = c & 31; pre[i] = *(const u32x4*)(xkv + ((size_t)b * 256 + mt * 128 + row) * 2048 + 1024 + h * 256 + c16 * 8); } };
    auto putK = [&]() {
#pragma unroll
        for (int i = 0; i < 8; ++i) { const int c = tid + 512 * i, row = c >> 5, c16 = c & 31; *(LAS u32x4*)(lds + X_T + row * X_TS + c16 * 16) = pre[i]; } };
    { const int it0 = items[0]; loadK(it0 >> 6, (it0 >> 4) & 3, 0); }
    for (int ii = 0; ii < nitems; ++ii) {
        const int item = items[ii];
        const int b = item >> 6, h = (item >> 4) & 3, qt = item & 15;
        const size_t tok = (size_t)b * SEQ + qt * 128 + wid * 16 + fr;
        bf16x8 qf[8];
#pragma unroll
        for (int s = 0; s < 8; ++s) qf[s] = __builtin_bit_cast(bf16x8, *(const u32x4*)(xq + tok * DM + h * 256 + s * 32 + fg * 8));
        f32x4 sc[16];
#pragma unroll
        for (int mt = 0; mt < 2; ++mt) {
            lds_barrier();
            putK();
            if (mt == 0) loadK(b, h, 1); else loadV(b, h, 0);
            lds_barrier();
#pragma unroll
            for (int mf = 0; mf < 8; ++mf) {
                f32x4 a4 = (f32x4){0.f, 0.f, 0.f, 0.f};
#pragma unroll
                for (int s = 0; s < 8; ++s) {
                    const bf16x8 kf = *(const LAS bf16x8*)(lds + X_T + (mf * 16 + fr) * X_TS + (s * 32 + fg * 8) * 2);
                    a4 = __builtin_amdgcn_mfma_f32_16x16x32_bf16(kf, qf[s], a4, 0, 0, 0);
                }
                sc[mt * 8 + mf] = a4;
            }
        }
        float mx = -3.0e38f;
#pragma unroll
        for (int f = 0; f < 16; ++f) mx = fmaxf(mx, fmaxf(fmaxf(sc[f][0], sc[f][1]), fmaxf(sc[f][2], sc[f][3])));
        volatile LAS float* scr = (volatile LAS float*)(lds + X_SCR) + wid * 64;
        scr[lane] = mx;
        { const float m0 = scr[fr], m1 = scr[fr + 16], m2 = scr[fr + 32], m3 = scr[fr + 48]; mx = fmaxf(fmaxf(m0, m1), fmaxf(m2, m3)); }
        float sum = 0.f;
#pragma unroll
        for (int f = 0; f < 16; ++f)
#pragma unroll
            for (int r = 0; r < 4; ++r) { const float pe = __expf(sc[f][r] - mx); sc[f][r] = pe; sum += pe; }
        scr[lane] = sum;
        { const float m0 = scr[fr], m1 = scr[fr + 16], m2 = scr[fr + 32], m3 = scr[fr + 48]; sum = (m0 + m1) + (m2 + m3); }
        const float inv = 1.0f / sum;
        f32x4 o[16];
#pragma unroll
        for (int f = 0; f < 16; ++f) o[f] = (f32x4){0.f, 0.f, 0.f, 0.f};
#pragma unroll
        for (int mt = 0; mt < 2; ++mt) {
            lds_barrier();
            putK();
            if (mt == 0) loadV(b, h, 1);
            else if (ii + 1 < nitems) { const int itn = items[ii + 1]; loadK(itn >> 6, (itn >> 4) & 3, 0); }
#pragma unroll
            for (int f = 0; f < 8; ++f) { const f32x4 pv = sc[mt * 8 + f] * inv; u32x2 w; w.x = cvt_pk_bf16(pv[0], pv[1]); w.y = cvt_pk_bf16(pv[2], pv[3]);
                *(LAS u32x2*)(Pw + fr * 272 + (f * 16 + fg * 4) * 2) = w; }
            lds_barrier();
#pragma unroll
            for (int s = 0; s < 4; ++s) {
                const bf16x8 pf = *(const LAS bf16x8*)(Pw + fr * 272 + (s * 32 + fg * 8) * 2);
#pragma unroll
                for (int df = 0; df < 16; ++df) {
                    const bf16x8 vf = tr_frag(lds + X_T, X_TS, s * 32, df * 16, lane);
                    o[df] = __builtin_amdgcn_mfma_f32_16x16x32_bf16(vf, pf, o[df], 0, 0, 0);
                }
            }
        }
#pragma unroll
        for (int df = 0; df < 16; ++df) { u32x2 w; w.x = cvt_pk_bf16(o[df][0], o[df][1]); w.y = cvt_pk_bf16(o[df][2], o[df][3]);
            *(u32x2*)(xo + tok * DM + h * 256 + df * 16 + fg * 4) = w; }
    }
    lds_barrier();
}
__device__ __forceinline__ void xattn_pair(LAS unsigned char* lds, int i0, const bf16_t* xq, const bf16_t* xkv, bf16_t* xo) { const int it[2] = {i0, i0 + 1}; xattn_items(lds, it, 2, xq, xkv, xo); }
__device__ __forceinline__ void xattn_item(LAS unsigned char* lds, int item, const bf16_t* xq, const bf16_t* xkv, bf16_t* xo) { const int it[1] = {item}; xattn_items(lds, it, 1, xq, xkv, xo); }

struct Ptrs {
    unsigned char* ws; float *ss1, *ss2, *ss3, *ss4, *ss5, *ssm, *stats, *rcos, *rsin; bf16_t *mb, *xkv, *B0, *B1, *B2, *B3, *B4, *qbuf, *kbuf;
    __device__ __forceinline__ explicit Ptrs(unsigned char* w) {
        size_t z = 0; asm volatile("" : "+s"(z));
        ws = w + z; ss1 = (float*)(ws + S_SS); ss2 = ss1 + T_TOK; ss3 = ss2 + T_TOK; ss4 = ss3 + T_TOK; ss5 = ss4 + T_TOK;
        ssm = (float*)(ws + S_SSM); stats = (float*)(ws + S_STATS); rcos = (float*)(ws + S_COS); rsin = (float*)(ws + S_SIN);
        mb = (bf16_t*)(ws + A_MB); xkv = (bf16_t*)(ws + A_XKV);
        B0 = (bf16_t*)(ws + A_B0); B1 = (bf16_t*)(ws + A_B1); B2 = (bf16_t*)(ws + A_B2); B3 = (bf16_t*)(ws + A_B3); B4 = (bf16_t*)(ws + A_B4);
        qbuf = B1; kbuf = B1 + (size_t)T_TOK * 512;
    }
    __device__ __forceinline__ const bf16_t* w(size_t off) const { return (const bf16_t*)(ws + off); }
};
template <class Epi>
__device__ __forceinline__ void run_gemm(LAS unsigned char* lds, const bf16_t* A, int lda, const bf16_t* Bt, int M, int N, int K, int c, const Epi& E) {
    pg8::StaticOrder S; S.init(M, N, (int)gridDim.x, c);
    pg8::gemm_phase(lds, pg8::Gemm{A, Bt, M, N, K, lda, K}, S, E);
}
__device__ __forceinline__ void phase_prep(const Params& p, LAS unsigned char* lds) {
    const Ptrs P(p.ws); unsigned char* ws = P.ws;
    const int G = (int)gridDim.x, bid = (int)blockIdx.x, tid = threadIdx.x;
    for (int i = bid * 512 + tid; i < 4 * T_TOK; i += G * 512) P.ss2[i] = 0.f;
    for (int i = bid * 512 + tid; i < T_TOK * 8; i += G * 512) P.stats[i] = 0.f;
    for (int i = bid * 512 + tid; i < SEQ * 64; i += G * 512) {
        const int pos = i >> 6, d = i & 63;
        const float invf = exp2f(-(float)d * (13.287712379549449f / 64.0f));
        const float ang = (float)pos * invf;
        const float nrev = rintf(ang * 0.15915494309189535f);
        float r = fmaf(-nrev, 6.2831854820251465f, ang); r = fmaf(-nrev, -1.7484555314695172e-07f, r);
        P.rcos[i] = __builtin_amdgcn_cosf(r * 0.15915494309189535f); P.rsin[i] = __builtin_amdgcn_sinf(r * 0.15915494309189535f);
    }
    rows_prep(p.in[0], P.B0, P.ss1, T_TOK);
    rows_prep(p.in[1], P.mb, P.ssm, MEMT);
    const float* w1a = p.in[3]; const float* w3a = p.in[4];
    wprep(lds, (bf16_t*)(ws + W_13A), 5632, 1024, p.in[2], [=](int r) { const int pn = r >> 8, bj = (r >> 7) & 1, pp = r & 127; return RowSrc{(bj ? w3a : w1a) + pn * 128 + pp, DFF}; });
    const float* w2a = p.in[5];
    wprep(lds, (bf16_t*)(ws + W_2A), 1024, 2816, nullptr, [=](int r) { return RowSrc{w2a + r, 1024}; });
    const float* win = p.in[7];
    wprep(lds, (bf16_t*)(ws + W_IN), 4096, 1024, p.in[6], [=](int r) {
        int col;
        if (r < 1024) { const int seg = r >> 9, rr = r & 511, pnl = rr >> 8, bj = (rr >> 7) & 1, pp = rr & 127; const int head = 2 * pnl + (pp >> 6), d = pp & 63; col = seg * 512 + head * 128 + 64 * bj + d; }
        else if (r < 2048) col = 3072 + (r - 1024);
        else if (r < 3072) col = 1024 + (r - 2048);
        else col = 4096 + (r - 3072);
        return RowSrc{win + col, 5120}; });
    const float* wxk = p.in[24]; const float* wxv = p.in[25];
    wprep(lds, (bf16_t*)(ws + W_XKV), 2048, 1024, p.in[22], [=](int r) { return r < 1024 ? RowSrc{wxk + r, 1024} : RowSrc{wxv + (r - 1024), 1024}; });
    const float* wrg = p.in[12]; const float* wig = p.in[14];
    wprep(lds, (bf16_t*)(ws + W_LRU), 2048, 128, nullptr, [=](int r) { const int gi = (r >> 7) & 7, c = r & 127; return RowSrc{(r < 1024 ? wrg : wig) + gi * 16384 + c, 128}; });
}
__device__ __forceinline__ void phase1_late(const Params& p, LAS unsigned char* lds, unsigned char* ws) {
    const int G = (int)gridDim.x, bid = (int)blockIdx.x;
    const int nlate = G / 4, l0 = G - nlate;
    if (bid >= l0) {
        const float* w1b = p.in[28]; const float* w3b = p.in[29];
        wprep(lds, (bf16_t*)(ws + W_13B), 5632, 1024, p.in[27], [=](int r) { const int pn = r >> 8, bj = (r >> 7) & 1, pp = r & 127; return RowSrc{(bj ? w3b : w1b) + pn * 128 + pp, DFF}; }, bid - l0, nlate);
        const float* w2b = p.in[30];
        wprep(lds, (bf16_t*)(ws + W_2B), 1024, 2816, nullptr, [=](int r) { return RowSrc{w2b + r, 1024}; }, bid - l0, nlate);
    } else if (bid >= G / 2) {
        const int m0 = G / 2, nm = l0 - m0;
        const float* wout = p.in[20]; wprep(lds, (bf16_t*)(ws + W_OUT), 1024, 1024, nullptr, [=](int r) { return RowSrc{wout + r, 1024}; }, bid - m0, nm);
        const float* wxq = p.in[23]; wprep(lds, (bf16_t*)(ws + W_XQ), 1024, 1024, p.in[21], [=](int r) { return RowSrc{wxq + r, 1024}; }, bid - m0, nm);
        const float* wxo = p.in[26]; wprep(lds, (bf16_t*)(ws + W_XO), 1024, 1024, nullptr, [=](int r) { return RowSrc{wxo + r, 1024}; }, bid - m0, nm);
    }
}
__device__ __forceinline__ void phase_mix(const Params& p, LAS unsigned char* lds, int mode = 0) {
    const Ptrs P(p.ws); const int G = (int)gridDim.x, bid = (int)blockIdx.x;
    if (G == 256) {
        if (bid < 128) { retention_item(lds, bid, P.qbuf, P.kbuf, P.B3, P.stats);
            unsigned char* ws = P.ws; const float* win = p.in[7]; const float* wbg = p.in[18];
            wprep(lds, (bf16_t*)(ws + W_GG), 3072, 1024, p.in[6], [=](int r) { return r < 1024 ? RowSrc{win + 2048 + r, 5120} : RowSrc{wbg + (r - 1024), 2048}; }, bid, 128);
            const float* wro = p.in[9]; wprep(lds, (bf16_t*)(ws + W_RO), 1024, 1024, nullptr, [=](int r) { return RowSrc{wro + r, 1024}; }, bid, 128);
            const float* wlo = p.in[17]; wprep(lds, (bf16_t*)(ws + W_LO), 1024, 1024, nullptr, [=](int r) { return RowSrc{wlo + r, 1024}; }, bid, 128); }
        else lru_item(lds, bid - 128, P.B2, P.B4, P.w(W_LRU), p.in[10], p.in[11], p.in[13], p.in[15], p.in[16]);
    } else {
        { unsigned char* ws = P.ws; const float* win = p.in[7]; const float* wbg = p.in[18];
          wprep(lds, (bf16_t*)(ws + W_GG), 3072, 1024, p.in[6], [=](int r) { return r < 1024 ? RowSrc{win + 2048 + r, 5120} : RowSrc{wbg + (r - 1024), 2048}; });
          const float* wro = p.in[9]; wprep(lds, (bf16_t*)(ws + W_RO), 1024, 1024, nullptr, [=](int r) { return RowSrc{wro + r, 1024}; });
          const float* wlo = p.in[17]; wprep(lds, (bf16_t*)(ws + W_LO), 1024, 1024, nullptr, [=](int r) { return RowSrc{wlo + r, 1024}; }); }
        for (int it = bid; it < 256; it += G) {
            if (it < 128) retention_item(lds, it, P.qbuf, P.kbuf, P.B3, P.stats);
            else lru_item(lds, it - 128, P.B2, P.B4, P.w(W_LRU), p.in[10], p.in[11], p.in[13], p.in[15], p.in[16]);
        }
    }
}
__device__ __forceinline__ void phase_final(const Params& p) {
    const Ptrs P(p.ws); const int G = (int)gridDim.x, bid = (int)blockIdx.x, tid = threadIdx.x;
    const float* gf = p.in[31]; float* X = p.out;
    for (int i = bid * 512 + tid; i < T_TOK * 256; i += G * 512) {
        const int row = i >> 8, c = (i & 255) * 4; const float rs = rs_of(P.ss5[row]);
        const u32x2 w = *(const u32x2*)(P.B0 + (size_t)row * DM + c); const f32x4 gv = *(const f32x4*)(gf + c);
        f32x4 v = (f32x4){bflo(w.x), bfhi(w.x), bflo(w.y), bfhi(w.y)};
        v = v * rs * gv; *(f32x4*)(X + (size_t)row * DM + c) = v;
    }
}

__global__ __launch_bounds__(512, 2) void fwd_mega(Params p) {
    extern __shared__ __attribute__((aligned(16))) unsigned char shm[];
    LAS unsigned char* lds = (LAS unsigned char*)shm;
    cg::grid_group grid = cg::this_grid();
    const int bid = (int)blockIdx.x, G = (int)gridDim.x;
    unsigned* bar = (unsigned*)(p.ws + S_BAR);
    volatile LAS unsigned* xst = (volatile LAS unsigned*)(lds + LDS_BYTES - 16);
    if (threadIdx.x == 0) { xst[0] = 0u; xst[1] = 0u; }
    __syncthreads();
    const XcdBarrier xb = xcd_barrier_post(bar, xst);
    if (p.ph_lo > 1000) grid.sync();
#ifndef PHMASK
#define PHMASK 0x7fff
#endif
#ifndef REPMASK
#define REPMASK 0
#endif
#define PHASE(k, body) if (((PHMASK >> (k)) & 1) && p.ph_lo <= (k) && (k) < p.ph_hi) { if ((k) > p.ph_lo) xcd_barrier(xb); { body } if ((REPMASK >> (k)) & 1) { xcd_barrier(xb); { body } } }
    PHASE(0, phase_prep(p, lds);)
    PHASE(1, { const Ptrs P(p.ws);
        run_gemm(lds, P.B0, 1024, P.w(W_13A), T_TOK, 5632, 1024, bid, EpiSwiglu{P.B1, P.ss1});
        run_gemm(lds, P.mb, 1024, P.w(W_XKV), MEMT, 2048, 1024, (bid + G / 2) % G, EpiScale{P.xkv, 2048, P.ssm, 1.0f});
        phase1_late(p, lds, P.ws); })
    PHASE(2, { const Ptrs P(p.ws);
        run_gemm(lds, P.B1, DFF, P.w(W_2A), T_TOK, 1024, DFF, bid, EpiResidB<false>{P.B0, P.B0, P.ss2, 0.5f}); })
    PHASE(3, { const Ptrs P(p.ws);
        run_gemm(lds, P.B0, 1024, P.w(W_IN), T_TOK, 4096, 1024, bid, EpiInproj{P.qbuf, P.B2, P.ss2, P.rcos, P.rsin}); })
    PHASE(4, phase_mix(p, lds);)
    PHASE(5, { const Ptrs P(p.ws);
        run_gemm(lds, P.B0, 1024, P.w(W_GG), T_TOK, 3072, 1024, bid, EpiGG{P.B3, P.B1, P.ss2, P.stats, p.in[8], p.in[19]}); })
    PHASE(6, { const Ptrs P(p.ws);
        run_gemm(lds, P.B3, 1024, P.w(W_RO), T_TOK, 1024, 1024, bid, EpiMerge<false>{(bf16_t*)p.out, P.B1}); })
    if (((PHMASK >> 7) & 1) && p.ph_lo <= 7 && 7 < p.ph_hi) { const Ptrs P(p.ws);
        run_gemm(lds, P.B4, 1024, P.w(W_LO), T_TOK, 1024, 1024, bid, EpiMerge<true>{(bf16_t*)p.out, P.B1}); }
    PHASE(8, { const Ptrs P(p.ws);
        run_gemm(lds, (const bf16_t*)p.out, 1024, P.w(W_OUT), T_TOK, 1024, 1024, bid, EpiResidB<false>{P.B0, P.B3, P.ss3, 1.0f}); })
    PHASE(9, { const Ptrs P(p.ws);
        run_gemm(lds, P.B3, 1024, P.w(W_XQ), T_TOK, 1024, 1024, bid, EpiScale{P.B4, 1024, P.ss3, 0.0625f});
        if (G == 256) {
            pg8::StaticOrder S; S.init(T_TOK, 1024, G, bid); Unit u; S.next(0, u);
            asm volatile("s_waitcnt vmcnt(0)" ::: "memory"); __syncthreads();
            xattn_pair(lds, ((u.pm >> 3) << 6) | (u.pn << 4) | ((u.pm & 7) * 2), P.B4, P.xkv, P.B0);
        } })
    if (G != 256) { PHASE(10, { const Ptrs P(p.ws);
        for (int it = bid; it < 512; it += G) xattn_item(lds, it, P.B4, P.xkv, P.B0); }) }
    PHASE(11, { const Ptrs P(p.ws);
        run_gemm(lds, P.B0, 1024, P.w(W_XO), T_TOK, 1024, 1024, bid, EpiResidB<false>{P.B3, P.B4, P.ss4, 1.0f}); })
    PHASE(12, { const Ptrs P(p.ws);
        run_gemm(lds, P.B4, 1024, P.w(W_13B), T_TOK, 5632, 1024, bid, EpiSwiglu{P.B1, P.ss4}); })
    if (G == 256) {
        PHASE(13, { const Ptrs P(p.ws);
            run_gemm(lds, P.B1, DFF, P.w(W_2B), T_TOK, 1024, DFF, bid, EpiFinal{P.B4, p.out, P.ss5, p.in[31], xb}); })
    } else {
        PHASE(13, { const Ptrs P(p.ws);
            run_gemm(lds, P.B1, DFF, P.w(W_2B), T_TOK, 1024, DFF, bid, EpiResidB<false>{P.B4, P.B0, P.ss5, 0.5f}); })
        PHASE(14, phase_final(p);)
    }
#undef PHASE
}

constexpr int N_PHASES = 15;
#ifndef DBG_HI
#define DBG_HI N_PHASES
#endif
extern "C" void kernel_launch(void* const* d_in, const int* in_sizes, int n_in, void* d_out, int out_size, void* d_ws, size_t ws_size, hipStream_t stream) {
    static int grid = 0;
    if (grid == 0) {
        if (n_in != 32 || out_size != T_TOK * DM || ws_size < WS_NEED) { fprintf(stderr, "kernel_launch: unexpected shapes (n_in %d out %d ws %zu)\n", n_in, out_size, ws_size); grid = -1; return; }
        int dev = 0, cus = 0, per_cu = 0;
        hipGetDevice(&dev); hipDeviceGetAttribute(&cus, hipDeviceAttributeMultiprocessorCount, dev);
        hipFuncSetAttribute((const void*)fwd_mega, hipFuncAttributeMaxDynamicSharedMemorySize, LDS_BYTES);
        hipOccupancyMaxActiveBlocksPerMultiprocessor(&per_cu, (const void*)fwd_mega, 512, LDS_BYTES);
        if (per_cu < 1) { fprintf(stderr, "kernel_launch: occupancy query says %d blocks/CU\n", per_cu); per_cu = 1; }
        (void)hipGetLastError();
        grid = cus;
    }
    if (grid < 0) return;
    Params p{};
    for (int i = 0; i < 32; ++i) p.in[i] = (const float*)d_in[i];
    p.out = (float*)d_out; p.ws = (unsigned char*)d_ws;
#ifndef N_CUTS
#define N_CUTS 1
#endif
    if (hipMemsetAsync((unsigned char*)d_ws + S_BAR, 0, 16384, stream) != hipSuccess) { fprintf(stderr, "kernel_launch: memset of the barrier word failed\n"); return; }
    for (int li = 0; li < N_CUTS; ++li) {
        p.ph_lo = li * DBG_HI / N_CUTS; p.ph_hi = (li + 1) * DBG_HI / N_CUTS;
        void* args[] = {&p};
        hipError_t e = hipLaunchCooperativeKernel((const void*)fwd_mega, dim3(grid), dim3(512), args, LDS_BYTES, stream);
        if (e != hipSuccess) fprintf(stderr, "cooperative launch failed: %s (grid %d)\n", hipGetErrorString(e), grid);
    }
}
```
